# Optimizing an MI355X kernel written in HIP

```python
import math
import jax, jax.numpy as jnp
from jax import lax
import numpy as np

D_MODEL = 2048
BATCH = 4
SEQ = 8192
DEPTH = 1

CHUNK = 64
N_META = 16
Q_BLOCK = 128
N_DIFF_HEADS = 4
DIFF_HEAD_DIM = 128
DIFF_WIDTH = N_DIFF_HEADS * 2 * DIFF_HEAD_DIM
N_FOX_HEADS = 8
FOX_HEAD_DIM = 128
FOX_WIDTH = N_FOX_HEADS * FOX_HEAD_DIM
D_FF = -(-8 * D_MODEL // (3 * 256)) * 256
RMS_EPS = 1e-6
SUBLN_EPS = 1e-5
SPLIT_SIZES = [DIFF_WIDTH, DIFF_WIDTH, DIFF_WIDTH, FOX_WIDTH, FOX_WIDTH, FOX_WIDTH,
               N_FOX_HEADS, D_MODEL, D_MODEL]
SPLIT_OFFSETS = np.cumsum(SPLIT_SIZES)[:-1].tolist()
N_IN_COLS = int(sum(SPLIT_SIZES))

kernel_name = "hybrid_diffattn_fox_gated_block"


def _rms_norm(x, g, eps):
    xf = x.astype(jnp.float32)
    y = xf * lax.rsqrt(jnp.mean(xf * xf, axis=-1, keepdims=True) + eps)
    return (y * g.astype(jnp.float32)).astype(x.dtype)


def _chunk_id(pos):
    return jnp.where(pos < N_META, 0, 1 + (pos - N_META) // CHUNK)


def _alibi_slopes(n):
    return jnp.asarray([2.0 ** (-8.0 * (i + 1) / n) for i in range(n)], dtype=jnp.float32)


def _diff_attention(q, k, v, lam, slopes, pos):
    b, l = q.shape[0], q.shape[1]
    n_blk = l // Q_BLOCK
    key_chunk = _chunk_id(pos)
    q_blk = jnp.moveaxis(q.reshape(b, n_blk, Q_BLOCK, N_DIFF_HEADS, 2, DIFF_HEAD_DIM), 1, 0)
    pos_blk = pos.reshape(n_blk, Q_BLOCK)
    scale = DIFF_HEAD_DIM ** -0.5

    def one_block(args):
        qi, pi = args
        s = jnp.einsum("bqhcd,bkhcd->bhcqk", qi, k).astype(jnp.float32) * scale
        dist = jnp.abs(pi[:, None] - pos[None, :]).astype(jnp.float32)
        s = s - slopes[:, None, None, None] * dist
        visible = key_chunk[None, :] <= _chunk_id(pi)[:, None]
        p = jax.nn.softmax(jnp.where(visible, s, -jnp.inf), axis=-1)
        w = p[:, :, 0] - lam * p[:, :, 1]
        return jnp.einsum("bhqk,bkhe->bqhe", w.astype(v.dtype), v)

    o = lax.map(one_block, (q_blk, pos_blk))
    return jnp.moveaxis(o, 0, 1).reshape(b, l, N_DIFF_HEADS, 2 * DIFF_HEAD_DIM)


def _forgetting_attention(q, k, v, log_f, pos):
    b, l = q.shape[0], q.shape[1]
    n_blk = l // Q_BLOCK
    cum = jnp.moveaxis(jnp.cumsum(log_f, axis=1), 2, 1)
    q_blk = jnp.moveaxis(q.reshape(b, n_blk, Q_BLOCK, N_FOX_HEADS, FOX_HEAD_DIM), 1, 0)
    c_blk = jnp.moveaxis(cum.reshape(b, N_FOX_HEADS, n_blk, Q_BLOCK), 2, 0)
    pos_blk = pos.reshape(n_blk, Q_BLOCK)
    scale = FOX_HEAD_DIM ** -0.5

    def one_block(args):
        qi, ci, pi = args
        s = (jnp.einsum("bqhd,bkhd->bhqk", qi, k).astype(jnp.float32) * scale
             + (ci[:, :, :, None] - cum[:, :, None, :]))
        visible = pos[None, :] <= pi[:, None]
        p = jax.nn.softmax(jnp.where(visible, s, -jnp.inf), axis=-1)
        return jnp.einsum("bhqk,bkhd->bqhd", p.astype(v.dtype), v)

    o = lax.map(one_block, (q_blk, c_blk, pos_blk))
    return jnp.moveaxis(o, 0, 1).reshape(b, l, N_FOX_HEADS * FOX_HEAD_DIM)


def _hybrid_layer(h, pos, slopes, lambda_init, g_mix, w_in, lambda_q1, lambda_k1, lambda_q2,
                  lambda_k2, g_subln, b_f, w_branch_a, w_branch_f, w_out, g_ffn, w_gate,
                  w_up, w_down):
    b, l, _ = h.shape
    u = _rms_norm(h, g_mix, RMS_EPS)
    z = u @ w_in
    qa, ka, va, qf, kf, vf, zf, za_gate, zf_gate = jnp.split(z, SPLIT_OFFSETS, axis=-1)

    lam = (jnp.exp(jnp.sum(lambda_q1.astype(jnp.float32) * lambda_k1.astype(jnp.float32)))
           - jnp.exp(jnp.sum(lambda_q2.astype(jnp.float32) * lambda_k2.astype(jnp.float32)))
           + lambda_init)
    oa = _diff_attention(qa.reshape(b, l, N_DIFF_HEADS, 2, DIFF_HEAD_DIM),
                         ka.reshape(b, l, N_DIFF_HEADS, 2, DIFF_HEAD_DIM),
                         va.reshape(b, l, N_DIFF_HEADS, 2 * DIFF_HEAD_DIM),
                         lam, slopes, pos)
    oa = (_rms_norm(oa, g_subln, SUBLN_EPS) * (1.0 - lambda_init)).reshape(b, l, DIFF_WIDTH)

    log_f = jax.nn.log_sigmoid(zf.astype(jnp.float32) + b_f.astype(jnp.float32))
    of = _forgetting_attention(qf.reshape(b, l, N_FOX_HEADS, FOX_HEAD_DIM),
                               kf.reshape(b, l, N_FOX_HEADS, FOX_HEAD_DIM),
                               vf.reshape(b, l, N_FOX_HEADS, FOX_HEAD_DIM),
                               log_f, pos)

    merged = jax.nn.sigmoid(za_gate) * (oa @ w_branch_a) + jax.nn.sigmoid(zf_gate) * (of @ w_branch_f)
    h = h + merged @ w_out

    v2 = _rms_norm(h, g_ffn, RMS_EPS)
    h = h + (jax.nn.silu(v2 @ w_gate) * (v2 @ w_up)) @ w_down
    return h


def setup_inputs(seed: int = 0) -> dict:
    key = jax.random.key(seed)
    ks = jax.random.split(key, 20)
    f32 = jnp.float32

    def nrm(k, shape, scale):
        return jax.random.normal(k, shape, f32) * scale

    return {
        "x": nrm(ks[0], (BATCH, SEQ, D_MODEL), 1.0),
        "meta": nrm(ks[1], (N_META, D_MODEL), 1.0),
        "g_mix": 1.0 + nrm(ks[2], (DEPTH, D_MODEL), 0.02),
        "w_in": nrm(ks[3], (DEPTH, D_MODEL, N_IN_COLS), D_MODEL ** -0.5),
        "lambda_q1": nrm(ks[4], (DEPTH, DIFF_HEAD_DIM), 0.1),
        "lambda_k1": nrm(ks[5], (DEPTH, DIFF_HEAD_DIM), 0.1),
        "lambda_q2": nrm(ks[6], (DEPTH, DIFF_HEAD_DIM), 0.1),
        "lambda_k2": nrm(ks[7], (DEPTH, DIFF_HEAD_DIM), 0.1),
        "g_subln": 1.0 + nrm(ks[8], (DEPTH, 2 * DIFF_HEAD_DIM), 0.02),
        "b_f": jax.random.uniform(ks[9], (DEPTH, N_FOX_HEADS), f32, 1.0, 4.0),
        "w_branch_a": nrm(ks[10], (DEPTH, DIFF_WIDTH, D_MODEL), DIFF_WIDTH ** -0.5),
        "w_branch_f": nrm(ks[11], (DEPTH, FOX_WIDTH, D_MODEL), FOX_WIDTH ** -0.5),
        "w_out": nrm(ks[12], (DEPTH, D_MODEL, D_MODEL), D_MODEL ** -0.5),
        "g_ffn": 1.0 + nrm(ks[13], (DEPTH, D_MODEL), 0.02),
        "w_gate": nrm(ks[14], (DEPTH, D_MODEL, D_FF), D_MODEL ** -0.5),
        "w_up": nrm(ks[15], (DEPTH, D_MODEL, D_FF), D_MODEL ** -0.5),
        "w_down": nrm(ks[16], (DEPTH, D_FF, D_MODEL), D_FF ** -0.5),
        "g_final": 1.0 + nrm(ks[17], (D_MODEL,), 0.02),
    }


def reference(x, meta, g_mix, w_in, lambda_q1, lambda_k1, lambda_q2, lambda_k2, g_subln, b_f,
              w_branch_a, w_branch_f, w_out, g_ffn, w_gate, w_up, w_down, g_final):
    b, s, _ = x.shape
    l_real = s + N_META
    l_pad = -(-l_real // Q_BLOCK) * Q_BLOCK
    h = jnp.concatenate([jnp.broadcast_to(meta[None].astype(x.dtype), (b, N_META, D_MODEL)), x], axis=1)
    h = jnp.pad(h, ((0, 0), (0, l_pad - l_real), (0, 0)))
    pos = jnp.arange(l_pad, dtype=jnp.int32)
    slopes = _alibi_slopes(N_DIFF_HEADS)
    for i in range(DEPTH):
        lambda_init = 0.8 - 0.6 * math.exp(-0.3 * i)
        h = _hybrid_layer(h, pos, slopes, lambda_init, g_mix[i], w_in[i], lambda_q1[i],
                          lambda_k1[i], lambda_q2[i], lambda_k2[i], g_subln[i], b_f[i],
                          w_branch_a[i], w_branch_f[i], w_out[i], g_ffn[i], w_gate[i],
                          w_up[i], w_down[i])
    h = _rms_norm(h, g_final, RMS_EPS)
    return h[:, N_META:N_META + s]
```

```cpp
#include <hip/hip_runtime.h>
#include <hip/hip_cooperative_groups.h>
#include <cstdio>
#include <cstdint>
namespace cg = cooperative_groups;

#ifndef ONE_LAUNCH
#define ONE_LAUNCH 0
#endif

typedef unsigned short bf16_t;
typedef short bf16x8 __attribute__((ext_vector_type(8)));
typedef short s16x4 __attribute__((ext_vector_type(4)));
typedef float f32x4 __attribute__((ext_vector_type(4)));
typedef float f32x16 __attribute__((ext_vector_type(16)));
typedef unsigned u32x4 __attribute__((ext_vector_type(4)));
typedef unsigned u32x2 __attribute__((ext_vector_type(2)));

constexpr int DM = 2048, NBATCH = 4, SEQ = 8192, NMETA = 16;
constexpr int VPAD = 48;
constexpr int LB = 8256;
constexpr int M = NBATCH * LB;
constexpr int NINC = 10248;
constexpr int N1 = 10240;
constexpr int DFF = 5632, N5 = 2 * DFF;
constexpr int NHD = 48;

constexpr size_t SZ_W1T = (size_t)N1 * DM * 2, SZ_WAT = (size_t)DM * 1024 * 2, SZ_WOT = (size_t)DM * DM * 2, SZ_W5T = (size_t)N5 * DM * 2, SZ_WDT = (size_t)DM * DFF * 2;
constexpr size_t WS_W1T = 0, WS_WAT = WS_W1T + SZ_W1T, WS_WFT = WS_WAT + SZ_WAT, WS_WOT = WS_WFT + SZ_WAT, WS_W5T = WS_WOT + SZ_WOT, WS_WDT = WS_W5T + SZ_W5T;
constexpr size_t WS_RA = WS_WDT + SZ_WDT;
constexpr size_t SZ_RA = (size_t)M * DM * 2;
constexpr size_t WS_RB = WS_RA + SZ_RA;
constexpr size_t SZ_RB = (size_t)NHD * M * 128 * 2;
constexpr size_t WS_RG = WS_RB + SZ_RB;
constexpr size_t SZ_RG = (size_t)M * 4096 * 2;
constexpr size_t WS_RSTD1 = WS_RG + SZ_RG, WS_SSQ2 = WS_RSTD1 + (size_t)M * 4, WS_SSQ3 = WS_SSQ2 + (size_t)M * 4;
constexpr size_t WS_LOGF = WS_SSQ3 + (size_t)M * 4, WS_CUM = WS_LOGF + (size_t)32 * LB * 4;
constexpr size_t WS_SCR = WS_CUM + (size_t)32 * LB * 4;
constexpr size_t WS_END = WS_SCR + (size_t)256 * 262144;
constexpr int LDS_BYTES = 131072;

namespace pg8 {
#define PG8_LAS __attribute__((address_space(3)))
constexpr int BM = 256, BK = 64, HALF = 128, HTB = HALF * BK * 2, STAGE_BYTES = 8 * HTB, NXCD = 8, WGM = 8;
__host__ __device__ __forceinline__ int lds_byte(int r, int c) { const int st = (r >> 4) * 2 + (c >> 5), rr = r & 15, cc = c & 31, ob = rr * 64 + cc * 2; return st * 1024 + (ob ^ (((ob >> 9) & 1) << 5)); }
__host__ __device__ __forceinline__ void stage_rc(int b, int& R, int& C) { const int st = b / 1024, sb = b % 1024, swz = sb ^ (((sb >> 9) & 1) << 5); R = (st >> 1) * 16 + swz / 64; C = (st & 1) * 32 + (swz % 64) / 2; }
__host__ __device__ __forceinline__ int perm32(int rho) { const int n = rho >> 4, i = rho & 15; return 8 * (i >> 2) + 4 * n + (i & 3); }
struct Unit { int pm, pn; };
struct Gemm { const bf16_t* A; const bf16_t* Bt; int M, N, K; };
struct StaticOrder {
    int nM, nN, nwg, G, c;
    __host__ __device__ void init(int M_, int N_, int G_, int c_) { nM = M_ / BM; nN = N_ / BM; nwg = nM * nN; G = G_; c = c_; }
    __host__ __device__ bool next(int i, Unit& u) const {
        const long L = (long)i * G + c; if (L >= nwg) return false;
        int wgid = (int)L; { const int q = nwg / NXCD, r = nwg % NXCD, xcd = wgid % NXCD, off = wgid / NXCD; wgid = (xcd < r ? xcd * (q + 1) : r * (q + 1) + (xcd - r) * q) + off; }
        const int nig = WGM * nN, gid = wgid / nig, fm = gid * WGM, gsz = (nM - fm) < WGM ? (nM - fm) : WGM;
        u.pm = fm + ((wgid % nig) % gsz); u.pn = (wgid % nig) / gsz; return true;
    }
    __device__ __forceinline__ void a_ready(const Unit&) const {}
    __device__ __forceinline__ void done(const Unit&) const {}
};
__device__ __forceinline__ unsigned cvt_pk_bf16(float lo, float hi) { unsigned r; asm volatile("v_cvt_pk_bf16_f32 %0, %1, %2" : "=v"(r) : "v"(lo), "v"(hi)); return r; }

template <class Epi, class Sched>
__device__ __forceinline__ void gemm_phase(PG8_LAS unsigned char* lds, const Gemm g, const Sched& S, const Epi& E, const int tid) {
    const int wid = __builtin_amdgcn_readfirstlane(tid >> 6), lane = tid & 63, wr = wid >> 2, wc = wid & 3, fr = lane & 15, fq = lane >> 4;
    const int K = g.K, nt = K / BK;
    unsigned voffA[2], voffB[2];
#pragma unroll
    for (int i = 0; i < 2; ++i) { int R, C; stage_rc(tid * 16 + i * 8192, R, C); const int Rb = Epi::PERM ? ((R & ~31) + perm32(R & 31)) : R;
        voffA[i] = (unsigned)(R * K + C) * 2u; voffB[i] = (unsigned)(Rb * K + C) * 2u; }
    const size_t kstep = (size_t)(BK * 2);
    const size_t hstep = (size_t)HALF * K * 2;
    const size_t tstep = 2 * hstep;
    const unsigned ldsw = (unsigned)wid * 1024u;
    const int aoff = lds_byte(wr * 64 + fr, fq * 8), boff = lds_byte(wc * 32 + fr, fq * 8);
#define PG8_SA(b, h) (((b) * 2 + (h)) * HTB)
#define PG8_SB(b, h) ((4 + (b) * 2 + (h)) * HTB)
#define PG8_STAGE(bufoff, gbase, voff) do { _Pragma("unroll") for (int _i = 0; _i < 2; ++_i) \
        __builtin_amdgcn_global_load_lds((const unsigned*)((const char*)(gbase) + (voff)[_i]), (PG8_LAS unsigned*)(lds + (bufoff) + ldsw + _i * 8192), 16, 0, 0); } while (0)
#define PG8_LDA(dst, b, h) do { _Pragma("unroll") for (int m = 0; m < 4; ++m) _Pragma("unroll") for (int k = 0; k < 2; ++k) dst[m][k] = *(const PG8_LAS bf16x8*)(lds + PG8_SA(b, h) + aoff + m * 2048 + k * 1024); } while (0)
#define PG8_LDB(dst, b, h) do { _Pragma("unroll") for (int n = 0; n < 2; ++n) _Pragma("unroll") for (int k = 0; k < 2; ++k) dst[n][k] = *(const PG8_LAS bf16x8*)(lds + PG8_SB(b, h) + boff + n * 2048 + k * 1024); } while (0)
#define PG8_MMA(ai, bj, At, Bt) do { __builtin_amdgcn_s_setprio(1); _Pragma("unroll") for (int m = 0; m < 4; ++m) _Pragma("unroll") for (int n = 0; n < 2; ++n) _Pragma("unroll") for (int k = 0; k < 2; ++k) \
        acc[ai][bj][m][n] = __builtin_amdgcn_mfma_f32_16x16x32_bf16(Bt[n][k], At[m][k], acc[ai][bj][m][n], 0, 0, 0); __builtin_amdgcn_s_setprio(0); } while (0)
#define PG8_WAIT_V(n) asm volatile("s_waitcnt vmcnt(" #n ")" ::: "memory")
#define PG8_WAIT_L(n) asm volatile("s_waitcnt lgkmcnt(" #n ")" ::: "memory")
#define PG8_BAR __builtin_amdgcn_s_barrier()
#define PG8_SCHED __builtin_amdgcn_sched_barrier(0)
    Unit cur, nxt; int ui = 0;
    if (!S.next(0, cur)) return;
    f32x4 acc[2][2][4][2];
#pragma unroll
    for (int a = 0; a < 2; ++a)
#pragma unroll
        for (int b = 0; b < 2; ++b)
#pragma unroll
            for (int m = 0; m < 4; ++m)
#pragma unroll
                for (int n = 0; n < 2; ++n) acc[a][b][m][n] = (f32x4){0.f, 0.f, 0.f, 0.f};
    bf16x8 At[4][2], B0[2][2], B1[2][2];
    const char* cA = (const char*)g.A + (size_t)cur.pm * tstep; const char* cB = (const char*)g.Bt + (size_t)cur.pn * tstep;
    S.a_ready(cur);
    PG8_STAGE(PG8_SB(0, 0), cB, voffB); PG8_STAGE(PG8_SA(0, 0), cA, voffA); PG8_STAGE(PG8_SB(0, 1), cB + hstep, voffB); PG8_STAGE(PG8_SA(0, 1), cA + hstep, voffA);
    if (wr == 1) PG8_BAR;
    PG8_WAIT_V(4); PG8_BAR;
    PG8_STAGE(PG8_SB(1, 0), cB + kstep, voffB); PG8_STAGE(PG8_SA(1, 0), cA + kstep, voffA); PG8_STAGE(PG8_SB(1, 1), cB + hstep + kstep, voffB);
    PG8_WAIT_V(6); PG8_BAR;
    for (;;) {
        const bool has_next = S.next(ui + 1, nxt);
        const char* nA = has_next ? (const char*)g.A + (size_t)nxt.pm * tstep : cA; const char* nB = has_next ? (const char*)g.Bt + (size_t)nxt.pn * tstep : cB;
        for (int t = 0; t < nt; t += 2) {
            const bool last = (t == nt - 2);
            const char* a1 = cA + (size_t)(t + 1) * kstep;
            const char* a2 = last ? nA : cA + (size_t)(t + 2) * kstep; const char* b2 = last ? nB : cB + (size_t)(t + 2) * kstep;
            const char* a3 = a2 + kstep; const char* b3 = b2 + kstep;
            if (last && has_next) S.a_ready(nxt);
            PG8_LDB(B0, 0, 0); PG8_SCHED; PG8_LDA(At, 0, 0); PG8_STAGE(PG8_SA(1, 1), a1 + hstep, voffA);
            PG8_WAIT_L(8); PG8_BAR; PG8_WAIT_L(0); PG8_MMA(0, 0, At, B0); PG8_BAR; PG8_SCHED;
            PG8_LDB(B1, 0, 1); PG8_STAGE(PG8_SB(0, 0), b2, voffB);
            PG8_BAR; PG8_WAIT_L(0); PG8_MMA(0, 1, At, B1); PG8_BAR;
            PG8_LDA(At, 0, 1); PG8_STAGE(PG8_SA(0, 0), a2, voffA);
            PG8_BAR; PG8_WAIT_L(0); PG8_MMA(1, 0, At, B0); PG8_BAR; PG8_SCHED;
            PG8_STAGE(PG8_SB(0, 1), b2 + hstep, voffB);
            PG8_WAIT_V(6); PG8_BAR; PG8_MMA(1, 1, At, B1); PG8_BAR;
            PG8_LDB(B0, 1, 0); PG8_SCHED; PG8_LDA(At, 1, 0); PG8_STAGE(PG8_SA(0, 1), a2 + hstep, voffA);
            PG8_WAIT_L(8); PG8_BAR; PG8_WAIT_L(0); PG8_MMA(0, 0, At, B0); PG8_BAR; PG8_SCHED;
            PG8_LDB(B1, 1, 1); PG8_STAGE(PG8_SB(1, 0), b3, voffB);
            PG8_BAR; PG8_WAIT_L(0); PG8_MMA(0, 1, At, B1); PG8_BAR;
            PG8_LDA(At, 1, 1); PG8_STAGE(PG8_SA(1, 0), a3, voffA);
            PG8_BAR; PG8_WAIT_L(0); PG8_MMA(1, 0, At, B0); PG8_BAR; PG8_SCHED;
            PG8_STAGE(PG8_SB(1, 1), b3 + hstep, voffB);
            PG8_WAIT_V(6); PG8_BAR; PG8_MMA(1, 1, At, B1); PG8_BAR;
        }
        E(acc, cur, wr, wc, fr, fq); S.done(cur);
        if (!has_next) break;
#pragma unroll
        for (int a = 0; a < 2; ++a)
#pragma unroll
            for (int b = 0; b < 2; ++b)
#pragma unroll
                for (int m = 0; m < 4; ++m)
#pragma unroll
                    for (int n = 0; n < 2; ++n) acc[a][b][m][n] = (f32x4){0.f, 0.f, 0.f, 0.f};
        cur = nxt; cA = nA; cB = nB; ++ui;
    }
    PG8_WAIT_V(0);
    if (wr == 0) PG8_BAR;
    PG8_BAR;
#undef PG8_SA
#undef PG8_SB
#undef PG8_STAGE
#undef PG8_LDA
#undef PG8_LDB
#undef PG8_MMA
#undef PG8_WAIT_V
#undef PG8_WAIT_L
#undef PG8_BAR
#undef PG8_SCHED
}
}

__device__ __forceinline__ int fresh_lane() { int l; asm volatile("v_mbcnt_lo_u32_b32 %0, -1, 0\n\tv_mbcnt_hi_u32_b32 %0, -1, %0" : "=v"(l)); return l; }
__device__ __forceinline__ float bf2f(unsigned short b) { return __uint_as_float(((unsigned)b) << 16); }
__device__ __forceinline__ float sigmoidf_(float x) { return __builtin_amdgcn_rcpf(1.0f + __builtin_amdgcn_exp2f(-1.4426950408889634f * x)); }
__device__ __forceinline__ u32x4 pack8u(f32x4 a, f32x4 b) { u32x4 w = {pg8::cvt_pk_bf16(a[0], a[1]), pg8::cvt_pk_bf16(a[2], a[3]), pg8::cvt_pk_bf16(b[0], b[1]), pg8::cvt_pk_bf16(b[2], b[3])}; return w; }
__device__ __forceinline__ void unpack8(u32x4 w, f32x4& a, f32x4& b) {
    a = (f32x4){__uint_as_float(w.x << 16), __uint_as_float(w.x & 0xffff0000u), __uint_as_float(w.y << 16), __uint_as_float(w.y & 0xffff0000u)};
    b = (f32x4){__uint_as_float(w.z << 16), __uint_as_float(w.z & 0xffff0000u), __uint_as_float(w.w << 16), __uint_as_float(w.w & 0xffff0000u)};
}
__device__ __forceinline__ float wave_sum(float v) {
#pragma unroll
    for (int o = 32; o >= 1; o >>= 1) v += __shfl_xor(v, o);
    return v;
}

typedef f32x4 Acc[2][2][4][2];
struct Epi1 { static constexpr bool PERM = true;
    bf16_t* QKV; bf16_t* GATES; const float* rstd;
    __device__ __forceinline__ void operator()(const Acc& acc, const pg8::Unit& u, int wr, int wc, int fr, int fq) const {
        const int row0 = u.pm * 256 + wr * 64 + fr;
        if (u.pn < 24) {
#pragma unroll
            for (int ai = 0; ai < 2; ++ai)
#pragma unroll
                for (int m = 0; m < 4; ++m) { const int row = row0 + ai * 128 + m * 16; const float rs = rstd[row];
#pragma unroll
                    for (int bj = 0; bj < 2; ++bj) { bf16_t* dst = QKV + ((size_t)(2 * u.pn + bj) * M + row) * 128 + wc * 32 + 8 * fq;
                        *(u32x4*)dst = pack8u(acc[ai][bj][m][0] * rs, acc[ai][bj][m][1] * rs); } }
        } else {
            const int colb = (u.pn - 24) * 256 + wc * 32 + 8 * fq;
#pragma unroll
            for (int ai = 0; ai < 2; ++ai)
#pragma unroll
                for (int m = 0; m < 4; ++m) { const int row = row0 + ai * 128 + m * 16; const float rs = rstd[row];
#pragma unroll
                    for (int bj = 0; bj < 2; ++bj) { f32x4 v0 = acc[ai][bj][m][0] * rs, v1 = acc[ai][bj][m][1] * rs;
#pragma unroll
                        for (int j = 0; j < 4; ++j) { v0[j] = sigmoidf_(v0[j]); v1[j] = sigmoidf_(v1[j]); }
                        *(u32x4*)(GATES + (size_t)row * 4096 + colb + bj * 128) = pack8u(v0, v1); } }
        }
    }
};
struct Epi3a { static constexpr bool PERM = true;
    float* TMP; const bf16_t* GATES;
    __device__ __forceinline__ void operator()(const Acc& acc, const pg8::Unit& u, int wr, int wc, int fr, int fq) const {
        const int row0 = u.pm * 256 + wr * 64 + fr, col0 = u.pn * 256 + wc * 32 + 8 * fq;
#pragma unroll
        for (int ai = 0; ai < 2; ++ai)
#pragma unroll
            for (int m = 0; m < 4; ++m) { const int row = row0 + ai * 128 + m * 16;
#pragma unroll
                for (int bj = 0; bj < 2; ++bj) { const int col = col0 + bj * 128; f32x4 g0, g1; unpack8(*(const u32x4*)(GATES + (size_t)row * 4096 + col), g0, g1);
                    float* d = TMP + (size_t)row * DM + col; *(f32x4*)d = acc[ai][bj][m][0] * g0; *(f32x4*)(d + 4) = acc[ai][bj][m][1] * g1; } }
    }
};
struct Epi3b { static constexpr bool PERM = true;
    const float* TMP; const bf16_t* GATES; bf16_t* MERGED;
    __device__ __forceinline__ void operator()(const Acc& acc, const pg8::Unit& u, int wr, int wc, int fr, int fq) const {
        const int row0 = u.pm * 256 + wr * 64 + fr, col0 = u.pn * 256 + wc * 32 + 8 * fq;
#pragma unroll
        for (int ai = 0; ai < 2; ++ai)
#pragma unroll
            for (int m = 0; m < 4; ++m) { const int row = row0 + ai * 128 + m * 16;
#pragma unroll
                for (int bj = 0; bj < 2; ++bj) { const int col = col0 + bj * 128; f32x4 g0, g1; unpack8(*(const u32x4*)(GATES + (size_t)row * 4096 + 2048 + col), g0, g1);
                    const float* s = TMP + (size_t)row * DM + col; const f32x4 t0 = *(const f32x4*)s, t1 = *(const f32x4*)(s + 4);
                    *(u32x4*)(MERGED + (size_t)row * DM + col) = pack8u(t0 + acc[ai][bj][m][0] * g0, t1 + acc[ai][bj][m][1] * g1); } }
    }
};
struct Epi4 { static constexpr bool PERM = true;
    const float* x; float* out; bf16_t* H1B; float* ssq;
    __device__ __forceinline__ void operator()(const Acc& acc, const pg8::Unit& u, int wr, int wc, int fr, int fq) const {
        const int row0 = u.pm * 256 + wr * 64 + fr, col0 = u.pn * 256 + wc * 32 + 8 * fq;
#pragma unroll
        for (int ai = 0; ai < 2; ++ai)
#pragma unroll
            for (int m = 0; m < 4; ++m) { const int row = row0 + ai * 128 + m * 16; const int b = row / LB, vp = row - b * LB;
                if (vp >= 64) { const size_t orow = (size_t)b * SEQ + (vp - 64); float ss = 0.f;
#pragma unroll
                    for (int bj = 0; bj < 2; ++bj) { const int col = col0 + bj * 128; const float* xs = x + orow * DM + col;
                        const f32x4 h0 = *(const f32x4*)xs + acc[ai][bj][m][0], h1 = *(const f32x4*)(xs + 4) + acc[ai][bj][m][1];
                        float* d = out + orow * DM + col; *(f32x4*)d = h0; *(f32x4*)(d + 4) = h1;
                        *(u32x4*)(H1B + (size_t)row * DM + col) = pack8u(h0, h1);
                        ss += (h0[0] * h0[0] + h0[1] * h0[1]) + (h0[2] * h0[2] + h0[3] * h0[3]) + (h1[0] * h1[0] + h1[1] * h1[1]) + (h1[2] * h1[2] + h1[3] * h1[3]); }
                    ss += __shfl_xor(ss, 16); ss += __shfl_xor(ss, 32);
                    if (fq == 0) unsafeAtomicAdd(ssq + row, ss);
                } else { float ss = 0.f; ss += __shfl_xor(ss, 16); ss += __shfl_xor(ss, 32); (void)ss; } }
    }
};
struct Epi5 { static constexpr bool PERM = true;
    const float* ssq; bf16_t* ACT;
    __device__ __forceinline__ void operator()(const Acc& acc, const pg8::Unit& u, int wr, int wc, int fr, int fq) const {
        const int row0 = u.pm * 256 + wr * 64 + fr, col0 = u.pn * 128 + wc * 32 + 8 * fq;
#pragma unroll
        for (int ai = 0; ai < 2; ++ai)
#pragma unroll
            for (int m = 0; m < 4; ++m) { const int row = row0 + ai * 128 + m * 16; const float rs = __builtin_amdgcn_rsqf(ssq[row] * (1.0f / 2048.0f) + 1e-6f);
                f32x4 o[2];
#pragma unroll
                for (int n = 0; n < 2; ++n) { const f32x4 g = acc[ai][0][m][n] * rs, up = acc[ai][1][m][n] * rs;
#pragma unroll
                    for (int j = 0; j < 4; ++j) o[n][j] = g[j] * sigmoidf_(g[j]) * up[j]; }
                *(u32x4*)(ACT + (size_t)row * DFF + col0) = pack8u(o[0], o[1]); }
    }
};
struct Epi6 { static constexpr bool PERM = true;
    float* out; float* ssq;
    __device__ __forceinline__ void operator()(const Acc& acc, const pg8::Unit& u, int wr, int wc, int fr, int fq) const {
        const int row0 = u.pm * 256 + wr * 64 + fr, col0 = u.pn * 256 + wc * 32 + 8 * fq;
#pragma unroll
        for (int ai = 0; ai < 2; ++ai)
#pragma unroll
            for (int m = 0; m < 4; ++m) { const int row = row0 + ai * 128 + m * 16; const int b = row / LB, vp = row - b * LB;
                if (vp >= 64) { const size_t orow = (size_t)b * SEQ + (vp - 64); float ss = 0.f;
#pragma unroll
                    for (int bj = 0; bj < 2; ++bj) { const int col = col0 + bj * 128; float* d = out + orow * DM + col;
                        const f32x4 h0 = *(const f32x4*)d + acc[ai][bj][m][0], h1 = *(const f32x4*)(d + 4) + acc[ai][bj][m][1];
                        *(f32x4*)d = h0; *(f32x4*)(d + 4) = h1;
                        ss += (h0[0] * h0[0] + h0[1] * h0[1]) + (h0[2] * h0[2] + h0[3] * h0[3]) + (h1[0] * h1[0] + h1[1] * h1[1]) + (h1[2] * h1[2] + h1[3] * h1[3]); }
                    ss += __shfl_xor(ss, 16); ss += __shfl_xor(ss, 32);
                    if (fq == 0) unsafeAtomicAdd(ssq + row, ss);
                } else { float ss = 0.f; ss += __shfl_xor(ss, 16); ss += __shfl_xor(ss, 32); (void)ss; } }
    }
};

namespace att {
constexpr int D = 128, NW = 8, QBLK = 32, KVBLK = 64, QB = 256;
constexpr int SHM_V = KVBLK * D * 2, SHM_K = KVBLK * D * 2;
constexpr int LDS_WS = 2 * SHM_V + 2 * SHM_K;
constexpr int LDS_TAB = LDS_WS + NW * 64 * 4;
constexpr float SCALE = 0.08838834764831845f;
constexpr float THR = 8.f;
#define KSWZ(row, colB) ((row) * 256 + ((colB) ^ (((row) & 7) << 4)))
#define SBAR() __builtin_amdgcn_sched_barrier(0)
__device__ __forceinline__ int v_st(int k, int c) { const int kk = (k & ~0xC) | ((k & 4) << 1) | ((k & 8) >> 1); return ((kk >> 3) * 4 + (c >> 5)) * 512 + ((kk & 7) * 32 + (c & 31)) * 2; }
__device__ __forceinline__ int v_rd_base(int lane) { return ((lane & 3) << 3) | (((lane >> 2) & 3) << 6) | (((lane >> 4) & 1) << 5) | (((lane >> 5) & 1) << 8); }
constexpr int v_rd_off(int d0, int ks, int half) { return d0 * 512 + ks * 4096 + half * 2048; }
__device__ __forceinline__ int crow(int r, int hi) { return (r & 3) + 8 * (r >> 2) + 4 * hi; }
__device__ __forceinline__ unsigned cvtpk(float lo, float hi) { unsigned r; asm volatile("v_cvt_pk_bf16_f32 %0, %1, %2" : "=v"(r) : "v"(lo), "v"(hi)); return r; }
__device__ __forceinline__ bf16x8 load8(const bf16_t* p) { return *reinterpret_cast<const bf16x8*>(p); }
__device__ __forceinline__ void mask_tile(f32x16& p0, f32x16& p1, int dqe, int dqt, unsigned W, float s2) {
    const float NEG = -__builtin_inff();
#pragma unroll
    for (int r = 0; r < 16; ++r) {
        const int c = (r & 3) + 8 * (r >> 2);
        const int a0 = c - dqt, a1 = c + 32 - dqt;
        p0[r] -= s2 * (float)(a0 > 0 ? a0 : 0);
        p1[r] -= s2 * (float)(a1 > 0 ? a1 : 0);
        if ((unsigned)(dqe - c) >= W) p0[r] = NEG;
        if ((unsigned)(dqe - c - 32) >= W) p1[r] = NEG;
    }
}
__device__ __forceinline__ void partialSM(f32x16& p0, f32x16& p1, float& m_reg, float& mn, float& alpha) {
    float pmax = p0[0]; for (int r = 1; r < 16; ++r) pmax = fmaxf(pmax, p0[r]); for (int r = 0; r < 16; ++r) pmax = fmaxf(pmax, p1[r]);
    { auto rr = __builtin_amdgcn_permlane32_swap(__float_as_uint(pmax), __float_as_uint(pmax), false, false);
      pmax = fmaxf(__uint_as_float(rr[0]), __uint_as_float(rr[1])); }
    constexpr float C2 = 1.4426950408889634f * SCALE;
    if (__builtin_expect(__all((pmax - m_reg) * SCALE <= THR), 1)) { mn = m_reg; alpha = 1.f; }
    else { mn = fmaxf(m_reg, pmax); alpha = __builtin_amdgcn_exp2f((m_reg - mn) * C2); m_reg = mn; }
    const float mnL = -mn * C2;
    for (int r = 0; r < 16; ++r) p0[r] = fmaf(p0[r], C2, mnL); for (int r = 0; r < 16; ++r) p1[r] = fmaf(p1[r], C2, mnL);
    for (int r = 0; r < 16; ++r) p0[r] = __builtin_amdgcn_exp2f(p0[r]);
}
__device__ __forceinline__ void finishSM(f32x16& p0, f32x16& p1, float alpha, float& l_reg, bf16x8& pa0, bf16x8& pa1, bf16x8& pa2, bf16x8& pa3) {
    for (int r = 0; r < 16; ++r) p1[r] = __builtin_amdgcn_exp2f(p1[r]);
    float ps = 0; for (int r = 0; r < 16; ++r) ps += p0[r]; for (int r = 0; r < 16; ++r) ps += p1[r];
    { auto rr = __builtin_amdgcn_permlane32_swap(__float_as_uint(ps), __float_as_uint(ps), false, false);
      ps = __uint_as_float(rr[0]) + __uint_as_float(rr[1]); }
    l_reg = l_reg * alpha + ps;
#define PK4(P, B_, OUT) do { unsigned a0 = cvtpk(P[B_+0], P[B_+1]), a1 = cvtpk(P[B_+2], P[B_+3]);                          \
        unsigned b0 = cvtpk(P[B_+4], P[B_+5]), b1 = cvtpk(P[B_+6], P[B_+7]);                                             \
        auto r0 = __builtin_amdgcn_permlane32_swap(a0, b0, false, false); auto r1 = __builtin_amdgcn_permlane32_swap(a1, b1, false, false); \
        u32x4 w = {r0[0], r1[0], r0[1], r1[1]}; OUT = *reinterpret_cast<bf16x8*>(&w); } while (0)
    PK4(p0, 0, pa0); PK4(p0, 8, pa1); PK4(p1, 0, pa2); PK4(p1, 8, pa3);
#undef PK4
}
template <int KB>
__device__ __forceinline__ void qkt(f32x16& p0, f32x16& p1, const char* K_lds, int r32, int hi, const bf16x8* qr) {
    p0 = f32x16{}; p1 = f32x16{};
    const char* kb[4];
#pragma unroll
    for (int dd = 0; dd < 4; ++dd) kb[dd] = K_lds + KB * SHM_K + KSWZ(r32, (dd * 16 + hi * 8) * 2);
#pragma unroll
    for (int d0 = 0; d0 < 8; ++d0) { const char* a = kb[d0 & 3] + (d0 >> 2) * 128;
        bf16x8 b0 = *reinterpret_cast<const bf16x8*>(a);
        bf16x8 b1 = *reinterpret_cast<const bf16x8*>(a + 32 * 256);
        p0 = __builtin_amdgcn_mfma_f32_32x32x16_bf16(b0, qr[d0], p0, 0, 0, 0);
        p1 = __builtin_amdgcn_mfma_f32_32x32x16_bf16(b1, qr[d0], p1, 0, 0, 0); }
}
template <int VB>
__device__ __forceinline__ void pv_tile(f32x16* o, int vb0, bf16x8 pa0, bf16x8 pa1, bf16x8 pa2, bf16x8 pa3) {
#define TRRD(dst, off) asm volatile("ds_read_b64_tr_b16 %0, %1 offset:%2" : "=&v"(dst) : "v"(vb0), "i"(off) : "memory")
#define PV_D0(d0) do { s16x4 l0, l1, l2, l3, h0, h1, h2, h3; constexpr int b_ = VB * SHM_V + v_rd_off(d0, 0, 0); \
        TRRD(l0, b_); TRRD(h0, b_ + 2048); TRRD(l1, b_ + 4096); TRRD(h1, b_ + 6144); TRRD(l2, b_ + 8192); TRRD(h2, b_ + 10240); TRRD(l3, b_ + 12288); TRRD(h3, b_ + 14336); \
        asm volatile("s_waitcnt lgkmcnt(0)" ::: "memory"); SBAR();   \
        o[d0] = __builtin_amdgcn_mfma_f32_32x32x16_bf16(pa0, (bf16x8){l0[0], l0[1], l0[2], l0[3], h0[0], h0[1], h0[2], h0[3]}, o[d0], 0, 0, 0);   \
        o[d0] = __builtin_amdgcn_mfma_f32_32x32x16_bf16(pa1, (bf16x8){l1[0], l1[1], l1[2], l1[3], h1[0], h1[1], h1[2], h1[3]}, o[d0], 0, 0, 0);   \
        o[d0] = __builtin_amdgcn_mfma_f32_32x32x16_bf16(pa2, (bf16x8){l2[0], l2[1], l2[2], l2[3], h2[0], h2[1], h2[2], h2[3]}, o[d0], 0, 0, 0);   \
        o[d0] = __builtin_amdgcn_mfma_f32_32x32x16_bf16(pa3, (bf16x8){l3[0], l3[1], l3[2], l3[3], h3[0], h3[1], h3[2], h3[3]}, o[d0], 0, 0, 0); } while (0)
    PV_D0(0); PV_D0(1); PV_D0(2); PV_D0(3);
#undef PV_D0
#undef TRRD
}
struct Blk { const bf16_t* Q; const bf16_t* K; const bf16_t* V; bf16_t* O; int P0; int mode; float s2; };
struct Seam { bf16x8 qr[8]; bf16x8 st_v0, st_v1, st_k0, st_k1; };
#define ROW(p, k0, rr) ((p) + (size_t)((k0) + (rr)) * D + sc)
#define VMW() asm volatile("s_waitcnt vmcnt(0)" ::: "memory")
#define VMWN(n) asm volatile("s_waitcnt vmcnt(%0)" :: "i"(n) : "memory")
#define SLOAD_H(Kp, Vp, k0) do { S.st_v0 = load8(ROW(Vp, k0, sr)); S.st_v1 = load8(ROW(Vp, k0, 32 + sr));              \
                         S.st_k0 = load8(ROW(Kp, k0, sr)); S.st_k1 = load8(ROW(Kp, k0, 32 + sr)); } while (0)
#define SWRITE_HK(bf) do { *(bf16x8*)(K_lds + (bf) * SHM_K + kws) = S.st_k0; *(bf16x8*)(K_lds + (bf) * SHM_K + kws + 32 * 256) = S.st_k1; } while (0)
#define SWRITE_HV(bf) do { *(bf16x8*)(V_lds + (bf) * SHM_V + vst0) = S.st_v0; *(bf16x8*)(V_lds + (bf) * SHM_V + vst1) = S.st_v1; } while (0)
#define SWRITE_H(bf) do { SWRITE_HV(bf); SWRITE_HK(bf); } while (0)
__device__ __forceinline__ void attn_prime(const Blk& cur, char* lds, Seam& S, const int tid) {
    const int wid = __builtin_amdgcn_readfirstlane(tid >> 6), lane = tid & 63, r32 = lane & 31, hi = lane >> 5;
    const int sr = tid >> 4, sc = (tid & 15) * 8, kws = KSWZ(sr, sc * 2); char* K_lds = lds + 2 * SHM_V;
    for (int d0 = 0; d0 < 8; ++d0) S.qr[d0] = load8(cur.Q + (size_t)(wid * QBLK + r32) * D + d0 * 16 + hi * 8);
    SLOAD_H(cur.K, cur.V, 0); VMW(); SWRITE_HK(0);
    __syncthreads();
}
__device__ __forceinline__ void attn_block(const Blk& cur, const Blk& nxt, char* lds, Seam& S, float lam, float* scrT, float* scrD, const float* g_subln, const int tid) {
    const int wid = __builtin_amdgcn_readfirstlane(tid >> 6), lane = tid & 63, r32 = lane & 31, hi = lane >> 5;
    const int NT = (cur.P0 + QB - 1) / KVBLK + 1;
    const int qlo = cur.P0 + wid * QBLK;
    const int qt4 = qlo + r32 - 4 * hi;
    const bool isdiff = cur.mode != 0;
    char* V_lds = lds; char* K_lds = lds + 2 * SHM_V;
    float* ws = (float*)(lds + LDS_WS) + wid * 64; float* li_l = ws, * al_l = ws + 32;
    float m_reg = -1e30f, l_reg = 0; f32x16 o[4] = {};
    const int sr = tid >> 4, sc = (tid & 15) * 8, vst0 = v_st(sr, sc), vst1 = v_st(32 + sr, sc), kws = KSWZ(sr, sc * 2);
    const int vb0 = (int)(uintptr_t)V_lds + v_rd_base(lane);
    const bf16_t* Kh = cur.K; const bf16_t* Vh = cur.V;
#define RESC(a) do { if (__any((a) < 1.f)) { if (hi == 0) al_l[r32] = (a); asm volatile("s_waitcnt lgkmcnt(0)" ::: "memory");              \
                     for (int d_ = 0; d_ < 4; ++d_) for (int r = 0; r < 16; ++r) o[d_][r] *= al_l[crow(r, hi)]; } } while (0)
#define KBASE(t) ((t) * KVBLK)
#define BIAS(P0_, P1_, t) do { int h_ = hi; asm volatile("" : "+v"(h_)); const float* tb_ = (const float*)(lds + LDS_TAB) + (4 * h_ + KBASE(t));         \
        _Pragma("unroll") for (int i_ = 0; i_ < 4; ++i_) { const f32x4 b0_ = *(const f32x4*)(tb_ + 8 * i_), b1_ = *(const f32x4*)(tb_ + 32 + 8 * i_); \
            _Pragma("unroll") for (int j_ = 0; j_ < 4; ++j_) { P0_[4 * i_ + j_] += b0_[j_]; P1_[4 * i_ + j_] += b1_[j_]; } } } while (0)
#define MASKT(P0_, P1_, t) do { const int kb_ = KBASE(t); BIAS(P0_, P1_, t); if (kb_ + KVBLK - 1 > qlo || kb_ == 0) { int q_ = qt4; asm volatile("" : "+v"(q_)); const int qt_ = q_ + 4 * hi, qe_ = isdiff ? (qt_ | 63) : qt_;      \
            mask_tile(P0_, P1_, qe_ - kb_ - 4 * hi, q_ - kb_, (unsigned)(qe_ - 47), cur.s2); } } while (0)
#define SEAM_K0() do { VMWN(8); SWRITE_HK(0); SBAR(); } while (0)
    f32x16 pA0, pA1, pB0, pB1; float mnA, mnB, alA, alB; bf16x8 pa0, pa1, pa2, pa3;
    SWRITE_HV(0); SBAR();
    if (NT > 1) { SLOAD_H(Kh, Vh, KBASE(1)); }
    SBAR(); qkt<0>(pA0, pA1, K_lds, r32, hi, S.qr);
    MASKT(pA0, pA1, 0); partialSM(pA0, pA1, m_reg, mnA, alA);
    if (NT > 1) { VMW(); SWRITE_H(1); }
    __syncthreads();
#define HALF_STEP(PX0, PX1, mnX, alX, PY0, PY1, alY, t, KB, VB, SB_) do {                                                      \
        SBAR(); qkt<KB>(PX0, PX1, K_lds, r32, hi, S.qr);                                             \
        finishSM(PY0, PY1, alY, l_reg, pa0, pa1, pa2, pa3); SBAR();                                                           \
        if ((t) + 1 < NT) { SLOAD_H(Kh, Vh, KBASE((t) + 1)); SBAR(); }                                               \
        pv_tile<VB>(o, vb0, pa0, pa1, pa2, pa3); MASKT(PX0, PX1, (t)); partialSM(PX0, PX1, m_reg, mnX, alX);                                        \
        __syncthreads();                                                                                                      \
        if ((t) + 1 < NT) { VMW(); SWRITE_H(SB_); }                                                                          \
        RESC(alX); __syncthreads(); } while (0)
    for (int t = 1; t + 1 < NT; t += 2) {
        HALF_STEP(pB0, pB1, mnB, alB, pA0, pA1, alA, t, 1, 0, 0);
        HALF_STEP(pA0, pA1, mnA, alA, pB0, pB1, alB, t + 1, 0, 1, 1);
    }
    const bool even = (NT & 1) == 0;
    if (even) { SBAR(); qkt<1>(pB0, pB1, K_lds, r32, hi, S.qr); SBAR(); }
    { int t2 = tid; asm volatile("" : "+v"(t2));
      const int sr2 = t2 >> 4, sc2 = (t2 & 15) * 8, l2 = t2 & 63;
      const unsigned off = (unsigned)(sr2 * D + sc2);
      S.st_v0 = load8(nxt.V + off); S.st_v1 = load8(nxt.V + off + 32 * D); S.st_k0 = load8(nxt.K + off); S.st_k1 = load8(nxt.K + off + 32 * D); SBAR();
      const unsigned qoff = (unsigned)((wid * QBLK + (l2 & 31)) * D + (l2 >> 5) * 8);
#pragma unroll
      for (int d0 = 0; d0 < 8; ++d0) S.qr[d0] = load8(nxt.Q + qoff + d0 * 16); }
    SBAR();
    finishSM(pA0, pA1, alA, l_reg, pa0, pa1, pa2, pa3); SBAR();
    pv_tile<0>(o, vb0, pa0, pa1, pa2, pa3);
    if (even) { MASKT(pB0, pB1, NT - 1); partialSM(pB0, pB1, m_reg, mnB, alB); __syncthreads(); RESC(alB);
        finishSM(pB0, pB1, alB, l_reg, pa0, pa1, pa2, pa3); SBAR(); pv_tile<1>(o, vb0, pa0, pa1, pa2, pa3); }
    SBAR(); SEAM_K0();
    int ln = lane; asm volatile("" : "+v"(ln));
    const int r32e = ln & 31;
    if (hi == 0) li_l[r32] = l_reg; asm volatile("s_waitcnt lgkmcnt(0)" ::: "memory");
    float rli[16];
#pragma unroll
    for (int r = 0; r < 16; ++r) rli[r] = __builtin_amdgcn_rcpf(li_l[crow(r, hi)]);
    const int mode = cur.mode;
    if (mode == 0) {
        bf16_t* Ow = cur.O + (size_t)(wid * QBLK) * 1024;
#pragma unroll
        for (int r = 0; r < 16; ++r) { const int orow = crow(r, hi);
#pragma unroll
            for (int d0 = 0; d0 < 4; ++d0) { const float v = o[d0][r] * rli[r]; const float vn = __shfl_xor(v, 1);
                if ((r32e & 1) == 0) *(unsigned*)(Ow + (orow * 1024 + d0 * 32 + r32e)) = cvtpk(v, vn); } }
    } else if (mode == 1) {
        float* T = scrT + (wid * 4096 + ln);
#pragma unroll
        for (int r = 0; r < 16; ++r)
#pragma unroll
            for (int d0 = 0; d0 < 4; ++d0) T[(r * 4 + d0) * 64] = o[d0][r] * rli[r];
    } else {
        const float* T = scrT + (wid * 4096 + ln); float* Dl = scrD + (wid * 4096 + ln);
#pragma unroll
        for (int r = 0; r < 16; ++r)
#pragma unroll
            for (int d0 = 0; d0 < 4; ++d0) o[d0][r] = __hip_atomic_load(T + (r * 4 + d0) * 64, __ATOMIC_RELAXED, __HIP_MEMORY_SCOPE_AGENT) - lam * (o[d0][r] * rli[r]);
        if (mode == 2) {
#pragma unroll
            for (int r = 0; r < 16; ++r)
#pragma unroll
                for (int d0 = 0; d0 < 4; ++d0) Dl[(r * 4 + d0) * 64] = o[d0][r];
        } else {
            bf16_t* Ow = cur.O + (size_t)(wid * QBLK) * 1024;
            float gs0[4], gs1[4];
#pragma unroll
            for (int d0 = 0; d0 < 4; ++d0) { gs0[d0] = g_subln[d0 * 32 + r32e] * 0.8f; gs1[d0] = g_subln[128 + d0 * 32 + r32e] * 0.8f; }
#pragma unroll
            for (int r = 0; r < 16; ++r) { const int orow = crow(r, hi);
                float e0[4]; float ss = 0.f;
#pragma unroll
                for (int d0 = 0; d0 < 4; ++d0) { e0[d0] = __hip_atomic_load(Dl + (r * 4 + d0) * 64, __ATOMIC_RELAXED, __HIP_MEMORY_SCOPE_AGENT); ss += e0[d0] * e0[d0] + o[d0][r] * o[d0][r]; }
                ss += __shfl_xor(ss, 1); ss += __shfl_xor(ss, 2); ss += __shfl_xor(ss, 4); ss += __shfl_xor(ss, 8); ss += __shfl_xor(ss, 16);
                const float rn = __builtin_amdgcn_rsqf(ss * (1.0f / 256.0f) + 1e-5f);
#pragma unroll
                for (int d0 = 0; d0 < 4; ++d0) { const float v0 = e0[d0] * rn * gs0[d0], v1 = o[d0][r] * rn * gs1[d0]; const float v0n = __shfl_xor(v0, 1), v1n = __shfl_xor(v1, 1);
                    if ((r32e & 1) == 0) { *(unsigned*)(Ow + (orow * 1024 + d0 * 32 + r32e)) = cvtpk(v0, v0n); *(unsigned*)(Ow + (orow * 1024 + 128 + d0 * 32 + r32e)) = cvtpk(v1, v1n); } }
                asm volatile("" ::: "memory"); }
        }
    }
    __syncthreads();
#undef RESC
#undef KBASE
#undef BIAS
#undef MASKT
#undef SEAM_K0
#undef HALF_STEP
}
#undef ROW
#undef VMW
#undef VMWN
#undef SLOAD_H
#undef SWRITE_HK
#undef SWRITE_HV
#undef SWRITE_H
}

struct Params { const float* in[18]; float* out; unsigned char* ws; int ph_lo, ph_hi; };

__device__ __forceinline__ void transpose_job(const float* __restrict__ src, int ld, int col0, int nN, int Kdim, bf16_t* __restrict__ dst, int up, const float* __restrict__ scale, float* tile, const int tid) {
    const int nK = Kdim / 64, total = nK * nN;
    f32x4 v[2];
    int t = blockIdx.x;
    if (t < total) { const int k0 = (t / nN) * 64, n0 = (t % nN) * 64;
#pragma unroll
        for (int i = 0; i < 2; ++i) { const int idx = tid + 512 * i, kk = idx >> 4, c4 = idx & 15; v[i] = *(const f32x4*)(src + (size_t)(k0 + kk) * ld + col0 + n0 + c4 * 4) * (scale ? scale[k0 + kk] : 1.0f); } }
    for (; t < total; t += gridDim.x) {
        const int k0 = (t / nN) * 64, n0 = (t % nN) * 64;
#pragma unroll
        for (int i = 0; i < 2; ++i) { const int idx = tid + 512 * i, kk = idx >> 4, c4 = idx & 15;
#pragma unroll
            for (int j = 0; j < 4; ++j) tile[kk * 65 + c4 * 4 + j] = v[i][j]; }
        const int tn = t + gridDim.x;
        if (tn < total) { const int k1 = (tn / nN) * 64, n1 = (tn % nN) * 64;
#pragma unroll
            for (int i = 0; i < 2; ++i) { const int idx = tid + 512 * i, kk = idx >> 4, c4 = idx & 15; v[i] = *(const f32x4*)(src + (size_t)(k1 + kk) * ld + col0 + n1 + c4 * 4) * (scale ? scale[k1 + kk] : 1.0f); } }
        __syncthreads();
        { const int n = tid >> 3, kc = (tid & 7) * 8; f32x4 a, b;
#pragma unroll
            for (int j = 0; j < 4; ++j) { a[j] = tile[(kc + j) * 65 + n]; b[j] = tile[(kc + 4 + j) * 65 + n]; }
            const int drow = (up < 0) ? (n0 + n) : (256 * (n0 >> 7) + (n0 & 127) + up * 128 + n);
            *(u32x4*)(dst + (size_t)drow * Kdim + k0 + kc) = pack8u(a, b); }
        __syncthreads();
    }
}

__global__ void __launch_bounds__(512, 2) fwd_kernel(Params p) {
    extern __shared__ __attribute__((aligned(16))) unsigned char lds[];
    cg::grid_group grid = cg::this_grid();
    const int wid = __builtin_amdgcn_readfirstlane(threadIdx.x >> 6), G = gridDim.x, bx = blockIdx.x;
    unsigned char* ws = p.ws;
    bf16_t* W1T = (bf16_t*)(ws + WS_W1T); bf16_t* WAT = (bf16_t*)(ws + WS_WAT); bf16_t* WFT = (bf16_t*)(ws + WS_WFT); bf16_t* WOT = (bf16_t*)(ws + WS_WOT);
    bf16_t* W5T = (bf16_t*)(ws + WS_W5T); bf16_t* WDT = (bf16_t*)(ws + WS_WDT);
    bf16_t* XB = (bf16_t*)(ws + WS_RA); bf16_t* OA = (bf16_t*)(ws + WS_RA); bf16_t* OF = (bf16_t*)(ws + WS_RA + (size_t)M * 1024 * 2); bf16_t* H1B = (bf16_t*)(ws + WS_RA);
    bf16_t* QKV = (bf16_t*)(ws + WS_RB); float* TMP = (float*)(ws + WS_RB); bf16_t* MERGED = (bf16_t*)(ws + WS_RB + (size_t)M * DM * 4); bf16_t* ACT = (bf16_t*)(ws + WS_RB);
    bf16_t* GATES = (bf16_t*)(ws + WS_RG);
    float* RSTD1 = (float*)(ws + WS_RSTD1); float* SSQ2 = (float*)(ws + WS_SSQ2); float* SSQ3 = (float*)(ws + WS_SSQ3);
    float* LOGF = (float*)(ws + WS_LOGF); float* CUM = (float*)(ws + WS_CUM);
    const int lo = p.ph_lo, hi_ = p.ph_hi;
#define IN(k) (lo <= (k) && (k) < hi_)
#define SEAM(k) do { if (IN(k) && IN((k) + 1)) grid.sync(); } while (0)

    if (IN(0)) {
        const int lane = fresh_lane(), tid = wid * 64 + lane;
        float* tile = (float*)lds;
        const float* w_in = p.in[3];
        transpose_job(w_in, NINC, 0, 96, DM, W1T, -1, p.in[2], tile, tid);
        transpose_job(w_in, NINC, 6152, 64, DM, W1T + (size_t)6144 * DM, -1, p.in[2], tile, tid);
        transpose_job(p.in[10], DM, 0, 32, 1024, WAT, -1, nullptr, tile, tid);
        transpose_job(p.in[11], DM, 0, 32, 1024, WFT, -1, nullptr, tile, tid);
        transpose_job(p.in[12], DM, 0, 32, DM, WOT, -1, nullptr, tile, tid);
        transpose_job(p.in[14], DFF, 0, 88, DM, W5T, 0, p.in[13], tile, tid);
        transpose_job(p.in[15], DFF, 0, 88, DM, W5T, 1, p.in[13], tile, tid);
        transpose_job(p.in[16], DM, 0, 32, DFF, WDT, -1, nullptr, tile, tid);
        float* WF = (float*)lds;
        for (int k = tid; k < DM; k += 512) { const float g = p.in[2][k]; const f32x4 a = *(const f32x4*)(w_in + (size_t)k * NINC + 6144), b = *(const f32x4*)(w_in + (size_t)k * NINC + 6148);
#pragma unroll
            for (int j = 0; j < 4; ++j) { WF[j * DM + k] = a[j] * g; WF[(4 + j) * DM + k] = b[j] * g; } }
        __syncthreads();
        const float* x = p.in[0]; const float* meta = p.in[1]; const float* b_f = p.in[9];
        for (int row = bx * 8 + wid; row < M; row += G * 8) {
            const int b = row / LB, vp = row - b * LB;
            const float* src = vp >= 64 ? x + ((size_t)b * SEQ + (vp - 64)) * DM : meta + (size_t)(vp >= VPAD ? vp - VPAD : 0) * DM;
            f32x4 v[8]; float ss = 0.f; float zf[8];
#pragma unroll
            for (int j = 0; j < 8; ++j) zf[j] = 0.f;
#pragma unroll
            for (int i = 0; i < 8; ++i) { v[i] = *(const f32x4*)(src + i * 256 + lane * 4); if (vp < VPAD) v[i] = (f32x4){0.f, 0.f, 0.f, 0.f};
                ss += (v[i][0] * v[i][0] + v[i][1] * v[i][1]) + (v[i][2] * v[i][2] + v[i][3] * v[i][3]); }
#pragma unroll
            for (int i = 0; i < 8; ++i) {
                u32x2 w; w.x = pg8::cvt_pk_bf16(v[i][0], v[i][1]); w.y = pg8::cvt_pk_bf16(v[i][2], v[i][3]);
                *(u32x2*)(XB + (size_t)row * DM + i * 256 + lane * 4) = w;
#pragma unroll
                for (int j = 0; j < 8; ++j) { const f32x4 wv = *(const f32x4*)(WF + j * DM + i * 256 + lane * 4); zf[j] += (v[i][0] * wv[0] + v[i][1] * wv[1]) + (v[i][2] * wv[2] + v[i][3] * wv[3]); } }
            ss = wave_sum(ss);
#pragma unroll
            for (int j = 0; j < 8; ++j) zf[j] = wave_sum(zf[j]);
            const float rs = __builtin_amdgcn_rsqf(ss * (1.0f / 2048.0f) + 1e-6f);
            if (lane == 0) { RSTD1[row] = rs; SSQ2[row] = 0.f; SSQ3[row] = 0.f; }
            if (lane < 8) { float zz = zf[0];
#pragma unroll
                for (int j = 1; j < 8; ++j) zz = (lane == j) ? zf[j] : zz;
                const float y = zz * rs + b_f[lane];
                const float lf = fminf(y, 0.f) - log1pf(__expf(-fabsf(y)));
                LOGF[(size_t)(b * 8 + lane) * LB + vp] = vp >= VPAD ? lf : 0.f; }
        }
        __syncthreads();
    }
    SEAM(0);

    if (IN(1)) {
        const int lane = fresh_lane(), tid = wid * 64 + lane;
        if (bx < 32) {
            const float* srcp = LOGF + (size_t)bx * LB; float* dstp = CUM + (size_t)bx * LB; float* red = (float*)lds;
            const int i0 = tid * 17; float vals[17]; float s = 0.f;
#pragma unroll
            for (int i = 0; i < 17; ++i) { const int k = i0 + i; vals[i] = k < LB ? srcp[k] : 0.f; s += vals[i]; vals[i] = s; }
            float incl = s;
#pragma unroll
            for (int o = 1; o < 64; o <<= 1) { const float t = __shfl_up(incl, o); if (lane >= o) incl += t; }
            if (lane == 63) red[wid] = incl;
            __syncthreads();
            float base = incl - s;
            for (int w = 0; w < wid; ++w) base += red[w];
#pragma unroll
            for (int i = 0; i < 17; ++i) { const int k = i0 + i; if (k < LB) dstp[k] = (base + vals[i]) * 11.313708498984761f; }
            __syncthreads();
        }
        pg8::Gemm g{XB, W1T, M, N1, DM}; pg8::StaticOrder S; S.init(M, N1, G, bx);
        Epi1 E{QKV, GATES, RSTD1};
        pg8::gemm_phase<Epi1, pg8::StaticOrder>((PG8_LAS unsigned char*)lds, g, S, E, wid * 64 + fresh_lane());
    }
    SEAM(1);

    if (IN(2)) {
        const int lane = fresh_lane(), tid = wid * 64 + lane;
        float lam;
        { const float* q1 = p.in[4]; const float* k1 = p.in[5]; const float* q2 = p.in[6]; const float* k2 = p.in[7];
          float s1 = q1[lane] * k1[lane] + q1[lane + 64] * k1[lane + 64], s2 = q2[lane] * k2[lane] + q2[lane + 64] * k2[lane + 64];
          s1 = wave_sum(s1); s2 = wave_sum(s2); lam = __expf(s1) - __expf(s2) + 0.2f; lam = __uint_as_float(__builtin_amdgcn_readfirstlane(__float_as_uint(lam))); }
        const float* g_subln = p.in[8];
        float* scrT = (float*)(ws + WS_SCR + (size_t)bx * 262144); float* scrD = scrT + 32768;
        float* tabw = (float*)(lds + att::LDS_TAB);
        const int vcu = (G % 8 == 0) ? (bx % 8) * (G / 8) + bx / 8 : bx;
        const int nsi = (256 - vcu + G - 1) / G;
        const int nbp = nsi * 12;
        auto desc = [&](int bp) -> att::Blk {
            const int s = vcu + (bp / 12) * G, idx = bp % 12; att::Blk r;
            if (idx < 4) { const int pr = 2 * s + (idx >> 1), bh = pr >> 4, y = pr & 15, qb = (idx & 1) ? 31 - y : y, b = bh >> 3, h = bh & 7;
                const size_t rb = (size_t)b * LB; r.P0 = 64 + 256 * qb; r.mode = 0; r.s2 = 0.f;
                r.Q = QKV + ((size_t)(24 + h) * M + rb + r.P0) * 128; r.K = QKV + ((size_t)(32 + h) * M + rb) * 128; r.V = QKV + ((size_t)(40 + h) * M + rb) * 128;
                r.O = OF + (rb + r.P0) * 1024 + h * 128; }
            else { const int j = idx - 4, sel = j >> 2, pass = j & 3, e = pass >> 1, c = pass & 1, bh = s >> 4, y = s & 15, qb = sel ? 31 - y : y, b = bh >> 2, h = bh & 3;
                const size_t rb = (size_t)b * LB; r.P0 = 64 + 256 * qb; r.mode = (c == 0) ? 1 : (e == 0 ? 2 : 3);
                r.s2 = 2.0f * 11.313708498984761f * (h == 0 ? 0.25f : h == 1 ? 0.0625f : h == 2 ? 0.015625f : 0.00390625f);
                r.Q = QKV + ((size_t)(2 * h + c) * M + rb + r.P0) * 128; r.K = QKV + ((size_t)(8 + 2 * h + c) * M + rb) * 128; r.V = QKV + ((size_t)(16 + 2 * h + e) * M + rb) * 128;
                r.O = OA + (rb + r.P0) * 1024 + h * 256; }
            return r; };
        if (nbp > 0) {
            att::Seam S;
            att::Blk cur = desc(0);
            att::attn_prime(cur, (char*)lds, S, wid * 64 + fresh_lane());
            for (int bp = 0; bp < nbp; ++bp) {
                const att::Blk nxt = desc(bp + 1 < nbp ? bp + 1 : bp);
                { const int s = vcu + (bp / 12) * G, idx = bp % 12; const int nk = cur.P0 + 256; const int tt = wid * 64 + fresh_lane();
                  if (idx < 4) { const int pr = 2 * s + (idx >> 1), bh = pr >> 4; const float* cm = CUM + (size_t)bh * LB; const float cref = cm[cur.P0];
                      for (int k = tt; k < nk; k += 512) tabw[k] = cref - cm[k]; }
                  else { const float sl = 0.5f * cur.s2; for (int k = tt; k < nk; k += 512) tabw[k] = sl * (float)(k - cur.P0); } }
                __syncthreads();
                att::attn_block(cur, nxt, (char*)lds, S, lam, scrT, scrD, g_subln, wid * 64 + fresh_lane());
                cur = nxt;
            }
        }
        asm volatile("s_waitcnt vmcnt(0)" ::: "memory");
        __syncthreads();
    }
    SEAM(2);

    if (IN(3)) {
        { pg8::Gemm g{OA, WAT, M, DM, 1024}; pg8::StaticOrder S; S.init(M, DM, G, bx); Epi3a E{TMP, GATES};
          pg8::gemm_phase<Epi3a, pg8::StaticOrder>((PG8_LAS unsigned char*)lds, g, S, E, wid * 64 + fresh_lane()); }
        { pg8::Gemm g{OF, WFT, M, DM, 1024}; pg8::StaticOrder S; S.init(M, DM, G, bx); Epi3b E{TMP, GATES, MERGED};
          pg8::gemm_phase<Epi3b, pg8::StaticOrder>((PG8_LAS unsigned char*)lds, g, S, E, wid * 64 + fresh_lane()); }
    }
    SEAM(3);

    if (IN(4)) {
        pg8::Gemm g{MERGED, WOT, M, DM, DM}; pg8::StaticOrder S; S.init(M, DM, G, bx); Epi4 E{p.in[0], p.out, H1B, SSQ2};
        pg8::gemm_phase<Epi4, pg8::StaticOrder>((PG8_LAS unsigned char*)lds, g, S, E, wid * 64 + fresh_lane());
    }
    SEAM(4);

    if (IN(5)) {
        pg8::Gemm g{H1B, W5T, M, N5, DM}; pg8::StaticOrder S; S.init(M, N5, G, bx); Epi5 E{SSQ2, ACT};
        pg8::gemm_phase<Epi5, pg8::StaticOrder>((PG8_LAS unsigned char*)lds, g, S, E, wid * 64 + fresh_lane());
    }
    SEAM(5);

    if (IN(6)) {
        pg8::Gemm g{ACT, WDT, M, DM, DFF}; pg8::StaticOrder S; S.init(M, DM, G, bx); Epi6 E{p.out, SSQ3};
        pg8::gemm_phase<Epi6, pg8::StaticOrder>((PG8_LAS unsigned char*)lds, g, S, E, wid * 64 + fresh_lane());
    }
    SEAM(6);

    if (IN(7)) {
        const int lane = fresh_lane();
        const float* gfin = p.in[17];
        f32x4 gv[8];
#pragma unroll
        for (int i = 0; i < 8; ++i) gv[i] = *(const f32x4*)(gfin + i * 256 + lane * 4);
        for (int orow = bx * 8 + wid; orow < NBATCH * SEQ; orow += G * 8) {
            const int b = orow / SEQ, t = orow - b * SEQ; const int row = b * LB + 64 + t;
            const float rs = __builtin_amdgcn_rsqf(SSQ3[row] * (1.0f / 2048.0f) + 1e-6f);
            float* d = p.out + (size_t)orow * DM + lane * 4;
#pragma unroll
            for (int i = 0; i < 8; ++i) { const f32x4 v = *(const f32x4*)(d + i * 256); *(f32x4*)(d + i * 256) = v * rs * gv[i]; }
        }
    }
#undef IN
#undef SEAM
}

extern "C" void kernel_launch(void* const* d_in, const int* in_sizes, int n_in, void* d_out, int out_size, void* d_ws, size_t ws_size, hipStream_t stream) {
    static int grid = 0;
    if (grid == 0) {
        if (n_in != 18 || ws_size < WS_END) { fprintf(stderr, "kernel_launch: need 18 inputs and >= %zu bytes of workspace (got %d, %zu)\n", (size_t)WS_END, n_in, ws_size); grid = -1; return; }
        int dev = 0, cus = 0, per_cu = 0;
        (void)hipGetDevice(&dev);
        if (hipDeviceGetAttribute(&cus, hipDeviceAttributeMultiprocessorCount, dev) != hipSuccess || cus <= 0) cus = 256;
        if (hipFuncSetAttribute((const void*)fwd_kernel, hipFuncAttributeMaxDynamicSharedMemorySize, LDS_BYTES) != hipSuccess) { fprintf(stderr, "kernel_launch: hipFuncSetAttribute failed\n"); }
        if (hipOccupancyMaxActiveBlocksPerMultiprocessor(&per_cu, (const void*)fwd_kernel, 512, LDS_BYTES) != hipSuccess || per_cu < 1) { fprintf(stderr, "kernel_launch: occupancy query says %d\n", per_cu); per_cu = 1; }
        (void)hipGetLastError();
        grid = cus * 1;
        if (grid > 256) grid = 256;
    }
    if (grid < 0) return;
    Params p{};
    for (int i = 0; i < 18; ++i) p.in[i] = (const float*)d_in[i];
    p.out = (float*)d_out; p.ws = (unsigned char*)d_ws;
#if ONE_LAUNCH
    p.ph_lo = 0; p.ph_hi = 8;
    void* args[] = {&p};
    hipError_t e = hipLaunchCooperativeKernel((const void*)fwd_kernel, dim3(grid), dim3(512), args, LDS_BYTES, stream);
    if (e != hipSuccess) fprintf(stderr, "cooperative launch failed: %s (grid %d)\n", hipGetErrorString(e), grid);
#else
    for (int ph = 0; ph < 8; ++ph) { p.ph_lo = ph; p.ph_hi = ph + 1; hipLaunchKernelGGL(fwd_kernel, dim3(grid), dim3(512), LDS_BYTES, stream, p); }
#endif
}
```

```cpp
#include <hip/hip_runtime.h>
#include <hip/hip_cooperative_groups.h>
#include <cstdio>
#include <cstdint>
namespace cg = cooperative_groups;

#ifndef ONE_LAUNCH
#define ONE_LAUNCH 1
#endif

typedef unsigned short bf16_t;
typedef short bf16x8 __attribute__((ext_vector_type(8)));
typedef short s16x4 __attribute__((ext_vector_type(4)));
typedef float f32x4 __attribute__((ext_vector_type(4)));
typedef float f32x16 __attribute__((ext_vector_type(16)));
typedef unsigned u32x4 __attribute__((ext_vector_type(4)));
typedef unsigned u32x2 __attribute__((ext_vector_type(2)));

constexpr int DM = 2048, NBATCH = 4, SEQ = 8192, NMETA = 16;
constexpr int VPAD = 48;
constexpr int LB = 8256;
constexpr int M = NBATCH * LB;
constexpr int NINC = 10248;
constexpr int N1 = 10240;
constexpr int DFF = 5632, N5 = 2 * DFF;
constexpr int NHD = 48;

constexpr size_t SZ_W1T = (size_t)N1 * DM * 2, SZ_WAT = (size_t)DM * 1024 * 2, SZ_WOT = (size_t)DM * DM * 2, SZ_W5T = (size_t)N5 * DM * 2, SZ_WDT = (size_t)DM * DFF * 2;
constexpr size_t WS_W1T = 0, WS_WAT = WS_W1T + SZ_W1T, WS_WFT = WS_WAT + SZ_WAT, WS_WOT = WS_WFT + SZ_WAT, WS_W5T = WS_WOT + SZ_WOT, WS_WDT = WS_W5T + SZ_W5T;
constexpr size_t WS_RA = WS_WDT + SZ_WDT;
constexpr size_t SZ_RA = (size_t)M * DM * 2;
constexpr size_t WS_RB = WS_RA + SZ_RA;
constexpr size_t SZ_RB = (size_t)NHD * M * 128 * 2;
constexpr size_t WS_RG = WS_RB + SZ_RB;
constexpr size_t SZ_RG = (size_t)M * 4096 * 2;
constexpr size_t WS_RSTD1 = WS_RG + SZ_RG, WS_SSQ2 = WS_RSTD1 + (size_t)M * 4, WS_SSQ3 = WS_SSQ2 + (size_t)M * 4;
constexpr size_t WS_LOGF = WS_SSQ3 + (size_t)M * 4, WS_CUM = WS_LOGF + (size_t)32 * LB * 4;
constexpr size_t WS_SCR = WS_CUM + (size_t)32 * LB * 4;
constexpr size_t WS_END = WS_SCR + (size_t)256 * 262144;
constexpr int LDS_BYTES = 131072;

namespace pg8 {
#define PG8_LAS __attribute__((address_space(3)))
constexpr int BM = 256, BK = 64, HALF = 128, HTB = HALF * BK * 2, STAGE_BYTES = 8 * HTB, NXCD = 8, WGM = 8;
__host__ __device__ __forceinline__ int lds_byte(int r, int c) { const int st = (r >> 4) * 2 + (c >> 5), rr = r & 15, cc = c & 31, ob = rr * 64 + cc * 2; return st * 1024 + (ob ^ (((ob >> 9) & 1) << 5)); }
__host__ __device__ __forceinline__ void stage_rc(int b, int& R, int& C) { const int st = b / 1024, sb = b % 1024, swz = sb ^ (((sb >> 9) & 1) << 5); R = (st >> 1) * 16 + swz / 64; C = (st & 1) * 32 + (swz % 64) / 2; }
__host__ __device__ __forceinline__ int perm32(int rho) { const int n = rho >> 4, i = rho & 15; return 8 * (i >> 2) + 4 * n + (i & 3); }
struct Unit { int pm, pn; };
struct Gemm { const bf16_t* A; const bf16_t* Bt; int M, N, K; };
struct StaticOrder {
    int nM, nN, nwg, G, c;
    __host__ __device__ void init(int M_, int N_, int G_, int c_) { nM = M_ / BM; nN = N_ / BM; nwg = nM * nN; G = G_; c = c_; }
    __host__ __device__ bool next(int i, Unit& u) const {
        const long L = (long)i * G + c; if (L >= nwg) return false;
        int wgid = (int)L; { const int q = nwg / NXCD, r = nwg % NXCD, xcd = wgid % NXCD, off = wgid / NXCD; wgid = (xcd < r ? xcd * (q + 1) : r * (q + 1) + (xcd - r) * q) + off; }
        const int nig = WGM * nN, gid = wgid / nig, fm = gid * WGM, gsz = (nM - fm) < WGM ? (nM - fm) : WGM;
        u.pm = fm + ((wgid % nig) % gsz); u.pn = (wgid % nig) / gsz; return true;
    }
    __device__ __forceinline__ void a_ready(const Unit&) const {}
    __device__ __forceinline__ void done(const Unit&) const {}
};
__device__ __forceinline__ unsigned cvt_pk_bf16(float lo, float hi) { unsigned r; asm volatile("v_cvt_pk_bf16_f32 %0, %1, %2" : "=v"(r) : "v"(lo), "v"(hi)); return r; }

template <class Epi, class Sched>
__device__ __forceinline__ void gemm_phase(PG8_LAS unsigned char* lds, const Gemm g, const Sched& S, const Epi& E, const int tid) {
    const int wid = __builtin_amdgcn_readfirstlane(tid >> 6), lane = tid & 63, wr = wid >> 2, wc = wid & 3, fr = lane & 15, fq = lane >> 4;
    const int K = g.K, nt = K / BK;
    unsigned voffA[2], voffB[2];
#pragma unroll
    for (int i = 0; i < 2; ++i) { int R, C; stage_rc(tid * 16 + i * 8192, R, C); const int Rb = Epi::PERM ? ((R & ~31) + perm32(R & 31)) : R;
        voffA[i] = (unsigned)(R * K + C) * 2u; voffB[i] = (unsigned)(Rb * K + C) * 2u; }
    const size_t kstep = (size_t)(BK * 2);
    const size_t hstep = (size_t)HALF * K * 2;
    const size_t tstep = 2 * hstep;
    const unsigned ldsw = (unsigned)wid * 1024u;
    const int aoff = lds_byte(wr * 64 + fr, fq * 8), boff = lds_byte(wc * 32 + fr, fq * 8);
#define PG8_SA(b, h) (((b) * 2 + (h)) * HTB)
#define PG8_SB(b, h) ((4 + (b) * 2 + (h)) * HTB)
#define PG8_STAGE(bufoff, gbase, voff) do { _Pragma("unroll") for (int _i = 0; _i < 2; ++_i) \
        __builtin_amdgcn_global_load_lds((const unsigned*)((const char*)(gbase) + (voff)[_i]), (PG8_LAS unsigned*)(lds + (bufoff) + ldsw + _i * 8192), 16, 0, 0); } while (0)
#define PG8_LDA(dst, b, h) do { _Pragma("unroll") for (int m = 0; m < 4; ++m) _Pragma("unroll") for (int k = 0; k < 2; ++k) dst[m][k] = *(const PG8_LAS bf16x8*)(lds + PG8_SA(b, h) + aoff + m * 2048 + k * 1024); } while (0)
#define PG8_LDB(dst, b, h) do { _Pragma("unroll") for (int n = 0; n < 2; ++n) _Pragma("unroll") for (int k = 0; k < 2; ++k) dst[n][k] = *(const PG8_LAS bf16x8*)(lds + PG8_SB(b, h) + boff + n * 2048 + k * 1024); } while (0)
#define PG8_MMA(ai, bj, At, Bt) do { __builtin_amdgcn_s_setprio(1); _Pragma("unroll") for (int m = 0; m < 4; ++m) _Pragma("unroll") for (int n = 0; n < 2; ++n) _Pragma("unroll") for (int k = 0; k < 2; ++k) \
        acc[ai][bj][m][n] = __builtin_amdgcn_mfma_f32_16x16x32_bf16(Bt[n][k], At[m][k], acc[ai][bj][m][n], 0, 0, 0); __builtin_amdgcn_s_setprio(0); } while (0)
#define PG8_WAIT_V(n) asm volatile("s_waitcnt vmcnt(" #n ")" ::: "memory")
#define PG8_WAIT_L(n) asm volatile("s_waitcnt lgkmcnt(" #n ")" ::: "memory")
#define PG8_BAR __builtin_amdgcn_s_barrier()
#define PG8_SCHED __builtin_amdgcn_sched_barrier(0)
    Unit cur, nxt; int ui = 0;
    if (!S.next(0, cur)) return;
    f32x4 acc[2][2][4][2];
#pragma unroll
    for (int a = 0; a < 2; ++a)
#pragma unroll
        for (int b = 0; b < 2; ++b)
#pragma unroll
            for (int m = 0; m < 4; ++m)
#pragma unroll
                for (int n = 0; n < 2; ++n) acc[a][b][m][n] = (f32x4){0.f, 0.f, 0.f, 0.f};
    bf16x8 At[4][2], B0[2][2], B1[2][2];
    const char* cA = (const char*)g.A + (size_t)cur.pm * tstep; const char* cB = (const char*)g.Bt + (size_t)cur.pn * tstep;
    S.a_ready(cur);
    PG8_STAGE(PG8_SB(0, 0), cB, voffB); PG8_STAGE(PG8_SA(0, 0), cA, voffA); PG8_STAGE(PG8_SB(0, 1), cB + hstep, voffB); PG8_STAGE(PG8_SA(0, 1), cA + hstep, voffA);
    if (wr == 1) PG8_BAR;
    PG8_WAIT_V(4); PG8_BAR;
    PG8_STAGE(PG8_SB(1, 0), cB + kstep, voffB); PG8_STAGE(PG8_SA(1, 0), cA + kstep, voffA); PG8_STAGE(PG8_SB(1, 1), cB + hstep + kstep, voffB);
    PG8_WAIT_V(6); PG8_BAR;
    for (;;) {
        const bool has_next = S.next(ui + 1, nxt);
        const char* nA = has_next ? (const char*)g.A + (size_t)nxt.pm * tstep : cA; const char* nB = has_next ? (const char*)g.Bt + (size_t)nxt.pn * tstep : cB;
        for (int t = 0; t < nt; t += 2) {
            const bool last = (t == nt - 2);
            const char* a1 = cA + (size_t)(t + 1) * kstep;
            const char* a2 = last ? nA : cA + (size_t)(t + 2) * kstep; const char* b2 = last ? nB : cB + (size_t)(t + 2) * kstep;
            const char* a3 = a2 + kstep; const char* b3 = b2 + kstep;
            if (last && has_next) S.a_ready(nxt);
            PG8_LDB(B0, 0, 0); PG8_SCHED; PG8_LDA(At, 0, 0); PG8_STAGE(PG8_SA(1, 1), a1 + hstep, voffA);
            PG8_WAIT_L(8); PG8_BAR; PG8_WAIT_L(0); PG8_MMA(0, 0, At, B0); PG8_BAR; PG8_SCHED;
            PG8_LDB(B1, 0, 1); PG8_STAGE(PG8_SB(0, 0), b2, voffB);
            PG8_BAR; PG8_WAIT_L(0); PG8_MMA(0, 1, At, B1); PG8_BAR;
            PG8_LDA(At, 0, 1); PG8_STAGE(PG8_SA(0, 0), a2, voffA);
            PG8_BAR; PG8_WAIT_L(0); PG8_MMA(1, 0, At, B0); PG8_BAR; PG8_SCHED;
            PG8_STAGE(PG8_SB(0, 1), b2 + hstep, voffB);
            PG8_WAIT_V(6); PG8_BAR; PG8_MMA(1, 1, At, B1); PG8_BAR;
            PG8_LDB(B0, 1, 0); PG8_SCHED; PG8_LDA(At, 1, 0); PG8_STAGE(PG8_SA(0, 1), a2 + hstep, voffA);
            PG8_WAIT_L(8); PG8_BAR; PG8_WAIT_L(0); PG8_MMA(0, 0, At, B0); PG8_BAR; PG8_SCHED;
            PG8_LDB(B1, 1, 1); PG8_STAGE(PG8_SB(1, 0), b3, voffB);
            PG8_BAR; PG8_WAIT_L(0); PG8_MMA(0, 1, At, B1); PG8_BAR;
            PG8_LDA(At, 1, 1); PG8_STAGE(PG8_SA(1, 0), a3, voffA);
            PG8_BAR; PG8_WAIT_L(0); PG8_MMA(1, 0, At, B0); PG8_BAR; PG8_SCHED;
            PG8_STAGE(PG8_SB(1, 1), b3 + hstep, voffB);
            PG8_WAIT_V(6); PG8_BAR; PG8_MMA(1, 1, At, B1); PG8_BAR;
        }
        E(acc, cur, wr, wc, fr, fq); S.done(cur);
        if (!has_next) break;
#pragma unroll
        for (int a = 0; a < 2; ++a)
#pragma unroll
            for (int b = 0; b < 2; ++b)
#pragma unroll
                for (int m = 0; m < 4; ++m)
#pragma unroll
                    for (int n = 0; n < 2; ++n) acc[a][b][m][n] = (f32x4){0.f, 0.f, 0.f, 0.f};
        cur = nxt; cA = nA; cB = nB; ++ui;
    }
    PG8_WAIT_V(0);
    if (wr == 0) PG8_BAR;
    PG8_BAR;
#undef PG8_SA
#undef PG8_SB
#undef PG8_STAGE
#undef PG8_LDA
#undef PG8_LDB
#undef PG8_MMA
#undef PG8_WAIT_V
#undef PG8_WAIT_L
#undef PG8_BAR
#undef PG8_SCHED
}
}

__device__ __forceinline__ int fresh_lane() { int l; asm volatile("v_mbcnt_lo_u32_b32 %0, -1, 0\n\tv_mbcnt_hi_u32_b32 %0, -1, %0" : "=v"(l)); return l; }
__device__ __forceinline__ float bf2f(unsigned short b) { return __uint_as_float(((unsigned)b) << 16); }
__device__ __forceinline__ float sigmoidf_(float x) { return __builtin_amdgcn_rcpf(1.0f + __builtin_amdgcn_exp2f(-1.4426950408889634f * x)); }
__device__ __forceinline__ u32x4 pack8u(f32x4 a, f32x4 b) { u32x4 w = {pg8::cvt_pk_bf16(a[0], a[1]), pg8::cvt_pk_bf16(a[2], a[3]), pg8::cvt_pk_bf16(b[0], b[1]), pg8::cvt_pk_bf16(b[2], b[3])}; return w; }
__device__ __forceinline__ void unpack8(u32x4 w, f32x4& a, f32x4& b) {
    a = (f32x4){__uint_as_float(w.x << 16), __uint_as_float(w.x & 0xffff0000u), __uint_as_float(w.y << 16), __uint_as_float(w.y & 0xffff0000u)};
    b = (f32x4){__uint_as_float(w.z << 16), __uint_as_float(w.z & 0xffff0000u), __uint_as_float(w.w << 16), __uint_as_float(w.w & 0xffff0000u)};
}
__device__ __forceinline__ float wave_sum(float v) {
#pragma unroll
    for (int o = 32; o >= 1; o >>= 1) v += __shfl_xor(v, o);
    return v;
}

typedef f32x4 Acc[2][2][4][2];
struct Epi1 { static constexpr bool PERM = true;
    bf16_t* QKV; bf16_t* GATES; const float* rstd;
    __device__ __forceinline__ void operator()(const Acc& acc, const pg8::Unit& u, int wr, int wc, int fr, int fq) const {
        const int row0 = u.pm * 256 + wr * 64 + fr;
        if (u.pn < 24) {
#pragma unroll
            for (int ai = 0; ai < 2; ++ai)
#pragma unroll
                for (int m = 0; m < 4; ++m) { const int row = row0 + ai * 128 + m * 16; const float rs = rstd[row];
#pragma unroll
                    for (int bj = 0; bj < 2; ++bj) { bf16_t* dst = QKV + ((size_t)(2 * u.pn + bj) * M + row) * 128 + wc * 32 + 8 * fq;
                        *(u32x4*)dst = pack8u(acc[ai][bj][m][0] * rs, acc[ai][bj][m][1] * rs); } }
        } else {
            const int colb = (u.pn - 24) * 256 + wc * 32 + 8 * fq;
#pragma unroll
            for (int ai = 0; ai < 2; ++ai)
#pragma unroll
                for (int m = 0; m < 4; ++m) { const int row = row0 + ai * 128 + m * 16; const float rs = rstd[row];
#pragma unroll
                    for (int bj = 0; bj < 2; ++bj) { f32x4 v0 = acc[ai][bj][m][0] * rs, v1 = acc[ai][bj][m][1] * rs;
#pragma unroll
                        for (int j = 0; j < 4; ++j) { v0[j] = sigmoidf_(v0[j]); v1[j] = sigmoidf_(v1[j]); }
                        *(u32x4*)(GATES + (size_t)row * 4096 + colb + bj * 128) = pack8u(v0, v1); } }
        }
    }
};
struct Epi3a { static constexpr bool PERM = true;
    float* TMP; const bf16_t* GATES;
    __device__ __forceinline__ void operator()(const Acc& acc, const pg8::Unit& u, int wr, int wc, int fr, int fq) const {
        const int row0 = u.pm * 256 + wr * 64 + fr, col0 = u.pn * 256 + wc * 32 + 8 * fq;
#pragma unroll
        for (int ai = 0; ai < 2; ++ai)
#pragma unroll
            for (int m = 0; m < 4; ++m) { const int row = row0 + ai * 128 + m * 16;
#pragma unroll
                for (int bj = 0; bj < 2; ++bj) { const int col = col0 + bj * 128; f32x4 g0, g1; unpack8(*(const u32x4*)(GATES + (size_t)row * 4096 + col), g0, g1);
                    float* d = TMP + (size_t)row * DM + col; *(f32x4*)d = acc[ai][bj][m][0] * g0; *(f32x4*)(d + 4) = acc[ai][bj][m][1] * g1; } }
    }
};
struct Epi3b { static constexpr bool PERM = true;
    const float* TMP; const bf16_t* GATES; bf16_t* MERGED;
    __device__ __forceinline__ void operator()(const Acc& acc, const pg8::Unit& u, int wr, int wc, int fr, int fq) const {
        const int row0 = u.pm * 256 + wr * 64 + fr, col0 = u.pn * 256 + wc * 32 + 8 * fq;
#pragma unroll
        for (int ai = 0; ai < 2; ++ai)
#pragma unroll
            for (int m = 0; m < 4; ++m) { const int row = row0 + ai * 128 + m * 16;
#pragma unroll
                for (int bj = 0; bj < 2; ++bj) { const int col = col0 + bj * 128; f32x4 g0, g1; unpack8(*(const u32x4*)(GATES + (size_t)row * 4096 + 2048 + col), g0, g1);
                    const float* s = TMP + (size_t)row * DM + col; const f32x4 t0 = *(const f32x4*)s, t1 = *(const f32x4*)(s + 4);
                    *(u32x4*)(MERGED + (size_t)row * DM + col) = pack8u(t0 + acc[ai][bj][m][0] * g0, t1 + acc[ai][bj][m][1] * g1); } }
    }
};
struct Epi4 { static constexpr bool PERM = true;
    const float* x; float* out; bf16_t* H1B; float* ssq;
    __device__ __forceinline__ void operator()(const Acc& acc, const pg8::Unit& u, int wr, int wc, int fr, int fq) const {
        const int row0 = u.pm * 256 + wr * 64 + fr, col0 = u.pn * 256 + wc * 32 + 8 * fq;
#pragma unroll
        for (int ai = 0; ai < 2; ++ai)
#pragma unroll
            for (int m = 0; m < 4; ++m) { const int row = row0 + ai * 128 + m * 16; const int b = row / LB, vp = row - b * LB;
                if (vp >= 64) { const size_t orow = (size_t)b * SEQ + (vp - 64); float ss = 0.f;
#pragma unroll
                    for (int bj = 0; bj < 2; ++bj) { const int col = col0 + bj * 128; const float* xs = x + orow * DM + col;
                        const f32x4 h0 = *(const f32x4*)xs + acc[ai][bj][m][0], h1 = *(const f32x4*)(xs + 4) + acc[ai][bj][m][1];
                        float* d = out + orow * DM + col; *(f32x4*)d = h0; *(f32x4*)(d + 4) = h1;
                        *(u32x4*)(H1B + (size_t)row * DM + col) = pack8u(h0, h1);
                        ss += (h0[0] * h0[0] + h0[1] * h0[1]) + (h0[2] * h0[2] + h0[3] * h0[3]) + (h1[0] * h1[0] + h1[1] * h1[1]) + (h1[2] * h1[2] + h1[3] * h1[3]); }
                    ss += __shfl_xor(ss, 16); ss += __shfl_xor(ss, 32);
                    if (fq == 0) unsafeAtomicAdd(ssq + row, ss);
                } else { float ss = 0.f; ss += __shfl_xor(ss, 16); ss += __shfl_xor(ss, 32); (void)ss; } }
    }
};
struct Epi5 { static constexpr bool PERM = true;
    const float* ssq; bf16_t* ACT;
    __device__ __forceinline__ void operator()(const Acc& acc, const pg8::Unit& u, int wr, int wc, int fr, int fq) const {
        const int row0 = u.pm * 256 + wr * 64 + fr, col0 = u.pn * 128 + wc * 32 + 8 * fq;
#pragma unroll
        for (int ai = 0; ai < 2; ++ai)
#pragma unroll
            for (int m = 0; m < 4; ++m) { const int row = row0 + ai * 128 + m * 16; const float rs = __builtin_amdgcn_rsqf(ssq[row] * (1.0f / 2048.0f) + 1e-6f);
                f32x4 o[2];
#pragma unroll
                for (int n = 0; n < 2; ++n) { const f32x4 g = acc[ai][0][m][n] * rs, up = acc[ai][1][m][n] * rs;
#pragma unroll
                    for (int j = 0; j < 4; ++j) o[n][j] = g[j] * sigmoidf_(g[j]) * up[j]; }
                *(u32x4*)(ACT + (size_t)row * DFF + col0) = pack8u(o[0], o[1]); }
    }
};
struct Epi6 { static constexpr bool PERM = true;
    float* out; float* ssq;
    __device__ __forceinline__ void operator()(const Acc& acc, const pg8::Unit& u, int wr, int wc, int fr, int fq) const {
        const int row0 = u.pm * 256 + wr * 64 + fr, col0 = u.pn * 256 + wc * 32 + 8 * fq;
#pragma unroll
        for (int ai = 0; ai < 2; ++ai)
#pragma unroll
            for (int m = 0; m < 4; ++m) { const int row = row0 + ai * 128 + m * 16; const int b = row / LB, vp = row - b * LB;
                if (vp >= 64) { const size_t orow = (size_t)b * SEQ + (vp - 64); float ss = 0.f;
#pragma unroll
                    for (int bj = 0; bj < 2; ++bj) { const int col = col0 + bj * 128; float* d = out + orow * DM + col;
                        const f32x4 h0 = *(const f32x4*)d + acc[ai][bj][m][0], h1 = *(const f32x4*)(d + 4) + acc[ai][bj][m][1];
                        *(f32x4*)d = h0; *(f32x4*)(d + 4) = h1;
                        ss += (h0[0] * h0[0] + h0[1] * h0[1]) + (h0[2] * h0[2] + h0[3] * h0[3]) + (h1[0] * h1[0] + h1[1] * h1[1]) + (h1[2] * h1[2] + h1[3] * h1[3]); }
                    ss += __shfl_xor(ss, 16); ss += __shfl_xor(ss, 32);
                    if (fq == 0) unsafeAtomicAdd(ssq + row, ss);
                } else { float ss = 0.f; ss += __shfl_xor(ss, 16); ss += __shfl_xor(ss, 32); (void)ss; } }
    }
};

namespace att {
constexpr int D = 128, NW = 8, QBLK = 32, KVBLK = 64, QB = 256;
constexpr int SHM_V = KVBLK * D * 2, SHM_K = KVBLK * D * 2;
constexpr int LDS_WS = 2 * SHM_V + 2 * SHM_K;
constexpr int LDS_TAB = LDS_WS + NW * 64 * 4;
constexpr float SCALE = 0.08838834764831845f;
constexpr float THR = 8.f;
#define KSWZ(row, colB) ((row) * 256 + ((colB) ^ (((row) & 7) << 4)))
#define SBAR() __builtin_amdgcn_sched_barrier(0)
__device__ __forceinline__ int v_st(int k, int c) { const int kk = (k & ~0xC) | ((k & 4) << 1) | ((k & 8) >> 1); return ((kk >> 3) * 4 + (c >> 5)) * 512 + ((kk & 7) * 32 + (c & 31)) * 2; }
__device__ __forceinline__ int v_rd_base(int lane) { return ((lane & 3) << 3) | (((lane >> 2) & 3) << 6) | (((lane >> 4) & 1) << 5) | (((lane >> 5) & 1) << 8); }
constexpr int v_rd_off(int d0, int ks, int half) { return d0 * 512 + ks * 4096 + half * 2048; }
__device__ __forceinline__ int crow(int r, int hi) { return (r & 3) + 8 * (r >> 2) + 4 * hi; }
__device__ __forceinline__ unsigned cvtpk(float lo, float hi) { unsigned r; asm volatile("v_cvt_pk_bf16_f32 %0, %1, %2" : "=v"(r) : "v"(lo), "v"(hi)); return r; }
__device__ __forceinline__ bf16x8 load8(const bf16_t* p) { return *reinterpret_cast<const bf16x8*>(p); }
__device__ __forceinline__ void mask_tile(f32x16& p0, f32x16& p1, int dqe, int dqt, unsigned W, float s2) {
    const float NEG = -__builtin_inff();
#pragma unroll
    for (int r = 0; r < 16; ++r) {
        const int c = (r & 3) + 8 * (r >> 2);
        const int a0 = c - dqt, a1 = c + 32 - dqt;
        p0[r] -= s2 * (float)(a0 > 0 ? a0 : 0);
        p1[r] -= s2 * (float)(a1 > 0 ? a1 : 0);
        if ((unsigned)(dqe - c) >= W) p0[r] = NEG;
        if ((unsigned)(dqe - c - 32) >= W) p1[r] = NEG;
    }
}
__device__ __forceinline__ void partialSM(f32x16& p0, f32x16& p1, float& m_reg, float& mn, float& alpha) {
    float pmax = p0[0]; for (int r = 1; r < 16; ++r) pmax = fmaxf(pmax, p0[r]); for (int r = 0; r < 16; ++r) pmax = fmaxf(pmax, p1[r]);
    { auto rr = __builtin_amdgcn_permlane32_swap(__float_as_uint(pmax), __float_as_uint(pmax), false, false);
      pmax = fmaxf(__uint_as_float(rr[0]), __uint_as_float(rr[1])); }
    constexpr float C2 = 1.4426950408889634f * SCALE;
    if (__builtin_expect(__all((pmax - m_reg) * SCALE <= THR), 1)) { mn = m_reg; alpha = 1.f; }
    else { mn = fmaxf(m_reg, pmax); alpha = __builtin_amdgcn_exp2f((m_reg - mn) * C2); m_reg = mn; }
    const float mnL = -mn * C2;
    for (int r = 0; r < 16; ++r) p0[r] = fmaf(p0[r], C2, mnL); for (int r = 0; r < 16; ++r) p1[r] = fmaf(p1[r], C2, mnL);
    for (int r = 0; r < 16; ++r) p0[r] = __builtin_amdgcn_exp2f(p0[r]);
}
__device__ __forceinline__ void finishSM(f32x16& p0, f32x16& p1, float alpha, float& l_reg, bf16x8& pa0, bf16x8& pa1, bf16x8& pa2, bf16x8& pa3) {
    for (int r = 0; r < 16; ++r) p1[r] = __builtin_amdgcn_exp2f(p1[r]);
    float ps = 0; for (int r = 0; r < 16; ++r) ps += p0[r]; for (int r = 0; r < 16; ++r) ps += p1[r];
    { auto rr = __builtin_amdgcn_permlane32_swap(__float_as_uint(ps), __float_as_uint(ps), false, false);
      ps = __uint_as_float(rr[0]) + __uint_as_float(rr[1]); }
    l_reg = l_reg * alpha + ps;
#define PK4(P, B_, OUT) do { unsigned a0 = cvtpk(P[B_+0], P[B_+1]), a1 = cvtpk(P[B_+2], P[B_+3]);                          \
        unsigned b0 = cvtpk(P[B_+4], P[B_+5]), b1 = cvtpk(P[B_+6], P[B_+7]);                                             \
        auto r0 = __builtin_amdgcn_permlane32_swap(a0, b0, false, false); auto r1 = __builtin_amdgcn_permlane32_swap(a1, b1, false, false); \
        u32x4 w = {r0[0], r1[0], r0[1], r1[1]}; OUT = *reinterpret_cast<bf16x8*>(&w); } while (0)
    PK4(p0, 0, pa0); PK4(p0, 8, pa1); PK4(p1, 0, pa2); PK4(p1, 8, pa3);
#undef PK4
}
template <int KB>
__device__ __forceinline__ void qkt(f32x16& p0, f32x16& p1, const char* K_lds, int r32, int hi, const bf16x8* qr) {
    p0 = f32x16{}; p1 = f32x16{};
    const char* kb[4];
#pragma unroll
    for (int dd = 0; dd < 4; ++dd) kb[dd] = K_lds + KB * SHM_K + KSWZ(r32, (dd * 16 + hi * 8) * 2);
#pragma unroll
    for (int d0 = 0; d0 < 8; ++d0) { const char* a = kb[d0 & 3] + (d0 >> 2) * 128;
        bf16x8 b0 = *reinterpret_cast<const bf16x8*>(a);
        bf16x8 b1 = *reinterpret_cast<const bf16x8*>(a + 32 * 256);
        p0 = __builtin_amdgcn_mfma_f32_32x32x16_bf16(b0, qr[d0], p0, 0, 0, 0);
        p1 = __builtin_amdgcn_mfma_f32_32x32x16_bf16(b1, qr[d0], p1, 0, 0, 0); }
}
template <int VB>
__device__ __forceinline__ void pv_tile(f32x16* o, int vb0, bf16x8 pa0, bf16x8 pa1, bf16x8 pa2, bf16x8 pa3) {
#define TRRD(dst, off) asm volatile("ds_read_b64_tr_b16 %0, %1 offset:%2" : "=&v"(dst) : "v"(vb0), "i"(off) : "memory")
#define PV_D0(d0) do { s16x4 l0, l1, l2, l3, h0, h1, h2, h3; constexpr int b_ = VB * SHM_V + v_rd_off(d0, 0, 0); \
        TRRD(l0, b_); TRRD(h0, b_ + 2048); TRRD(l1, b_ + 4096); TRRD(h1, b_ + 6144); TRRD(l2, b_ + 8192); TRRD(h2, b_ + 10240); TRRD(l3, b_ + 12288); TRRD(h3, b_ + 14336); \
        asm volatile("s_waitcnt lgkmcnt(0)" ::: "memory"); SBAR();   \
        o[d0] = __builtin_amdgcn_mfma_f32_32x32x16_bf16(pa0, (bf16x8){l0[0], l0[1], l0[2], l0[3], h0[0], h0[1], h0[2], h0[3]}, o[d0], 0, 0, 0);   \
        o[d0] = __builtin_amdgcn_mfma_f32_32x32x16_bf16(pa1, (bf16x8){l1[0], l1[1], l1[2], l1[3], h1[0], h1[1], h1[2], h1[3]}, o[d0], 0, 0, 0);   \
        o[d0] = __builtin_amdgcn_mfma_f32_32x32x16_bf16(pa2, (bf16x8){l2[0], l2[1], l2[2], l2[3], h2[0], h2[1], h2[2], h2[3]}, o[d0], 0, 0, 0);   \
        o[d0] = __builtin_amdgcn_mfma_f32_32x32x16_bf16(pa3, (bf16x8){l3[0], l3[1], l3[2], l3[3], h3[0], h3[1], h3[2], h3[3]}, o[d0], 0, 0, 0); } while (0)
    PV_D0(0); PV_D0(1); PV_D0(2); PV_D0(3);
#undef PV_D0
#undef TRRD
}
struct Blk { const bf16_t* Q; const bf16_t* K; const bf16_t* V; bf16_t* O; int P0; int mode; float s2; };
struct Seam { bf16x8 qr[8]; bf16x8 st_v0, st_v1, st_k0, st_k1; };
#define ROW(p, k0, rr) ((p) + (size_t)((k0) + (rr)) * D + sc)
#define VMW() asm volatile("s_waitcnt vmcnt(0)" ::: "memory")
#define VMWN(n) asm volatile("s_waitcnt vmcnt(%0)" :: "i"(n) : "memory")
#define SLOAD_H(Kp, Vp, k0) do { S.st_v0 = load8(ROW(Vp, k0, sr)); S.st_v1 = load8(ROW(Vp, k0, 32 + sr));              \
                         S.st_k0 = load8(ROW(Kp, k0, sr)); S.st_k1 = load8(ROW(Kp, k0, 32 + sr)); } while (0)
#define SWRITE_HK(bf) do { *(bf16x8*)(K_lds + (bf) * SHM_K + kws) = S.st_k0; *(bf16x8*)(K_lds + (bf) * SHM_K + kws + 32 * 256) = S.st_k1; } while (0)
#define SWRITE_HV(bf) do { *(bf16x8*)(V_lds + (bf) * SHM_V + vst0) = S.st_v0; *(bf16x8*)(V_lds + (bf) * SHM_V + vst1) = S.st_v1; } while (0)
#define SWRITE_H(bf) do { SWRITE_HV(bf); SWRITE_HK(bf); } while (0)
__device__ __forceinline__ void attn_prime(const Blk& cur, char* lds, Seam& S, const int tid) {
    const int wid = __builtin_amdgcn_readfirstlane(tid >> 6), lane = tid & 63, r32 = lane & 31, hi = lane >> 5;
    const int sr = tid >> 4, sc = (tid & 15) * 8, kws = KSWZ(sr, sc * 2); char* K_lds = lds + 2 * SHM_V;
    for (int d0 = 0; d0 < 8; ++d0) S.qr[d0] = load8(cur.Q + (size_t)(wid * QBLK + r32) * D + d0 * 16 + hi * 8);
    SLOAD_H(cur.K, cur.V, 0); VMW(); SWRITE_HK(0);
    __syncthreads();
}
__device__ __forceinline__ void attn_block(const Blk& cur, const Blk& nxt, char* lds, Seam& S, float lam, float* scrT, float* scrD, const float* g_subln, const int tid) {
    const int wid = __builtin_amdgcn_readfirstlane(tid >> 6), lane = tid & 63, r32 = lane & 31, hi = lane >> 5;
    const int NT = (cur.P0 + QB - 1) / KVBLK + 1;
    const int qlo = cur.P0 + wid * QBLK;
    const int qt4 = qlo + r32 - 4 * hi;
    const bool isdiff = cur.mode != 0;
    char* V_lds = lds; char* K_lds = lds + 2 * SHM_V;
    float* ws = (float*)(lds + LDS_WS) + wid * 64; float* li_l = ws, * al_l = ws + 32;
    float m_reg = -1e30f, l_reg = 0; f32x16 o[4] = {};
    const int sr = tid >> 4, sc = (tid & 15) * 8, vst0 = v_st(sr, sc), vst1 = v_st(32 + sr, sc), kws = KSWZ(sr, sc * 2);
    const int vb0 = (int)(uintptr_t)V_lds + v_rd_base(lane);
    const bf16_t* Kh = cur.K; const bf16_t* Vh = cur.V;
#define RESC(a) do { if (__any((a) < 1.f)) { if (hi == 0) al_l[r32] = (a); asm volatile("s_waitcnt lgkmcnt(0)" ::: "memory");              \
                     for (int d_ = 0; d_ < 4; ++d_) for (int r = 0; r < 16; ++r) o[d_][r] *= al_l[crow(r, hi)]; } } while (0)
#define KBASE(t) ((t) * KVBLK)
#define BIAS(P0_, P1_, t) do { int h_ = hi; asm volatile("" : "+v"(h_)); const float* tb_ = (const float*)(lds + LDS_TAB) + (4 * h_ + KBASE(t));         \
        _Pragma("unroll") for (int i_ = 0; i_ < 4; ++i_) { const f32x4 b0_ = *(const f32x4*)(tb_ + 8 * i_), b1_ = *(const f32x4*)(tb_ + 32 + 8 * i_); \
            _Pragma("unroll") for (int j_ = 0; j_ < 4; ++j_) { P0_[4 * i_ + j_] += b0_[j_]; P1_[4 * i_ + j_] += b1_[j_]; } } } while (0)
#define MASKT(P0_, P1_, t) do { const int kb_ = KBASE(t); BIAS(P0_, P1_, t); if (kb_ + KVBLK - 1 > qlo || kb_ == 0) { int q_ = qt4; asm volatile("" : "+v"(q_)); const int qt_ = q_ + 4 * hi, qe_ = isdiff ? (qt_ | 63) : qt_;      \
            mask_tile(P0_, P1_, qe_ - kb_ - 4 * hi, q_ - kb_, (unsigned)(qe_ - 47), cur.s2); } } while (0)
#define SEAM_K0() do { VMWN(8); SWRITE_HK(0); SBAR(); } while (0)
    f32x16 pA0, pA1, pB0, pB1; float mnA, mnB, alA, alB; bf16x8 pa0, pa1, pa2, pa3;
    SWRITE_HV(0); SBAR();
    if (NT > 1) { SLOAD_H(Kh, Vh, KBASE(1)); }
    SBAR(); qkt<0>(pA0, pA1, K_lds, r32, hi, S.qr);
    MASKT(pA0, pA1, 0); partialSM(pA0, pA1, m_reg, mnA, alA);
    if (NT > 1) { VMW(); SWRITE_H(1); }
    __syncthreads();
#define HALF_STEP(PX0, PX1, mnX, alX, PY0, PY1, alY, t, KB, VB, SB_) do {                                                      \
        SBAR(); qkt<KB>(PX0, PX1, K_lds, r32, hi, S.qr);                                             \
        finishSM(PY0, PY1, alY, l_reg, pa0, pa1, pa2, pa3); SBAR();                                                           \
        if ((t) + 1 < NT) { SLOAD_H(Kh, Vh, KBASE((t) + 1)); SBAR(); }                                               \
        pv_tile<VB>(o, vb0, pa0, pa1, pa2, pa3); MASKT(PX0, PX1, (t)); partialSM(PX0, PX1, m_reg, mnX, alX);                                        \
        __syncthreads();                                                                                                      \
        if ((t) + 1 < NT) { VMW(); SWRITE_H(SB_); }                                                                          \
        RESC(alX); __syncthreads(); } while (0)
    for (int t = 1; t + 1 < NT; t += 2) {
        HALF_STEP(pB0, pB1, mnB, alB, pA0, pA1, alA, t, 1, 0, 0);
        HALF_STEP(pA0, pA1, mnA, alA, pB0, pB1, alB, t + 1, 0, 1, 1);
    }
    const bool even = (NT & 1) == 0;
    if (even) { SBAR(); qkt<1>(pB0, pB1, K_lds, r32, hi, S.qr); SBAR(); }
    { int t2 = tid; asm volatile("" : "+v"(t2));
      const int sr2 = t2 >> 4, sc2 = (t2 & 15) * 8, l2 = t2 & 63;
      const unsigned off = (unsigned)(sr2 * D + sc2);
      S.st_v0 = load8(nxt.V + off); S.st_v1 = load8(nxt.V + off + 32 * D); S.st_k0 = load8(nxt.K + off); S.st_k1 = load8(nxt.K + off + 32 * D); SBAR();
      const unsigned qoff = (unsigned)((wid * QBLK + (l2 & 31)) * D + (l2 >> 5) * 8);
#pragma unroll
      for (int d0 = 0; d0 < 8; ++d0) S.qr[d0] = load8(nxt.Q + qoff + d0 * 16); }
    SBAR();
    finishSM(pA0, pA1, alA, l_reg, pa0, pa1, pa2, pa3); SBAR();
    pv_tile<0>(o, vb0, pa0, pa1, pa2, pa3);
    if (even) { MASKT(pB0, pB1, NT - 1); partialSM(pB0, pB1, m_reg, mnB, alB); __syncthreads(); RESC(alB);
        finishSM(pB0, pB1, alB, l_reg, pa0, pa1, pa2, pa3); SBAR(); pv_tile<1>(o, vb0, pa0, pa1, pa2, pa3); }
    SBAR(); SEAM_K0();
    int ln = lane; asm volatile("" : "+v"(ln));
    const int r32e = ln & 31;
    if (hi == 0) li_l[r32] = l_reg; asm volatile("s_waitcnt lgkmcnt(0)" ::: "memory");
    float rli[16];
#pragma unroll
    for (int r = 0; r < 16; ++r) rli[r] = __builtin_amdgcn_rcpf(li_l[crow(r, hi)]);
    const int mode = cur.mode;
    if (mode == 0) {
        bf16_t* Ow = cur.O + (size_t)(wid * QBLK) * 1024;
#pragma unroll
        for (int r = 0; r < 16; ++r) { const int orow = crow(r, hi);
#pragma unroll
            for (int d0 = 0; d0 < 4; ++d0) { const float v = o[d0][r] * rli[r]; const float vn = __shfl_xor(v, 1);
                if ((r32e & 1) == 0) *(unsigned*)(Ow + (orow * 1024 + d0 * 32 + r32e)) = cvtpk(v, vn); } }
    } else if (mode == 1) {
        float* T = scrT + (wid * 4096 + ln);
#pragma unroll
        for (int r = 0; r < 16; ++r)
#pragma unroll
            for (int d0 = 0; d0 < 4; ++d0) T[(r * 4 + d0) * 64] = o[d0][r] * rli[r];
    } else {
        const float* T = scrT + (wid * 4096 + ln); float* Dl = scrD + (wid * 4096 + ln);
#pragma unroll
        for (int r = 0; r < 16; ++r)
#pragma unroll
            for (int d0 = 0; d0 < 4; ++d0) o[d0][r] = __hip_atomic_load(T + (r * 4 + d0) * 64, __ATOMIC_RELAXED, __HIP_MEMORY_SCOPE_AGENT) - lam * (o[d0][r] * rli[r]);
        if (mode == 2) {
#pragma unroll
            for (int r = 0; r < 16; ++r)
#pragma unroll
                for (int d0 = 0; d0 < 4; ++d0) Dl[(r * 4 + d0) * 64] = o[d0][r];
        } else {
            bf16_t* Ow = cur.O + (size_t)(wid * QBLK) * 1024;
            float gs0[4], gs1[4];
#pragma unroll
            for (int d0 = 0; d0 < 4; ++d0) { gs0[d0] = g_subln[d0 * 32 + r32e] * 0.8f; gs1[d0] = g_subln[128 + d0 * 32 + r32e] * 0.8f; }
#pragma unroll
            for (int r = 0; r < 16; ++r) { const int orow = crow(r, hi);
                float e0[4]; float ss = 0.f;
#pragma unroll
                for (int d0 = 0; d0 < 4; ++d0) { e0[d0] = __hip_atomic_load(Dl + (r * 4 + d0) * 64, __ATOMIC_RELAXED, __HIP_MEMORY_SCOPE_AGENT); ss += e0[d0] * e0[d0] + o[d0][r] * o[d0][r]; }
                ss += __shfl_xor(ss, 1); ss += __shfl_xor(ss, 2); ss += __shfl_xor(ss, 4); ss += __shfl_xor(ss, 8); ss += __shfl_xor(ss, 16);
                const float rn = __builtin_amdgcn_rsqf(ss * (1.0f / 256.0f) + 1e-5f);
#pragma unroll
                for (int d0 = 0; d0 < 4; ++d0) { const float v0 = e0[d0] * rn * gs0[d0], v1 = o[d0][r] * rn * gs1[d0]; const float v0n = __shfl_xor(v0, 1), v1n = __shfl_xor(v1, 1);
                    if ((r32e & 1) == 0) { *(unsigned*)(Ow + (orow * 1024 + d0 * 32 + r32e)) = cvtpk(v0, v0n); *(unsigned*)(Ow + (orow * 1024 + 128 + d0 * 32 + r32e)) = cvtpk(v1, v1n); } }
                asm volatile("" ::: "memory"); }
        }
    }
    __syncthreads();
#undef RESC
#undef KBASE
#undef BIAS
#undef MASKT
#undef SEAM_K0
#undef HALF_STEP
}
#undef ROW
#undef VMW
#undef VMWN
#undef SLOAD_H
#undef SWRITE_HK
#undef SWRITE_HV
#undef SWRITE_H
}

struct Params { const float* in[18]; float* out; unsigned char* ws; int ph_lo, ph_hi; };

__device__ __forceinline__ void transpose_job(const float* __restrict__ src, int ld, int col0, int nN, int Kdim, bf16_t* __restrict__ dst, int up, const float* __restrict__ scale, float* tile, const int tid) {
    const int nK = Kdim / 64, total = nK * nN;
    f32x4 v[2];
    int t = blockIdx.x;
    if (t < total) { const int k0 = (t / nN) * 64, n0 = (t % nN) * 64;
#pragma unroll
        for (int i = 0; i < 2; ++i) { const int idx = tid + 512 * i, kk = idx >> 4, c4 = idx & 15; v[i] = *(const f32x4*)(src + (size_t)(k0 + kk) * ld + col0 + n0 + c4 * 4) * (scale ? scale[k0 + kk] : 1.0f); } }
    for (; t < total; t += gridDim.x) {
        const int k0 = (t / nN) * 64, n0 = (t % nN) * 64;
#pragma unroll
        for (int i = 0; i < 2; ++i) { const int idx = tid + 512 * i, kk = idx >> 4, c4 = idx & 15;
#pragma unroll
            for (int j = 0; j < 4; ++j) tile[kk * 65 + c4 * 4 + j] = v[i][j]; }
        const int tn = t + gridDim.x;
        if (tn < total) { const int k1 = (tn / nN) * 64, n1 = (tn % nN) * 64;
#pragma unroll
            for (int i = 0; i < 2; ++i) { const int idx = tid + 512 * i, kk = idx >> 4, c4 = idx & 15; v[i] = *(const f32x4*)(src + (size_t)(k1 + kk) * ld + col0 + n1 + c4 * 4) * (scale ? scale[k1 + kk] : 1.0f); } }
        __syncthreads();
        { const int n = tid >> 3, kc = (tid & 7) * 8; f32x4 a, b;
#pragma unroll
            for (int j = 0; j < 4; ++j) { a[j] = tile[(kc + j) * 65 + n]; b[j] = tile[(kc + 4 + j) * 65 + n]; }
            const int drow = (up < 0) ? (n0 + n) : (256 * (n0 >> 7) + (n0 & 127) + up * 128 + n);
            *(u32x4*)(dst + (size_t)drow * Kdim + k0 + kc) = pack8u(a, b); }
        __syncthreads();
    }
}

__global__ void __launch_bounds__(512, 2) fwd_kernel(Params p) {
    extern __shared__ __attribute__((aligned(16))) unsigned char lds[];
    cg::grid_group grid = cg::this_grid();
    const int wid = __builtin_amdgcn_readfirstlane(threadIdx.x >> 6), G = gridDim.x, bx = blockIdx.x;
    unsigned char* ws = p.ws;
    bf16_t* W1T = (bf16_t*)(ws + WS_W1T); bf16_t* WAT = (bf16_t*)(ws + WS_WAT); bf16_t* WFT = (bf16_t*)(ws + WS_WFT); bf16_t* WOT = (bf16_t*)(ws + WS_WOT);
    bf16_t* W5T = (bf16_t*)(ws + WS_W5T); bf16_t* WDT = (bf16_t*)(ws + WS_WDT);
    bf16_t* XB = (bf16_t*)(ws + WS_RA); bf16_t* OA = (bf16_t*)(ws + WS_RA); bf16_t* OF = (bf16_t*)(ws + WS_RA + (size_t)M * 1024 * 2); bf16_t* H1B = (bf16_t*)(ws + WS_RA);
    bf16_t* QKV = (bf16_t*)(ws + WS_RB); float* TMP = (float*)(ws + WS_RB); bf16_t* MERGED = (bf16_t*)(ws + WS_RB + (size_t)M * DM * 4); bf16_t* ACT = (bf16_t*)(ws + WS_RB);
    bf16_t* GATES = (bf16_t*)(ws + WS_RG);
    float* RSTD1 = (float*)(ws + WS_RSTD1); float* SSQ2 = (float*)(ws + WS_SSQ2); float* SSQ3 = (float*)(ws + WS_SSQ3);
    float* LOGF = (float*)(ws + WS_LOGF); float* CUM = (float*)(ws + WS_CUM);
    const int lo = p.ph_lo, hi_ = p.ph_hi;
#define IN(k) (lo <= (k) && (k) < hi_)
#define SEAM(k) do { if (IN(k) && IN((k) + 1)) grid.sync(); } while (0)

    if (IN(0)) {
        const int lane = fresh_lane(), tid = wid * 64 + lane;
        float* tile = (float*)lds;
        const float* w_in = p.in[3];
        transpose_job(w_in, NINC, 0, 96, DM, W1T, -1, p.in[2], tile, tid);
        transpose_job(w_in, NINC, 6152, 64, DM, W1T + (size_t)6144 * DM, -1, p.in[2], tile, tid);
        transpose_job(p.in[10], DM, 0, 32, 1024, WAT, -1, nullptr, tile, tid);
        transpose_job(p.in[11], DM, 0, 32, 1024, WFT, -1, nullptr, tile, tid);
        transpose_job(p.in[12], DM, 0, 32, DM, WOT, -1, nullptr, tile, tid);
        transpose_job(p.in[14], DFF, 0, 88, DM, W5T, 0, p.in[13], tile, tid);
        transpose_job(p.in[15], DFF, 0, 88, DM, W5T, 1, p.in[13], tile, tid);
        transpose_job(p.in[16], DM, 0, 32, DFF, WDT, -1, nullptr, tile, tid);
        float* WF = (float*)lds;
        for (int k = tid; k < DM; k += 512) { const float g = p.in[2][k]; const f32x4 a = *(const f32x4*)(w_in + (size_t)k * NINC + 6144), b = *(const f32x4*)(w_in + (size_t)k * NINC + 6148);
#pragma unroll
            for (int j = 0; j < 4; ++j) { WF[j * DM + k] = a[j] * g; WF[(4 + j) * DM + k] = b[j] * g; } }
        __syncthreads();
        const float* x = p.in[0]; const float* meta = p.in[1]; const float* b_f = p.in[9];
        for (int row = bx * 8 + wid; row < M; row += G * 8) {
            const int b = row / LB, vp = row - b * LB;
            const float* src = vp >= 64 ? x + ((size_t)b * SEQ + (vp - 64)) * DM : meta + (size_t)(vp >= VPAD ? vp - VPAD : 0) * DM;
            f32x4 v[8]; float ss = 0.f; float zf[8];
#pragma unroll
            for (int j = 0; j < 8; ++j) zf[j] = 0.f;
#pragma unroll
            for (int i = 0; i < 8; ++i) { v[i] = *(const f32x4*)(src + i * 256 + lane * 4); if (vp < VPAD) v[i] = (f32x4){0.f, 0.f, 0.f, 0.f};
                ss += (v[i][0] * v[i][0] + v[i][1] * v[i][1]) + (v[i][2] * v[i][2] + v[i][3] * v[i][3]); }
#pragma unroll
            for (int i = 0; i < 8; ++i) {
                u32x2 w; w.x = pg8::cvt_pk_bf16(v[i][0], v[i][1]); w.y = pg8::cvt_pk_bf16(v[i][2], v[i][3]);
                *(u32x2*)(XB + (size_t)row * DM + i * 256 + lane * 4) = w;
#pragma unroll
                for (int j = 0; j < 8; ++j) { const f32x4 wv = *(const f32x4*)(WF + j * DM + i * 256 + lane * 4); zf[j] += (v[i][0] * wv[0] + v[i][1] * wv[1]) + (v[i][2] * wv[2] + v[i][3] * wv[3]); } }
            ss = wave_sum(ss);
#pragma unroll
            for (int j = 0; j < 8; ++j) zf[j] = wave_sum(zf[j]);
            const float rs = __builtin_amdgcn_rsqf(ss * (1.0f / 2048.0f) + 1e-6f);
            if (lane == 0) { RSTD1[row] = rs; SSQ2[row] = 0.f; SSQ3[row] = 0.f; }
            if (lane < 8) { float zz = zf[0];
#pragma unroll
                for (int j = 1; j < 8; ++j) zz = (lane == j) ? zf[j] : zz;
                const float y = zz * rs + b_f[lane];
                const float lf = fminf(y, 0.f) - log1pf(__expf(-fabsf(y)));
                LOGF[(size_t)(b * 8 + lane) * LB + vp] = vp >= VPAD ? lf : 0.f; }
        }
        __syncthreads();
    }
    SEAM(0);

    if (IN(1)) {
        const int lane = fresh_lane(), tid = wid * 64 + lane;
        if (bx < 32) {
            const float* srcp = LOGF + (size_t)bx * LB; float* dstp = CUM + (size_t)bx * LB; float* red = (float*)lds;
            const int i0 = tid * 17; float vals[17]; float s = 0.f;
#pragma unroll
            for (int i = 0; i < 17; ++i) { const int k = i0 + i; vals[i] = k < LB ? srcp[k] : 0.f; s += vals[i]; vals[i] = s; }
            float incl = s;
#pragma unroll
            for (int o = 1; o < 64; o <<= 1) { const float t = __shfl_up(incl, o); if (lane >= o) incl += t; }
            if (lane == 63) red[wid] = incl;
            __syncthreads();
            float base = incl - s;
            for (int w = 0; w < wid; ++w) base += red[w];
#pragma unroll
            for (int i = 0; i < 17; ++i) { const int k = i0 + i; if (k < LB) dstp[k] = (base + vals[i]) * 11.313708498984761f; }
            __syncthreads();
        }
        pg8::Gemm g{XB, W1T, M, N1, DM}; pg8::StaticOrder S; S.init(M, N1, G, bx);
        Epi1 E{QKV, GATES, RSTD1};
        pg8::gemm_phase<Epi1, pg8::StaticOrder>((PG8_LAS unsigned char*)lds, g, S, E, wid * 64 + fresh_lane());
    }
    SEAM(1);

    if (IN(2)) {
        const int lane = fresh_lane(), tid = wid * 64 + lane;
        float lam;
        { const float* q1 = p.in[4]; const float* k1 = p.in[5]; const float* q2 = p.in[6]; const float* k2 = p.in[7];
          float s1 = q1[lane] * k1[lane] + q1[lane + 64] * k1[lane + 64], s2 = q2[lane] * k2[lane] + q2[lane + 64] * k2[lane + 64];
          s1 = wave_sum(s1); s2 = wave_sum(s2); lam = __expf(s1) - __expf(s2) + 0.2f; lam = __uint_as_float(__builtin_amdgcn_readfirstlane(__float_as_uint(lam))); }
        const float* g_subln = p.in[8];
        float* scrT = (float*)(ws + WS_SCR + (size_t)bx * 262144); float* scrD = scrT + 32768;
        float* tabw = (float*)(lds + att::LDS_TAB);
        const int vcu = (G % 8 == 0) ? (bx % 8) * (G / 8) + bx / 8 : bx;
        const int nsi = (256 - vcu + G - 1) / G;
        const int nbp = nsi * 12;
        auto desc = [&](int bp) -> att::Blk {
            const int s = vcu + (bp / 12) * G, idx = bp % 12; att::Blk r;
            if (idx < 4) { const int pr = 2 * s + (idx >> 1), bh = pr >> 4, y = pr & 15, qb = (idx & 1) ? 31 - y : y, b = bh >> 3, h = bh & 7;
                const size_t rb = (size_t)b * LB; r.P0 = 64 + 256 * qb; r.mode = 0; r.s2 = 0.f;
                r.Q = QKV + ((size_t)(24 + h) * M + rb + r.P0) * 128; r.K = QKV + ((size_t)(32 + h) * M + rb) * 128; r.V = QKV + ((size_t)(40 + h) * M + rb) * 128;
                r.O = OF + (rb + r.P0) * 1024 + h * 128; }
            else { const int j = idx - 4, sel = j >> 2, pass = j & 3, e = pass >> 1, c = pass & 1, bh = s >> 4, y = s & 15, qb = sel ? 31 - y : y, b = bh >> 2, h = bh & 3;
                const size_t rb = (size_t)b * LB; r.P0 = 64 + 256 * qb; r.mode = (c == 0) ? 1 : (e == 0 ? 2 : 3);
                r.s2 = 2.0f * 11.313708498984761f * (h == 0 ? 0.25f : h == 1 ? 0.0625f : h == 2 ? 0.015625f : 0.00390625f);
                r.Q = QKV + ((size_t)(2 * h + c) * M + rb + r.P0) * 128; r.K = QKV + ((size_t)(8 + 2 * h + c) * M + rb) * 128; r.V = QKV + ((size_t)(16 + 2 * h + e) * M + rb) * 128;
                r.O = OA + (rb + r.P0) * 1024 + h * 256; }
            return r; };
        if (nbp > 0) {
            att::Seam S;
            att::Blk cur = desc(0);
            att::attn_prime(cur, (char*)lds, S, wid * 64 + fresh_lane());
            for (int bp = 0; bp < nbp; ++bp) {
                const att::Blk nxt = desc(bp + 1 < nbp ? bp + 1 : bp);
                { const int s = vcu + (bp / 12) * G, idx = bp % 12; const int nk = cur.P0 + 256; const int tt = wid * 64 + fresh_lane();
                  if (idx < 4) { const int pr = 2 * s + (idx >> 1), bh = pr >> 4; const float* cm = CUM + (size_t)bh * LB; const float cref = cm[cur.P0];
                      for (int k = tt; k < nk; k += 512) tabw[k] = cref - cm[k]; }
                  else { const float sl = 0.5f * cur.s2; for (int k = tt; k < nk; k += 512) tabw[k] = sl * (float)(k - cur.P0); } }
                __syncthreads();
                att::attn_block(cur, nxt, (char*)lds, S, lam, scrT, scrD, g_subln, wid * 64 + fresh_lane());
                cur = nxt;
            }
        }
        asm volatile("s_waitcnt vmcnt(0)" ::: "memory");
        __syncthreads();
    }
    SEAM(2);

    if (IN(3)) {
        { pg8::Gemm g{OA, WAT, M, DM, 1024}; pg8::StaticOrder S; S.init(M, DM, G, bx); Epi3a E{TMP, GATES};
          pg8::gemm_phase<Epi3a, pg8::StaticOrder>((PG8_LAS unsigned char*)lds, g, S, E, wid * 64 + fresh_lane()); }
        { pg8::Gemm g{OF, WFT, M, DM, 1024}; pg8::StaticOrder S; S.init(M, DM, G, bx); Epi3b E{TMP, GATES, MERGED};
          pg8::gemm_phase<Epi3b, pg8::StaticOrder>((PG8_LAS unsigned char*)lds, g, S, E, wid * 64 + fresh_lane()); }
    }
    SEAM(3);

    if (IN(4)) {
        pg8::Gemm g{MERGED, WOT, M, DM, DM}; pg8::StaticOrder S; S.init(M, DM, G, bx); Epi4 E{p.in[0], p.out, H1B, SSQ2};
        pg8::gemm_phase<Epi4, pg8::StaticOrder>((PG8_LAS unsigned char*)lds, g, S, E, wid * 64 + fresh_lane());
    }
    SEAM(4);

    if (IN(5)) {
        pg8::Gemm g{H1B, W5T, M, N5, DM}; pg8::StaticOrder S; S.init(M, N5, G, bx); Epi5 E{SSQ2, ACT};
        pg8::gemm_phase<Epi5, pg8::StaticOrder>((PG8_LAS unsigned char*)lds, g, S, E, wid * 64 + fresh_lane());
    }
    SEAM(5);

    if (IN(6)) {
        pg8::Gemm g{ACT, WDT, M, DM, DFF}; pg8::StaticOrder S; S.init(M, DM, G, bx); Epi6 E{p.out, SSQ3};
        pg8::gemm_phase<Epi6, pg8::StaticOrder>((PG8_LAS unsigned char*)lds, g, S, E, wid * 64 + fresh_lane());
    }
    SEAM(6);

    if (IN(7)) {
        const int lane = fresh_lane();
        const float* gfin = p.in[17];
        f32x4 gv[8];
#pragma unroll
        for (int i = 0; i < 8; ++i) gv[i] = *(const f32x4*)(gfin + i * 256 + lane * 4);
        for (int orow = bx * 8 + wid; orow < NBATCH * SEQ; orow += G * 8) {
            const int b = orow / SEQ, t = orow - b * SEQ; const int row = b * LB + 64 + t;
            const float rs = __builtin_amdgcn_rsqf(SSQ3[row] * (1.0f / 2048.0f) + 1e-6f);
            float* d = p.out + (size_t)orow * DM + lane * 4;
#pragma unroll
            for (int i = 0; i < 8; ++i) { const f32x4 v = *(const f32x4*)(d + i * 256); *(f32x4*)(d + i * 256) = v * rs * gv[i]; }
        }
    }
#undef IN
#undef SEAM
}

extern "C" void kernel_launch(void* const* d_in, const int* in_sizes, int n_in, void* d_out, int out_size, void* d_ws, size_t ws_size, hipStream_t stream) {
    static int grid = 0;
    if (grid == 0) {
        if (n_in != 18 || ws_size < WS_END) { fprintf(stderr, "kernel_launch: need 18 inputs and >= %zu bytes of workspace (got %d, %zu)\n", (size_t)WS_END, n_in, ws_size); grid = -1; return; }
        int dev = 0, cus = 0, per_cu = 0;
        (void)hipGetDevice(&dev);
        if (hipDeviceGetAttribute(&cus, hipDeviceAttributeMultiprocessorCount, dev) != hipSuccess || cus <= 0) cus = 256;
        if (hipFuncSetAttribute((const void*)fwd_kernel, hipFuncAttributeMaxDynamicSharedMemorySize, LDS_BYTES) != hipSuccess) { fprintf(stderr, "kernel_launch: hipFuncSetAttribute failed\n"); }
        if (hipOccupancyMaxActiveBlocksPerMultiprocessor(&per_cu, (const void*)fwd_kernel, 512, LDS_BYTES) != hipSuccess || per_cu < 1) { fprintf(stderr, "kernel_launch: occupancy query says %d\n", per_cu); per_cu = 1; }
        (void)hipGetLastError();
        grid = cus * 1;
        if (grid > 256) grid = 256;
    }
    if (grid < 0) return;
    Params p{};
    for (int i = 0; i < 18; ++i) p.in[i] = (const float*)d_in[i];
    p.out = (float*)d_out; p.ws = (unsigned char*)d_ws;
#if ONE_LAUNCH
    p.ph_lo = 0; p.ph_hi = 8;
    void* args[] = {&p};
    hipError_t e = hipLaunchCooperativeKernel((const void*)fwd_kernel, dim3(grid), dim3(512), args, LDS_BYTES, stream);
    if (e != hipSuccess) fprintf(stderr, "cooperative launch failed: %s (grid %d)\n", hipGetErrorString(e), grid);
#else
    for (int ph = 0; ph < 8; ++ph) { p.ph_lo = ph; p.ph_hi = ph + 1; hipLaunchKernelGGL(fwd_kernel, dim3(grid), dim3(512), LDS_BYTES, stream, p); }
#endif
}
```

```cpp
#include <hip/hip_runtime.h>
#include <hip/hip_cooperative_groups.h>
#include <cstdio>
#include <cstdint>
namespace cg = cooperative_groups;

#ifndef REP_PHASE
#define REP_PHASE -1
#endif
#ifndef ONE_LAUNCH
#define ONE_LAUNCH 1
#endif

typedef unsigned short bf16_t;
typedef short bf16x8 __attribute__((ext_vector_type(8)));
typedef short s16x4 __attribute__((ext_vector_type(4)));
typedef float f32x4 __attribute__((ext_vector_type(4)));
typedef float f32x16 __attribute__((ext_vector_type(16)));
typedef unsigned u32x4 __attribute__((ext_vector_type(4)));
typedef unsigned u32x2 __attribute__((ext_vector_type(2)));

constexpr int DM = 2048, NBATCH = 4, SEQ = 8192, NMETA = 16;
constexpr int VPAD = 48;
constexpr int LB = 8256;
constexpr int M = NBATCH * SEQ;
constexpr int MQ = M + 64;
constexpr int NINC = 10248;
constexpr int N1 = 10240;
constexpr int DFF = 5632, N5 = 2 * DFF;
constexpr int NHD = 48;

constexpr size_t SZ_W1T = (size_t)N1 * DM * 2, SZ_WAT = (size_t)DM * 1024 * 2, SZ_WOT = (size_t)DM * DM * 2, SZ_W5T = (size_t)N5 * DM * 2, SZ_WDT = (size_t)DM * DFF * 2;
constexpr size_t WS_W1T = 0, WS_WAT = WS_W1T + SZ_W1T, WS_WFT = WS_WAT + SZ_WAT, WS_WOT = WS_WFT + SZ_WAT, WS_W5T = WS_WOT + SZ_WOT, WS_WDT = WS_W5T + SZ_W5T;
constexpr size_t WS_RA = WS_WDT + SZ_WDT;
constexpr size_t SZ_RA = (size_t)MQ * DM * 2;
constexpr size_t WS_RB = WS_RA + SZ_RA;
constexpr size_t SZ_RB = (size_t)NHD * MQ * 128 * 2;
constexpr size_t WS_RG = WS_RB + SZ_RB;
constexpr size_t SZ_RG = (size_t)M * 4096 * 2;
constexpr size_t WS_RSTD1 = WS_RG + SZ_RG, WS_SSQ2 = WS_RSTD1 + (size_t)MQ * 4, WS_SSQ3 = WS_SSQ2 + (size_t)M * 4;
constexpr size_t WS_LOGF = WS_SSQ3 + (size_t)M * 4, WS_CUM = WS_LOGF + (size_t)32 * LB * 4;
constexpr size_t WS_SCR = WS_CUM + (size_t)32 * LB * 4;
constexpr size_t WS_END = WS_SCR + (size_t)256 * 262144;
constexpr int LDS_BYTES = 131072;

namespace pg8 {
#define PG8_LAS __attribute__((address_space(3)))
constexpr int BM = 256, BK = 64, HALF = 128, HTB = HALF * BK * 2, STAGE_BYTES = 8 * HTB, NXCD = 8, WGM = 8;
__host__ __device__ __forceinline__ int lds_byte(int r, int c) { const int st = (r >> 4) * 2 + (c >> 5), rr = r & 15, cc = c & 31, ob = rr * 64 + cc * 2; return st * 1024 + (ob ^ (((ob >> 9) & 1) << 5)); }
__host__ __device__ __forceinline__ void stage_rc(int b, int& R, int& C) { const int st = b / 1024, sb = b % 1024, swz = sb ^ (((sb >> 9) & 1) << 5); R = (st >> 1) * 16 + swz / 64; C = (st & 1) * 32 + (swz % 64) / 2; }
__host__ __device__ __forceinline__ int perm32(int rho) { const int n = rho >> 4, i = rho & 15; return 8 * (i >> 2) + 4 * n + (i & 3); }
struct Unit { int pm, pn; };
struct Gemm { const bf16_t* A; const bf16_t* Bt; int M, N, K; };
struct StaticOrder {
    int nM, nN, nwg, G, c;
    __host__ __device__ void init(int M_, int N_, int G_, int c_) { nM = M_ / BM; nN = N_ / BM; nwg = nM * nN; G = G_; c = c_; }
    __host__ __device__ bool next(int i, Unit& u) const {
        const long L = (long)i * G + c; if (L >= nwg) return false;
        int wgid = (int)L; { const int q = nwg / NXCD, r = nwg % NXCD, xcd = wgid % NXCD, off = wgid / NXCD; wgid = (xcd < r ? xcd * (q + 1) : r * (q + 1) + (xcd - r) * q) + off; }
        const int nig = WGM * nN, gid = wgid / nig, fm = gid * WGM, gsz = (nM - fm) < WGM ? (nM - fm) : WGM;
        u.pm = fm + ((wgid % nig) % gsz); u.pn = (wgid % nig) / gsz; return true;
    }
    __device__ __forceinline__ void a_ready(const Unit&) const {}
    __device__ __forceinline__ void done(const Unit&) const {}
};
__device__ __forceinline__ unsigned cvt_pk_bf16(float lo, float hi) { unsigned r; asm volatile("v_cvt_pk_bf16_f32 %0, %1, %2" : "=v"(r) : "v"(lo), "v"(hi)); return r; }

template <class Epi, class Sched>
__device__ __forceinline__ void gemm_phase(PG8_LAS unsigned char* lds, const Gemm g, const Sched& S, const Epi& E, const int tid) {
    const int wid = __builtin_amdgcn_readfirstlane(tid >> 6), lane = tid & 63, wr = wid >> 2, wc = wid & 3, fr = lane & 15, fq = lane >> 4;
    const int K = g.K, nt = K / BK;
    unsigned voffA[2], voffB[2];
#pragma unroll
    for (int i = 0; i < 2; ++i) { int R, C; stage_rc(tid * 16 + i * 8192, R, C); const int Rb = Epi::PERM ? ((R & ~31) + perm32(R & 31)) : R;
        voffA[i] = (unsigned)(R * K + C) * 2u; voffB[i] = (unsigned)(Rb * K + C) * 2u; }
    const size_t kstep = (size_t)(BK * 2);
    const size_t hstep = (size_t)HALF * K * 2;
    const size_t tstep = 2 * hstep;
    const unsigned ldsw = (unsigned)wid * 1024u;
    const int aoff = lds_byte(wr * 64 + fr, fq * 8), boff = lds_byte(wc * 32 + fr, fq * 8);
#define PG8_SA(b, h) (((b) * 2 + (h)) * HTB)
#define PG8_SB(b, h) ((4 + (b) * 2 + (h)) * HTB)
#define PG8_STAGE(bufoff, gbase, voff) do { _Pragma("unroll") for (int _i = 0; _i < 2; ++_i) \
        __builtin_amdgcn_global_load_lds((const unsigned*)((const char*)(gbase) + (voff)[_i]), (PG8_LAS unsigned*)(lds + (bufoff) + ldsw + _i * 8192), 16, 0, 0); } while (0)
#define PG8_LDA(dst, b, h) do { _Pragma("unroll") for (int m = 0; m < 4; ++m) _Pragma("unroll") for (int k = 0; k < 2; ++k) dst[m][k] = *(const PG8_LAS bf16x8*)(lds + PG8_SA(b, h) + aoff + m * 2048 + k * 1024); } while (0)
#define PG8_LDB(dst, b, h) do { _Pragma("unroll") for (int n = 0; n < 2; ++n) _Pragma("unroll") for (int k = 0; k < 2; ++k) dst[n][k] = *(const PG8_LAS bf16x8*)(lds + PG8_SB(b, h) + boff + n * 2048 + k * 1024); } while (0)
#define PG8_MMA(ai, bj, At, Bt) do { __builtin_amdgcn_s_setprio(1); _Pragma("unroll") for (int m = 0; m < 4; ++m) _Pragma("unroll") for (int n = 0; n < 2; ++n) _Pragma("unroll") for (int k = 0; k < 2; ++k) \
        acc[ai][bj][m][n] = __builtin_amdgcn_mfma_f32_16x16x32_bf16(Bt[n][k], At[m][k], acc[ai][bj][m][n], 0, 0, 0); __builtin_amdgcn_s_setprio(0); } while (0)
#define PG8_WAIT_V(n) asm volatile("s_waitcnt vmcnt(" #n ")" ::: "memory")
#define PG8_WAIT_L(n) asm volatile("s_waitcnt lgkmcnt(" #n ")" ::: "memory")
#define PG8_BAR __builtin_amdgcn_s_barrier()
#define PG8_SCHED __builtin_amdgcn_sched_barrier(0)
    Unit cur, nxt; int ui = 0;
    if (!S.next(0, cur)) return;
    f32x4 acc[2][2][4][2];
#pragma unroll
    for (int a = 0; a < 2; ++a)
#pragma unroll
        for (int b = 0; b < 2; ++b)
#pragma unroll
            for (int m = 0; m < 4; ++m)
#pragma unroll
                for (int n = 0; n < 2; ++n) acc[a][b][m][n] = (f32x4){0.f, 0.f, 0.f, 0.f};
    bf16x8 At[4][2], B0[2][2], B1[2][2];
    const char* cA = (const char*)g.A + (size_t)cur.pm * tstep; const char* cB = (const char*)g.Bt + (size_t)cur.pn * tstep;
    S.a_ready(cur);
    PG8_STAGE(PG8_SB(0, 0), cB, voffB); PG8_STAGE(PG8_SA(0, 0), cA, voffA); PG8_STAGE(PG8_SB(0, 1), cB + hstep, voffB); PG8_STAGE(PG8_SA(0, 1), cA + hstep, voffA);
    if (wr == 1) PG8_BAR;
    PG8_WAIT_V(4); PG8_BAR;
    PG8_STAGE(PG8_SB(1, 0), cB + kstep, voffB); PG8_STAGE(PG8_SA(1, 0), cA + kstep, voffA); PG8_STAGE(PG8_SB(1, 1), cB + hstep + kstep, voffB);
    PG8_WAIT_V(6); PG8_BAR;
    for (;;) {
        const bool has_next = S.next(ui + 1, nxt);
        const char* nA = has_next ? (const char*)g.A + (size_t)nxt.pm * tstep : cA; const char* nB = has_next ? (const char*)g.Bt + (size_t)nxt.pn * tstep : cB;
        for (int t = 0; t < nt; t += 2) {
            const bool last = (t == nt - 2);
            const char* a1 = cA + (size_t)(t + 1) * kstep;
            const char* a2 = last ? nA : cA + (size_t)(t + 2) * kstep; const char* b2 = last ? nB : cB + (size_t)(t + 2) * kstep;
            const char* a3 = a2 + kstep; const char* b3 = b2 + kstep;
            if (last && has_next) S.a_ready(nxt);
            PG8_LDB(B0, 0, 0); PG8_SCHED; PG8_LDA(At, 0, 0); PG8_STAGE(PG8_SA(1, 1), a1 + hstep, voffA);
            PG8_WAIT_L(8); PG8_BAR; PG8_WAIT_L(0); PG8_MMA(0, 0, At, B0); PG8_BAR; PG8_SCHED;
            PG8_LDB(B1, 0, 1); PG8_STAGE(PG8_SB(0, 0), b2, voffB);
            PG8_BAR; PG8_WAIT_L(0); PG8_MMA(0, 1, At, B1); PG8_BAR;
            PG8_LDA(At, 0, 1); PG8_STAGE(PG8_SA(0, 0), a2, voffA);
            PG8_BAR; PG8_WAIT_L(0); PG8_MMA(1, 0, At, B0); PG8_BAR; PG8_SCHED;
            PG8_STAGE(PG8_SB(0, 1), b2 + hstep, voffB);
            PG8_WAIT_V(6); PG8_BAR; PG8_MMA(1, 1, At, B1); PG8_BAR;
            PG8_LDB(B0, 1, 0); PG8_SCHED; PG8_LDA(At, 1, 0); PG8_STAGE(PG8_SA(0, 1), a2 + hstep, voffA);
            PG8_WAIT_L(8); PG8_BAR; PG8_WAIT_L(0); PG8_MMA(0, 0, At, B0); PG8_BAR; PG8_SCHED;
            PG8_LDB(B1, 1, 1); PG8_STAGE(PG8_SB(1, 0), b3, voffB);
            PG8_BAR; PG8_WAIT_L(0); PG8_MMA(0, 1, At, B1); PG8_BAR;
            PG8_LDA(At, 1, 1); PG8_STAGE(PG8_SA(1, 0), a3, voffA);
            PG8_BAR; PG8_WAIT_L(0); PG8_MMA(1, 0, At, B0); PG8_BAR; PG8_SCHED;
            PG8_STAGE(PG8_SB(1, 1), b3 + hstep, voffB);
            PG8_WAIT_V(6); PG8_BAR; PG8_MMA(1, 1, At, B1); PG8_BAR;
        }
        E(acc, cur, wr, wc, fr, fq); S.done(cur);
        if (!has_next) break;
#pragma unroll
        for (int a = 0; a < 2; ++a)
#pragma unroll
            for (int b = 0; b < 2; ++b)
#pragma unroll
                for (int m = 0; m < 4; ++m)
#pragma unroll
                    for (int n = 0; n < 2; ++n) acc[a][b][m][n] = (f32x4){0.f, 0.f, 0.f, 0.f};
        cur = nxt; cA = nA; cB = nB; ++ui;
    }
    PG8_WAIT_V(0);
    if (wr == 0) PG8_BAR;
    PG8_BAR;
#undef PG8_SA
#undef PG8_SB
#undef PG8_STAGE
#undef PG8_LDA
#undef PG8_LDB
#undef PG8_MMA
#undef PG8_WAIT_V
#undef PG8_WAIT_L
#undef PG8_BAR
#undef PG8_SCHED
}
}

__device__ __forceinline__ int fresh_lane() { int l; asm volatile("v_mbcnt_lo_u32_b32 %0, -1, 0\n\tv_mbcnt_hi_u32_b32 %0, -1, %0" : "=v"(l)); return l; }
__device__ __forceinline__ float bf2f(unsigned short b) { return __uint_as_float(((unsigned)b) << 16); }
__device__ __forceinline__ float sigmoidf_(float x) { return __builtin_amdgcn_rcpf(1.0f + __builtin_amdgcn_exp2f(-1.4426950408889634f * x)); }
__device__ __forceinline__ u32x4 pack8u(f32x4 a, f32x4 b) { u32x4 w = {pg8::cvt_pk_bf16(a[0], a[1]), pg8::cvt_pk_bf16(a[2], a[3]), pg8::cvt_pk_bf16(b[0], b[1]), pg8::cvt_pk_bf16(b[2], b[3])}; return w; }
__device__ __forceinline__ void unpack8(u32x4 w, f32x4& a, f32x4& b) {
    a = (f32x4){__uint_as_float(w.x << 16), __uint_as_float(w.x & 0xffff0000u), __uint_as_float(w.y << 16), __uint_as_float(w.y & 0xffff0000u)};
    b = (f32x4){__uint_as_float(w.z << 16), __uint_as_float(w.z & 0xffff0000u), __uint_as_float(w.w << 16), __uint_as_float(w.w & 0xffff0000u)};
}
__device__ __forceinline__ float wave_sum(float v) {
#pragma unroll
    for (int o = 32; o >= 1; o >>= 1) v += __shfl_xor(v, o);
    return v;
}

typedef f32x4 Acc[2][2][4][2];
struct Epi1 { static constexpr bool PERM = true;
    bf16_t* QKV; bf16_t* GATES; const float* rstd;
    __device__ __forceinline__ void operator()(const Acc& acc, const pg8::Unit& u, int wr, int wc, int fr, int fq) const {
        const int row0 = u.pm * 256 + wr * 64 + fr;
        if (u.pn < 24) {
#pragma unroll
            for (int ai = 0; ai < 2; ++ai)
#pragma unroll
                for (int m = 0; m < 4; ++m) { const int row = row0 + ai * 128 + m * 16; const float rs = rstd[row];
#pragma unroll
                    for (int bj = 0; bj < 2; ++bj) { bf16_t* dst = QKV + ((size_t)(2 * u.pn + bj) * MQ + row) * 128 + wc * 32 + 8 * fq;
                        *(u32x4*)dst = pack8u(acc[ai][bj][m][0] * rs, acc[ai][bj][m][1] * rs); } }
        } else {
            const int colb = (u.pn - 24) * 256 + wc * 32 + 8 * fq;
#pragma unroll
            for (int ai = 0; ai < 2; ++ai)
#pragma unroll
                for (int m = 0; m < 4; ++m) { const int row = row0 + ai * 128 + m * 16; const float rs = rstd[row];
#pragma unroll
                    for (int bj = 0; bj < 2; ++bj) { f32x4 v0 = acc[ai][bj][m][0] * rs, v1 = acc[ai][bj][m][1] * rs;
#pragma unroll
                        for (int j = 0; j < 4; ++j) { v0[j] = sigmoidf_(v0[j]); v1[j] = sigmoidf_(v1[j]); }
                        *(u32x4*)(GATES + (size_t)row * 4096 + colb + bj * 128) = pack8u(v0, v1); } }
        }
    }
};
struct Epi3a { static constexpr bool PERM = true;
    float* TMP; const bf16_t* GATES;
    __device__ __forceinline__ void operator()(const Acc& acc, const pg8::Unit& u, int wr, int wc, int fr, int fq) const {
        const int row0 = u.pm * 256 + wr * 64 + fr, col0 = u.pn * 256 + wc * 32 + 8 * fq;
#pragma unroll
        for (int ai = 0; ai < 2; ++ai)
#pragma unroll
            for (int m = 0; m < 4; ++m) { const int row = row0 + ai * 128 + m * 16;
#pragma unroll
                for (int bj = 0; bj < 2; ++bj) { const int col = col0 + bj * 128; f32x4 g0, g1; unpack8(*(const u32x4*)(GATES + (size_t)row * 4096 + col), g0, g1);
                    float* d = TMP + (size_t)row * DM + col; *(f32x4*)d = acc[ai][bj][m][0] * g0; *(f32x4*)(d + 4) = acc[ai][bj][m][1] * g1; } }
    }
};
struct Epi3b { static constexpr bool PERM = true;
    const float* TMP; const bf16_t* GATES; bf16_t* MERGED;
    __device__ __forceinline__ void operator()(const Acc& acc, const pg8::Unit& u, int wr, int wc, int fr, int fq) const {
        const int row0 = u.pm * 256 + wr * 64 + fr, col0 = u.pn * 256 + wc * 32 + 8 * fq;
#pragma unroll
        for (int ai = 0; ai < 2; ++ai)
#pragma unroll
            for (int m = 0; m < 4; ++m) { const int row = row0 + ai * 128 + m * 16;
#pragma unroll
                for (int bj = 0; bj < 2; ++bj) { const int col = col0 + bj * 128; f32x4 g0, g1; unpack8(*(const u32x4*)(GATES + (size_t)row * 4096 + 2048 + col), g0, g1);
                    const float* s = TMP + (size_t)row * DM + col; const f32x4 t0 = *(const f32x4*)s, t1 = *(const f32x4*)(s + 4);
                    *(u32x4*)(MERGED + (size_t)row * DM + col) = pack8u(t0 + acc[ai][bj][m][0] * g0, t1 + acc[ai][bj][m][1] * g1); } }
    }
};
struct Epi4 { static constexpr bool PERM = true;
    const float* x; float* out; bf16_t* H1B; float* ssq;
    __device__ __forceinline__ void operator()(const Acc& acc, const pg8::Unit& u, int wr, int wc, int fr, int fq) const {
        const int row0 = u.pm * 256 + wr * 64 + fr, col0 = u.pn * 256 + wc * 32 + 8 * fq;
#pragma unroll
        for (int ai = 0; ai < 2; ++ai)
#pragma unroll
            for (int m = 0; m < 4; ++m) { const int row = row0 + ai * 128 + m * 16; const size_t orow = (size_t)row; float ss = 0.f;
#pragma unroll
                    for (int bj = 0; bj < 2; ++bj) { const int col = col0 + bj * 128; const float* xs = x + orow * DM + col;
                        const f32x4 h0 = *(const f32x4*)xs + acc[ai][bj][m][0], h1 = *(const f32x4*)(xs + 4) + acc[ai][bj][m][1];
                        float* d = out + orow * DM + col; *(f32x4*)d = h0; *(f32x4*)(d + 4) = h1;
                        *(u32x4*)(H1B + (size_t)row * DM + col) = pack8u(h0, h1);
                        ss += (h0[0] * h0[0] + h0[1] * h0[1]) + (h0[2] * h0[2] + h0[3] * h0[3]) + (h1[0] * h1[0] + h1[1] * h1[1]) + (h1[2] * h1[2] + h1[3] * h1[3]); }
                    ss += __shfl_xor(ss, 16); ss += __shfl_xor(ss, 32);
                    if (fq == 0) unsafeAtomicAdd(ssq + row, ss); }
    }
};
struct Epi5 { static constexpr bool PERM = true;
    const float* ssq; bf16_t* ACT;
    __device__ __forceinline__ void operator()(const Acc& acc, const pg8::Unit& u, int wr, int wc, int fr, int fq) const {
        const int row0 = u.pm * 256 + wr * 64 + fr, col0 = u.pn * 128 + wc * 32 + 8 * fq;
#pragma unroll
        for (int ai = 0; ai < 2; ++ai)
#pragma unroll
            for (int m = 0; m < 4; ++m) { const int row = row0 + ai * 128 + m * 16; const float rs = __builtin_amdgcn_rsqf(ssq[row] * (1.0f / 2048.0f) + 1e-6f);
                f32x4 o[2];
#pragma unroll
                for (int n = 0; n < 2; ++n) { const f32x4 g = acc[ai][0][m][n] * rs, up = acc[ai][1][m][n] * rs;
#pragma unroll
                    for (int j = 0; j < 4; ++j) o[n][j] = g[j] * sigmoidf_(g[j]) * up[j]; }
                *(u32x4*)(ACT + (size_t)row * DFF + col0) = pack8u(o[0], o[1]); }
    }
};
struct Epi6 { static constexpr bool PERM = true;
    float* out; float* ssq;
    __device__ __forceinline__ void operator()(const Acc& acc, const pg8::Unit& u, int wr, int wc, int fr, int fq) const {
        const int row0 = u.pm * 256 + wr * 64 + fr, col0 = u.pn * 256 + wc * 32 + 8 * fq;
#pragma unroll
        for (int ai = 0; ai < 2; ++ai)
#pragma unroll
            for (int m = 0; m < 4; ++m) { const int row = row0 + ai * 128 + m * 16; const size_t orow = (size_t)row; float ss = 0.f;
#pragma unroll
                    for (int bj = 0; bj < 2; ++bj) { const int col = col0 + bj * 128; float* d = out + orow * DM + col;
                        const f32x4 h0 = *(const f32x4*)d + acc[ai][bj][m][0], h1 = *(const f32x4*)(d + 4) + acc[ai][bj][m][1];
                        *(f32x4*)d = h0; *(f32x4*)(d + 4) = h1;
                        ss += (h0[0] * h0[0] + h0[1] * h0[1]) + (h0[2] * h0[2] + h0[3] * h0[3]) + (h1[0] * h1[0] + h1[1] * h1[1]) + (h1[2] * h1[2] + h1[3] * h1[3]); }
                    ss += __shfl_xor(ss, 16); ss += __shfl_xor(ss, 32);
                    if (fq == 0) unsafeAtomicAdd(ssq + row, ss); }
    }
};

namespace att {
constexpr int D = 128, NW = 8, QBLK = 32, KVBLK = 64, QB = 256;
constexpr int SHM_V = KVBLK * D * 2, SHM_K = KVBLK * D * 2;
constexpr int LDS_WS = 2 * SHM_V + 2 * SHM_K;
constexpr int LDS_TAB = LDS_WS + NW * 64 * 4;
constexpr float SCALE = 0.08838834764831845f;
constexpr float THR = 8.f;
#define KSWZ(row, colB) ((row) * 256 + ((colB) ^ (((row) & 7) << 4)))
#define SBAR() __builtin_amdgcn_sched_barrier(0)
__device__ __forceinline__ int v_st(int k, int c) { const int kk = (k & ~0xC) | ((k & 4) << 1) | ((k & 8) >> 1); return ((kk >> 3) * 4 + (c >> 5)) * 512 + ((kk & 7) * 32 + (c & 31)) * 2; }
__device__ __forceinline__ int v_rd_base(int lane) { return ((lane & 3) << 3) | (((lane >> 2) & 3) << 6) | (((lane >> 4) & 1) << 5) | (((lane >> 5) & 1) << 8); }
constexpr int v_rd_off(int d0, int ks, int half) { return d0 * 512 + ks * 4096 + half * 2048; }
__device__ __forceinline__ int crow(int r, int hi) { return (r & 3) + 8 * (r >> 2) + 4 * hi; }
__device__ __forceinline__ unsigned cvtpk(float lo, float hi) { unsigned r; asm volatile("v_cvt_pk_bf16_f32 %0, %1, %2" : "=v"(r) : "v"(lo), "v"(hi)); return r; }
__device__ __forceinline__ bf16x8 load8(const bf16_t* p) { return *reinterpret_cast<const bf16x8*>(p); }
__device__ __forceinline__ void mask_tile(f32x16& p0, f32x16& p1, int dqe, int dqt, unsigned W, float s2) {
    const float NEG = -__builtin_inff();
#pragma unroll
    for (int r = 0; r < 16; ++r) {
        const int c = (r & 3) + 8 * (r >> 2);
        const int a0 = c - dqt, a1 = c + 32 - dqt;
        p0[r] -= s2 * (float)(a0 > 0 ? a0 : 0);
        p1[r] -= s2 * (float)(a1 > 0 ? a1 : 0);
        if ((unsigned)(dqe - c) >= W) p0[r] = NEG;
        if ((unsigned)(dqe - c - 32) >= W) p1[r] = NEG;
    }
}
__device__ __forceinline__ void partialSM(f32x16& p0, f32x16& p1, float& m_reg, float& mn, float& alpha) {
    float pmax = p0[0]; for (int r = 1; r < 16; ++r) pmax = fmaxf(pmax, p0[r]); for (int r = 0; r < 16; ++r) pmax = fmaxf(pmax, p1[r]);
    { auto rr = __builtin_amdgcn_permlane32_swap(__float_as_uint(pmax), __float_as_uint(pmax), false, false);
      pmax = fmaxf(__uint_as_float(rr[0]), __uint_as_float(rr[1])); }
    constexpr float C2 = 1.4426950408889634f * SCALE;
    if (__builtin_expect(__all((pmax - m_reg) * SCALE <= THR), 1)) { mn = m_reg; alpha = 1.f; }
    else { mn = fmaxf(m_reg, pmax); alpha = __builtin_amdgcn_exp2f((m_reg - mn) * C2); m_reg = mn; }
    const float mnL = -mn * C2;
    for (int r = 0; r < 16; ++r) p0[r] = fmaf(p0[r], C2, mnL); for (int r = 0; r < 16; ++r) p1[r] = fmaf(p1[r], C2, mnL);
    for (int r = 0; r < 16; ++r) p0[r] = __builtin_amdgcn_exp2f(p0[r]);
}
__device__ __forceinline__ void finishSM(f32x16& p0, f32x16& p1, float alpha, float& l_reg, bf16x8& pa0, bf16x8& pa1, bf16x8& pa2, bf16x8& pa3) {
    for (int r = 0; r < 16; ++r) p1[r] = __builtin_amdgcn_exp2f(p1[r]);
    float ps = 0; for (int r = 0; r < 16; ++r) ps += p0[r]; for (int r = 0; r < 16; ++r) ps += p1[r];
    { auto rr = __builtin_amdgcn_permlane32_swap(__float_as_uint(ps), __float_as_uint(ps), false, false);
      ps = __uint_as_float(rr[0]) + __uint_as_float(rr[1]); }
    l_reg = l_reg * alpha + ps;
#define PK4(P, B_, OUT) do { unsigned a0 = cvtpk(P[B_+0], P[B_+1]), a1 = cvtpk(P[B_+2], P[B_+3]);                          \
        unsigned b0 = cvtpk(P[B_+4], P[B_+5]), b1 = cvtpk(P[B_+6], P[B_+7]);                                             \
        auto r0 = __builtin_amdgcn_permlane32_swap(a0, b0, false, false); auto r1 = __builtin_amdgcn_permlane32_swap(a1, b1, false, false); \
        u32x4 w = {r0[0], r1[0], r0[1], r1[1]}; OUT = *reinterpret_cast<bf16x8*>(&w); } while (0)
    PK4(p0, 0, pa0); PK4(p0, 8, pa1); PK4(p1, 0, pa2); PK4(p1, 8, pa3);
#undef PK4
}
template <int KB>
__device__ __forceinline__ void qkt(f32x16& p0, f32x16& p1, const char* K_lds, int r32, int hi, const bf16x8* qr) {
    p0 = f32x16{}; p1 = f32x16{};
    const char* kb[4];
#pragma unroll
    for (int dd = 0; dd < 4; ++dd) kb[dd] = K_lds + KB * SHM_K + KSWZ(r32, (dd * 16 + hi * 8) * 2);
#pragma unroll
    for (int d0 = 0; d0 < 8; ++d0) { const char* a = kb[d0 & 3] + (d0 >> 2) * 128;
        bf16x8 b0 = *reinterpret_cast<const bf16x8*>(a);
        bf16x8 b1 = *reinterpret_cast<const bf16x8*>(a + 32 * 256);
        p0 = __builtin_amdgcn_mfma_f32_32x32x16_bf16(b0, qr[d0], p0, 0, 0, 0);
        p1 = __builtin_amdgcn_mfma_f32_32x32x16_bf16(b1, qr[d0], p1, 0, 0, 0); }
}
template <int VB>
__device__ __forceinline__ void pv_tile(f32x16* o, int vb0, bf16x8 pa0, bf16x8 pa1, bf16x8 pa2, bf16x8 pa3) {
#define TRRD(dst, off) asm volatile("ds_read_b64_tr_b16 %0, %1 offset:%2" : "=&v"(dst) : "v"(vb0), "i"(off) : "memory")
#define PV_D0(d0) do { s16x4 l0, l1, l2, l3, h0, h1, h2, h3; constexpr int b_ = VB * SHM_V + v_rd_off(d0, 0, 0); \
        TRRD(l0, b_); TRRD(h0, b_ + 2048); TRRD(l1, b_ + 4096); TRRD(h1, b_ + 6144); TRRD(l2, b_ + 8192); TRRD(h2, b_ + 10240); TRRD(l3, b_ + 12288); TRRD(h3, b_ + 14336); \
        asm volatile("s_waitcnt lgkmcnt(0)" ::: "memory"); SBAR();   \
        o[d0] = __builtin_amdgcn_mfma_f32_32x32x16_bf16(pa0, (bf16x8){l0[0], l0[1], l0[2], l0[3], h0[0], h0[1], h0[2], h0[3]}, o[d0], 0, 0, 0);   \
        o[d0] = __builtin_amdgcn_mfma_f32_32x32x16_bf16(pa1, (bf16x8){l1[0], l1[1], l1[2], l1[3], h1[0], h1[1], h1[2], h1[3]}, o[d0], 0, 0, 0);   \
        o[d0] = __builtin_amdgcn_mfma_f32_32x32x16_bf16(pa2, (bf16x8){l2[0], l2[1], l2[2], l2[3], h2[0], h2[1], h2[2], h2[3]}, o[d0], 0, 0, 0);   \
        o[d0] = __builtin_amdgcn_mfma_f32_32x32x16_bf16(pa3, (bf16x8){l3[0], l3[1], l3[2], l3[3], h3[0], h3[1], h3[2], h3[3]}, o[d0], 0, 0, 0); } while (0)
    PV_D0(0); PV_D0(1); PV_D0(2); PV_D0(3);
#undef PV_D0
#undef TRRD
}
struct Blk { const bf16_t* Q; const bf16_t* K; const bf16_t* V; const bf16_t* K0; const bf16_t* V0; bf16_t* O; int P0; int mode; float s2; };
struct Seam { bf16x8 qr[8]; bf16x8 st_v0, st_v1, st_k0, st_k1; };
#define ROW(p, k0, rr) ((p) + (size_t)((k0) + (rr)) * D + sc)
#define VMW() asm volatile("s_waitcnt vmcnt(0)" ::: "memory")
#define VMWN(n) asm volatile("s_waitcnt vmcnt(%0)" :: "i"(n) : "memory")
#define SLOAD_H(Kp, Vp, k0) do { S.st_v0 = load8(ROW(Vp, k0, sr)); S.st_v1 = load8(ROW(Vp, k0, 32 + sr));              \
                         S.st_k0 = load8(ROW(Kp, k0, sr)); S.st_k1 = load8(ROW(Kp, k0, 32 + sr)); } while (0)
#define SWRITE_HK(bf) do { *(bf16x8*)(K_lds + (bf) * SHM_K + kws) = S.st_k0; *(bf16x8*)(K_lds + (bf) * SHM_K + kws + 32 * 256) = S.st_k1; } while (0)
#define SWRITE_HV(bf) do { *(bf16x8*)(V_lds + (bf) * SHM_V + vst0) = S.st_v0; *(bf16x8*)(V_lds + (bf) * SHM_V + vst1) = S.st_v1; } while (0)
#define SWRITE_H(bf) do { SWRITE_HV(bf); SWRITE_HK(bf); } while (0)
__device__ __forceinline__ void attn_prime(const Blk& cur, char* lds, Seam& S, const int tid) {
    const int wid = __builtin_amdgcn_readfirstlane(tid >> 6), lane = tid & 63, r32 = lane & 31, hi = lane >> 5;
    const int sr = tid >> 4, sc = (tid & 15) * 8, kws = KSWZ(sr, sc * 2); char* K_lds = lds + 2 * SHM_V;
    for (int d0 = 0; d0 < 8; ++d0) S.qr[d0] = load8(cur.Q + (size_t)(wid * QBLK + r32) * D + d0 * 16 + hi * 8);
    SLOAD_H(cur.K0, cur.V0, 0); VMW(); SWRITE_HK(0);
    __syncthreads();
}
__device__ __forceinline__ void attn_block(const Blk& cur, const Blk& nxt, char* lds, Seam& S, float lam, float* scrT, float* scrD, const float* g_subln, const int tid) {
    const int wid = __builtin_amdgcn_readfirstlane(tid >> 6), lane = tid & 63, r32 = lane & 31, hi = lane >> 5;
    const int NT = (cur.P0 + QB - 1) / KVBLK + 1;
    const int qlo = cur.P0 + wid * QBLK;
    const int qt4 = qlo + r32 - 4 * hi;
    const bool isdiff = cur.mode != 0;
    char* V_lds = lds; char* K_lds = lds + 2 * SHM_V;
    float* ws = (float*)(lds + LDS_WS) + wid * 64; float* li_l = ws, * al_l = ws + 32;
    float m_reg = -1e30f, l_reg = 0; f32x16 o[4] = {};
    const int sr = tid >> 4, sc = (tid & 15) * 8, vst0 = v_st(sr, sc), vst1 = v_st(32 + sr, sc), kws = KSWZ(sr, sc * 2);
    const int vb0 = (int)(uintptr_t)V_lds + v_rd_base(lane);
    const bf16_t* Kh = cur.K; const bf16_t* Vh = cur.V;
#define RESC(a) do { if (__any((a) < 1.f)) { if (hi == 0) al_l[r32] = (a); asm volatile("s_waitcnt lgkmcnt(0)" ::: "memory");              \
                     for (int d_ = 0; d_ < 4; ++d_) for (int r = 0; r < 16; ++r) o[d_][r] *= al_l[crow(r, hi)]; } } while (0)
#define KBASE(t) ((t) * KVBLK)
#define BIAS(P0_, P1_, t) do { int h_ = hi; asm volatile("" : "+v"(h_)); const float* tb_ = (const float*)(lds + LDS_TAB) + (4 * h_ + KBASE(t));         \
        _Pragma("unroll") for (int i_ = 0; i_ < 4; ++i_) { const f32x4 b0_ = *(const f32x4*)(tb_ + 8 * i_), b1_ = *(const f32x4*)(tb_ + 32 + 8 * i_); \
            _Pragma("unroll") for (int j_ = 0; j_ < 4; ++j_) { P0_[4 * i_ + j_] += b0_[j_]; P1_[4 * i_ + j_] += b1_[j_]; } } } while (0)
#define MASKT(P0_, P1_, t) do { const int kb_ = KBASE(t); BIAS(P0_, P1_, t); if (kb_ + KVBLK - 1 > qlo || kb_ == 0) { int q_ = qt4; asm volatile("" : "+v"(q_)); const int qt_ = q_ + 4 * hi, qe_ = isdiff ? (qt_ | 63) : qt_;      \
            mask_tile(P0_, P1_, qe_ - kb_ - 4 * hi, q_ - kb_, (unsigned)(qe_ - 47), cur.s2); } } while (0)
#define SEAM_K0() do { VMWN(8); SWRITE_HK(0); SBAR(); } while (0)
    f32x16 pA0, pA1, pB0, pB1; float mnA, mnB, alA, alB; bf16x8 pa0, pa1, pa2, pa3;
    SWRITE_HV(0); SBAR();
    if (NT > 1) { SLOAD_H(Kh, Vh, KBASE(1)); }
    SBAR(); qkt<0>(pA0, pA1, K_lds, r32, hi, S.qr);
    MASKT(pA0, pA1, 0); partialSM(pA0, pA1, m_reg, mnA, alA);
    if (NT > 1) { VMW(); SWRITE_H(1); }
    __syncthreads();
#define HALF_STEP(PX0, PX1, mnX, alX, PY0, PY1, alY, t, KB, VB, SB_) do {                                                      \
        SBAR(); qkt<KB>(PX0, PX1, K_lds, r32, hi, S.qr);                                             \
        finishSM(PY0, PY1, alY, l_reg, pa0, pa1, pa2, pa3); SBAR();                                                           \
        if ((t) + 1 < NT) { SLOAD_H(Kh, Vh, KBASE((t) + 1)); SBAR(); }                                               \
        pv_tile<VB>(o, vb0, pa0, pa1, pa2, pa3); MASKT(PX0, PX1, (t)); partialSM(PX0, PX1, m_reg, mnX, alX);                                        \
        __syncthreads();                                                                                                      \
        if ((t) + 1 < NT) { VMW(); SWRITE_H(SB_); }                                                                          \
        RESC(alX); __syncthreads(); } while (0)
    for (int t = 1; t + 1 < NT; t += 2) {
        HALF_STEP(pB0, pB1, mnB, alB, pA0, pA1, alA, t, 1, 0, 0);
        HALF_STEP(pA0, pA1, mnA, alA, pB0, pB1, alB, t + 1, 0, 1, 1);
    }
    const bool even = (NT & 1) == 0;
    if (even) { SBAR(); qkt<1>(pB0, pB1, K_lds, r32, hi, S.qr); SBAR(); }
    { int t2 = tid; asm volatile("" : "+v"(t2));
      const int sr2 = t2 >> 4, sc2 = (t2 & 15) * 8, l2 = t2 & 63;
      const unsigned off = (unsigned)(sr2 * D + sc2);
      S.st_v0 = load8(nxt.V0 + off); S.st_v1 = load8(nxt.V0 + off + 32 * D); S.st_k0 = load8(nxt.K0 + off); S.st_k1 = load8(nxt.K0 + off + 32 * D); SBAR();
      const unsigned qoff = (unsigned)((wid * QBLK + (l2 & 31)) * D + (l2 >> 5) * 8);
#pragma unroll
      for (int d0 = 0; d0 < 8; ++d0) S.qr[d0] = load8(nxt.Q + qoff + d0 * 16); }
    SBAR();
    finishSM(pA0, pA1, alA, l_reg, pa0, pa1, pa2, pa3); SBAR();
    pv_tile<0>(o, vb0, pa0, pa1, pa2, pa3);
    if (even) { MASKT(pB0, pB1, NT - 1); partialSM(pB0, pB1, m_reg, mnB, alB); __syncthreads(); RESC(alB);
        finishSM(pB0, pB1, alB, l_reg, pa0, pa1, pa2, pa3); SBAR(); pv_tile<1>(o, vb0, pa0, pa1, pa2, pa3); }
    SBAR(); SEAM_K0();
    int ln = lane; asm volatile("" : "+v"(ln));
    const int r32e = ln & 31;
    if (hi == 0) li_l[r32] = l_reg; asm volatile("s_waitcnt lgkmcnt(0)" ::: "memory");
    float rli[16];
#pragma unroll
    for (int r = 0; r < 16; ++r) rli[r] = __builtin_amdgcn_rcpf(li_l[crow(r, hi)]);
    const int mode = cur.mode;
    if (mode == 0) {
        bf16_t* Ow = cur.O + (size_t)(wid * QBLK) * 1024;
#pragma unroll
        for (int r = 0; r < 16; ++r) { const int orow = crow(r, hi);
#pragma unroll
            for (int d0 = 0; d0 < 4; ++d0) { const float v = o[d0][r] * rli[r]; const float vn = __shfl_xor(v, 1);
                if ((r32e & 1) == 0) *(unsigned*)(Ow + (orow * 1024 + d0 * 32 + r32e)) = cvtpk(v, vn); } }
    } else if (mode == 1) {
        float* T = scrT + (wid * 4096 + ln);
#pragma unroll
        for (int r = 0; r < 16; ++r)
#pragma unroll
            for (int d0 = 0; d0 < 4; ++d0) T[(r * 4 + d0) * 64] = o[d0][r] * rli[r];
    } else {
        const float* T = scrT + (wid * 4096 + ln); float* Dl = scrD + (wid * 4096 + ln);
#pragma unroll
        for (int r = 0; r < 16; ++r)
#pragma unroll
            for (int d0 = 0; d0 < 4; ++d0) o[d0][r] = __hip_atomic_load(T + (r * 4 + d0) * 64, __ATOMIC_RELAXED, __HIP_MEMORY_SCOPE_AGENT) - lam * (o[d0][r] * rli[r]);
        if (mode == 2) {
#pragma unroll
            for (int r = 0; r < 16; ++r)
#pragma unroll
                for (int d0 = 0; d0 < 4; ++d0) Dl[(r * 4 + d0) * 64] = o[d0][r];
        } else {
            bf16_t* Ow = cur.O + (size_t)(wid * QBLK) * 1024;
            float gs0[4], gs1[4];
#pragma unroll
            for (int d0 = 0; d0 < 4; ++d0) { gs0[d0] = g_subln[d0 * 32 + r32e] * 0.8f; gs1[d0] = g_subln[128 + d0 * 32 + r32e] * 0.8f; }
#pragma unroll
            for (int r = 0; r < 16; ++r) { const int orow = crow(r, hi);
                float e0[4]; float ss = 0.f;
#pragma unroll
                for (int d0 = 0; d0 < 4; ++d0) { e0[d0] = __hip_atomic_load(Dl + (r * 4 + d0) * 64, __ATOMIC_RELAXED, __HIP_MEMORY_SCOPE_AGENT); ss += e0[d0] * e0[d0] + o[d0][r] * o[d0][r]; }
                ss += __shfl_xor(ss, 1); ss += __shfl_xor(ss, 2); ss += __shfl_xor(ss, 4); ss += __shfl_xor(ss, 8); ss += __shfl_xor(ss, 16);
                const float rn = __builtin_amdgcn_rsqf(ss * (1.0f / 256.0f) + 1e-5f);
#pragma unroll
                for (int d0 = 0; d0 < 4; ++d0) { const float v0 = e0[d0] * rn * gs0[d0], v1 = o[d0][r] * rn * gs1[d0]; const float v0n = __shfl_xor(v0, 1), v1n = __shfl_xor(v1, 1);
                    if ((r32e & 1) == 0) { *(unsigned*)(Ow + (orow * 1024 + d0 * 32 + r32e)) = cvtpk(v0, v0n); *(unsigned*)(Ow + (orow * 1024 + 128 + d0 * 32 + r32e)) = cvtpk(v1, v1n); } }
                asm volatile("" ::: "memory"); }
        }
    }
    __syncthreads();
#undef RESC
#undef KBASE
#undef BIAS
#undef MASKT
#undef SEAM_K0
#undef HALF_STEP
}
#undef ROW
#undef VMW
#undef VMWN
#undef SLOAD_H
#undef SWRITE_HK
#undef SWRITE_HV
#undef SWRITE_H
}

struct Params { const float* in[18]; float* out; unsigned char* ws; int ph_lo, ph_hi; };

__device__ __forceinline__ void transpose_job(const float* __restrict__ src, int ld, int col0, int nN, int Kdim, bf16_t* __restrict__ dst, int up, const float* __restrict__ scale, float* tile, const int tid) {
    const int nK = Kdim / 64, total = nK * nN;
    f32x4 v[2];
    int t = blockIdx.x;
    if (t < total) { const int k0 = (t / nN) * 64, n0 = (t % nN) * 64;
#pragma unroll
        for (int i = 0; i < 2; ++i) { const int idx = tid + 512 * i, kk = idx >> 4, c4 = idx & 15; v[i] = *(const f32x4*)(src + (size_t)(k0 + kk) * ld + col0 + n0 + c4 * 4) * (scale ? scale[k0 + kk] : 1.0f); } }
    for (; t < total; t += gridDim.x) {
        const int k0 = (t / nN) * 64, n0 = (t % nN) * 64;
#pragma unroll
        for (int i = 0; i < 2; ++i) { const int idx = tid + 512 * i, kk = idx >> 4, c4 = idx & 15;
#pragma unroll
            for (int j = 0; j < 4; ++j) tile[kk * 65 + c4 * 4 + j] = v[i][j]; }
        const int tn = t + gridDim.x;
        if (tn < total) { const int k1 = (tn / nN) * 64, n1 = (tn % nN) * 64;
#pragma unroll
            for (int i = 0; i < 2; ++i) { const int idx = tid + 512 * i, kk = idx >> 4, c4 = idx & 15; v[i] = *(const f32x4*)(src + (size_t)(k1 + kk) * ld + col0 + n1 + c4 * 4) * (scale ? scale[k1 + kk] : 1.0f); } }
        __syncthreads();
        { const int n = tid >> 3, kc = (tid & 7) * 8; f32x4 a, b;
#pragma unroll
            for (int j = 0; j < 4; ++j) { a[j] = tile[(kc + j) * 65 + n]; b[j] = tile[(kc + 4 + j) * 65 + n]; }
            const int drow = (up < 0) ? (n0 + n) : (256 * (n0 >> 7) + (n0 & 127) + up * 128 + n);
            *(u32x4*)(dst + (size_t)drow * Kdim + k0 + kc) = pack8u(a, b); }
        __syncthreads();
    }
}

__global__ void __launch_bounds__(512, 2) fwd_kernel(Params p) {
    extern __shared__ __attribute__((aligned(16))) unsigned char lds[];
    cg::grid_group grid = cg::this_grid();
    const int wid = __builtin_amdgcn_readfirstlane(threadIdx.x >> 6), G = gridDim.x, bx = blockIdx.x;
    unsigned char* ws = p.ws;
    bf16_t* W1T = (bf16_t*)(ws + WS_W1T); bf16_t* WAT = (bf16_t*)(ws + WS_WAT); bf16_t* WFT = (bf16_t*)(ws + WS_WFT); bf16_t* WOT = (bf16_t*)(ws + WS_WOT);
    bf16_t* W5T = (bf16_t*)(ws + WS_W5T); bf16_t* WDT = (bf16_t*)(ws + WS_WDT);
    bf16_t* XB = (bf16_t*)(ws + WS_RA); bf16_t* OA = (bf16_t*)(ws + WS_RA); bf16_t* OF = (bf16_t*)(ws + WS_RA + (size_t)M * 1024 * 2); bf16_t* H1B = (bf16_t*)(ws + WS_RA);
    bf16_t* QKV = (bf16_t*)(ws + WS_RB); float* TMP = (float*)(ws + WS_RB); bf16_t* MERGED = (bf16_t*)(ws + WS_RB + (size_t)M * DM * 4); bf16_t* ACT = (bf16_t*)(ws + WS_RB);
    bf16_t* GATES = (bf16_t*)(ws + WS_RG);
    float* RSTD1 = (float*)(ws + WS_RSTD1); float* SSQ2 = (float*)(ws + WS_SSQ2); float* SSQ3 = (float*)(ws + WS_SSQ3);
    float* LOGF = (float*)(ws + WS_LOGF); float* CUM = (float*)(ws + WS_CUM);
    const int lo = p.ph_lo, hi_ = p.ph_hi;
#define IN(k) (lo <= (k) && (k) < hi_)
#define SEAM(k) do { if (IN(k) && IN((k) + 1)) grid.sync(); } while (0)

    for (int rep_ = 0; rep_ < (REP_PHASE == 0 ? 2 : 1); ++rep_) if (IN(0)) {
        if (rep_) grid.sync();
        const int lane = fresh_lane(), tid = wid * 64 + lane;
        float* tile = (float*)lds;
        const float* w_in = p.in[3];
        transpose_job(w_in, NINC, 0, 96, DM, W1T, -1, p.in[2], tile, tid);
        transpose_job(w_in, NINC, 6152, 64, DM, W1T + (size_t)6144 * DM, -1, p.in[2], tile, tid);
        transpose_job(p.in[10], DM, 0, 32, 1024, WAT, -1, nullptr, tile, tid);
        transpose_job(p.in[11], DM, 0, 32, 1024, WFT, -1, nullptr, tile, tid);
        transpose_job(p.in[12], DM, 0, 32, DM, WOT, -1, nullptr, tile, tid);
        transpose_job(p.in[14], DFF, 0, 88, DM, W5T, 0, p.in[13], tile, tid);
        transpose_job(p.in[15], DFF, 0, 88, DM, W5T, 1, p.in[13], tile, tid);
        transpose_job(p.in[16], DM, 0, 32, DFF, WDT, -1, nullptr, tile, tid);
        float* WF = (float*)lds;
        for (int k = tid; k < DM; k += 512) { const float g = p.in[2][k]; const f32x4 a = *(const f32x4*)(w_in + (size_t)k * NINC + 6144), b = *(const f32x4*)(w_in + (size_t)k * NINC + 6148);
#pragma unroll
            for (int j = 0; j < 4; ++j) { WF[j * DM + k] = a[j] * g; WF[(4 + j) * DM + k] = b[j] * g; } }
        __syncthreads();
        const float* x = p.in[0]; const float* meta = p.in[1]; const float* b_f = p.in[9];
        for (int job = bx * 8 + wid; job < M + NMETA; job += G * 8) {
            const bool ismeta = job >= M; const int row = ismeta ? job + VPAD : job;
            const float* src = ismeta ? meta + (size_t)(job - M) * DM : x + (size_t)job * DM;
            f32x4 v[8]; float ss = 0.f; float zf[8];
#pragma unroll
            for (int j = 0; j < 8; ++j) zf[j] = 0.f;
#pragma unroll
            for (int i = 0; i < 8; ++i) { v[i] = *(const f32x4*)(src + i * 256 + lane * 4);
                ss += (v[i][0] * v[i][0] + v[i][1] * v[i][1]) + (v[i][2] * v[i][2] + v[i][3] * v[i][3]); }
#pragma unroll
            for (int i = 0; i < 8; ++i) {
                u32x2 w; w.x = pg8::cvt_pk_bf16(v[i][0], v[i][1]); w.y = pg8::cvt_pk_bf16(v[i][2], v[i][3]);
                *(u32x2*)(XB + (size_t)row * DM + i * 256 + lane * 4) = w;
#pragma unroll
                for (int j = 0; j < 8; ++j) { const f32x4 wv = *(const f32x4*)(WF + j * DM + i * 256 + lane * 4); zf[j] += (v[i][0] * wv[0] + v[i][1] * wv[1]) + (v[i][2] * wv[2] + v[i][3] * wv[3]); } }
            ss = wave_sum(ss);
#pragma unroll
            for (int j = 0; j < 8; ++j) zf[j] = wave_sum(zf[j]);
            const float rs = __builtin_amdgcn_rsqf(ss * (1.0f / 2048.0f) + 1e-6f);
            if (lane == 0) { RSTD1[row] = rs; if (!ismeta) { SSQ2[row] = 0.f; SSQ3[row] = 0.f; } }
            if (lane < 8) { float zz = zf[0];
#pragma unroll
                for (int j = 1; j < 8; ++j) zz = (lane == j) ? zf[j] : zz;
                const float y = zz * rs + b_f[lane];
                const float lf = fminf(y, 0.f) - log1pf(__expf(-fabsf(y)));
                if (!ismeta) { const int b = job >> 13, t = job & (SEQ - 1); LOGF[(size_t)(b * 8 + lane) * LB + 64 + t] = lf; }
                else { const int vp = VPAD + (job - M);
#pragma unroll
                    for (int b = 0; b < NBATCH; ++b) LOGF[(size_t)(b * 8 + lane) * LB + vp] = lf; } }
        }
        if (bx == 0) for (int i = tid; i < 32 * VPAD; i += 512) LOGF[(size_t)(i / VPAD) * LB + (i % VPAD)] = 0.f;
        __syncthreads();
    }
    SEAM(0);

    for (int rep_ = 0; rep_ < (REP_PHASE == 1 ? 2 : 1); ++rep_) if (IN(1)) {
        if (rep_) grid.sync();
        const int lane = fresh_lane(), tid = wid * 64 + lane;
        if (bx < 32) {
            const float* srcp = LOGF + (size_t)bx * LB; float* dstp = CUM + (size_t)bx * LB; float* red = (float*)lds;
            const int i0 = tid * 17; float vals[17]; float s = 0.f;
#pragma unroll
            for (int i = 0; i < 17; ++i) { const int k = i0 + i; vals[i] = k < LB ? srcp[k] : 0.f; s += vals[i]; vals[i] = s; }
            float incl = s;
#pragma unroll
            for (int o = 1; o < 64; o <<= 1) { const float t = __shfl_up(incl, o); if (lane >= o) incl += t; }
            if (lane == 63) red[wid] = incl;
            __syncthreads();
            float base = incl - s;
            for (int w = 0; w < wid; ++w) base += red[w];
#pragma unroll
            for (int i = 0; i < 17; ++i) { const int k = i0 + i; if (k < LB) dstp[k] = (base + vals[i]) * 11.313708498984761f; }
            __syncthreads();
        }
        {
            bf16_t* xm = (bf16_t*)lds;
            for (int i = tid; i < 16 * 256; i += 512) *(u32x4*)(xm + (size_t)i * 8) = *(const u32x4*)(XB + (size_t)(M + VPAD) * DM + (size_t)i * 8);
            { const int i = bx * 512 + tid; if (i < 32 * VPAD * 16) { const int sl = i / (VPAD * 16), r = (i / 16) % VPAD, ch = i % 16; const int hd = sl < 16 ? 8 + sl : 16 + sl;
                *(u32x4*)(QKV + ((size_t)hd * MQ + M + r) * 128 + ch * 8) = (u32x4){0u, 0u, 0u, 0u}; } }
            __syncthreads();
            for (int c0 = bx * 16; c0 < 4096; c0 += G * 16) {
#pragma unroll 1
                for (int cc = 0; cc < 2; ++cc) { const int c = c0 + wid * 2 + cc, sl = c >> 7, hd = sl < 16 ? 8 + sl : 16 + sl, n = hd * 128 + (c & 127);
                    f32x4 wa[8];
#pragma unroll
                    for (int q = 0; q < 4; ++q) unpack8(*(const u32x4*)(W1T + (size_t)n * DM + lane * 32 + q * 8), wa[2 * q], wa[2 * q + 1]);
                    float mine = 0.f;
#pragma unroll 1
                    for (int j = 0; j < 16; ++j) { float a = 0.f;
#pragma unroll
                        for (int q = 0; q < 4; ++q) { f32x4 x0, x1; unpack8(*(const u32x4*)(xm + (size_t)j * DM + lane * 32 + q * 8), x0, x1);
                            a += (x0[0] * wa[2 * q][0] + x0[1] * wa[2 * q][1]) + (x0[2] * wa[2 * q][2] + x0[3] * wa[2 * q][3]) + (x1[0] * wa[2 * q + 1][0] + x1[1] * wa[2 * q + 1][1]) + (x1[2] * wa[2 * q + 1][2] + x1[3] * wa[2 * q + 1][3]); }
                        a = wave_sum(a); mine = (lane == j) ? a : mine; }
                    if (lane < 16) { const float v = mine * RSTD1[M + VPAD + lane]; QKV[((size_t)hd * MQ + M + VPAD + lane) * 128 + (c & 127)] = (bf16_t)(pg8::cvt_pk_bf16(v, v) & 0xffffu); } }
            }
            __syncthreads();
        }
        pg8::Gemm g{XB, W1T, M, N1, DM}; pg8::StaticOrder S; S.init(M, N1, G, bx);
        Epi1 E{QKV, GATES, RSTD1};
        pg8::gemm_phase<Epi1, pg8::StaticOrder>((PG8_LAS unsigned char*)lds, g, S, E, wid * 64 + fresh_lane());
    }
    SEAM(1);

    for (int rep_ = 0; rep_ < (REP_PHASE == 2 ? 2 : 1); ++rep_) if (IN(2)) {
        if (rep_) grid.sync();
        const int lane = fresh_lane(), tid = wid * 64 + lane;
        float lam;
        { const float* q1 = p.in[4]; const float* k1 = p.in[5]; const float* q2 = p.in[6]; const float* k2 = p.in[7];
          float s1 = q1[lane] * k1[lane] + q1[lane + 64] * k1[lane + 64], s2 = q2[lane] * k2[lane] + q2[lane + 64] * k2[lane + 64];
          s1 = wave_sum(s1); s2 = wave_sum(s2); lam = __expf(s1) - __expf(s2) + 0.2f; lam = __uint_as_float(__builtin_amdgcn_readfirstlane(__float_as_uint(lam))); }
        const float* g_subln = p.in[8];
        float* scrT = (float*)(ws + WS_SCR + (size_t)bx * 262144); float* scrD = scrT + 32768;
        float* tabw = (float*)(lds + att::LDS_TAB);
        const int vcu = (G % 8 == 0) ? (bx % 8) * (G / 8) + bx / 8 : bx;
        const int nsi = (256 - vcu + G - 1) / G;
        const int nbp = nsi * 12;
        auto desc = [&](int bp) -> att::Blk {
            const int s = vcu + (bp / 12) * G, idx = bp % 12; att::Blk r;
            if (idx < 4) { const int pr = 2 * s + (idx >> 1), bh = pr >> 4, y = pr & 15, qb = (idx & 1) ? 31 - y : y, b = bh >> 3, h = bh & 7;
                const size_t rb = (size_t)b * SEQ + 256 * qb; r.P0 = 64 + 256 * qb; r.mode = 0; r.s2 = 0.f;
                r.Q = QKV + ((size_t)(24 + h) * MQ + rb) * 128; r.K = QKV + ((size_t)(32 + h) * MQ + (size_t)b * SEQ) * 128 - 64 * 128; r.V = QKV + ((size_t)(40 + h) * MQ + (size_t)b * SEQ) * 128 - 64 * 128;
                r.K0 = QKV + ((size_t)(32 + h) * MQ + M) * 128; r.V0 = QKV + ((size_t)(40 + h) * MQ + M) * 128;
                r.O = OF + rb * 1024 + h * 128; }
            else { const int j = idx - 4, sel = j >> 2, pass = j & 3, e = pass >> 1, c = pass & 1, bh = s >> 4, y = s & 15, qb = sel ? 31 - y : y, b = bh >> 2, h = bh & 3;
                const size_t rb = (size_t)b * SEQ + 256 * qb; r.P0 = 64 + 256 * qb; r.mode = (c == 0) ? 1 : (e == 0 ? 2 : 3);
                r.s2 = 2.0f * 11.313708498984761f * (h == 0 ? 0.25f : h == 1 ? 0.0625f : h == 2 ? 0.015625f : 0.00390625f);
                r.Q = QKV + ((size_t)(2 * h + c) * MQ + rb) * 128; r.K = QKV + ((size_t)(8 + 2 * h + c) * MQ + (size_t)b * SEQ) * 128 - 64 * 128; r.V = QKV + ((size_t)(16 + 2 * h + e) * MQ + (size_t)b * SEQ) * 128 - 64 * 128;
                r.K0 = QKV + ((size_t)(8 + 2 * h + c) * MQ + M) * 128; r.V0 = QKV + ((size_t)(16 + 2 * h + e) * MQ + M) * 128;
                r.O = OA + rb * 1024 + h * 256; }
            return r; };
        if (nbp > 0) {
            att::Seam S;
            att::Blk cur = desc(0);
            att::attn_prime(cur, (char*)lds, S, wid * 64 + fresh_lane());
            for (int bp = 0; bp < nbp; ++bp) {
                const att::Blk nxt = desc(bp + 1 < nbp ? bp + 1 : bp);
                { const int s = vcu + (bp / 12) * G, idx = bp % 12; const int nk = cur.P0 + 256; const int tt = wid * 64 + fresh_lane();
                  if (idx < 4) { const int pr = 2 * s + (idx >> 1), bh = pr >> 4; const float* cm = CUM + (size_t)bh * LB; const float cref = cm[cur.P0];
                      for (int k = tt; k < nk; k += 512) tabw[k] = cref - cm[k]; }
                  else { const float sl = 0.5f * cur.s2; for (int k = tt; k < nk; k += 512) tabw[k] = sl * (float)(k - cur.P0); } }
                __syncthreads();
                att::attn_block(cur, nxt, (char*)lds, S, lam, scrT, scrD, g_subln, wid * 64 + fresh_lane());
                cur = nxt;
            }
        }
        asm volatile("s_waitcnt vmcnt(0)" ::: "memory");
        __syncthreads();
    }
    SEAM(2);

    for (int rep_ = 0; rep_ < (REP_PHASE == 3 ? 2 : 1); ++rep_) if (IN(3)) {
        if (rep_) grid.sync();
        { pg8::Gemm g{OA, WAT, M, DM, 1024}; pg8::StaticOrder S; S.init(M, DM, G, bx); Epi3a E{TMP, GATES};
          pg8::gemm_phase<Epi3a, pg8::StaticOrder>((PG8_LAS unsigned char*)lds, g, S, E, wid * 64 + fresh_lane()); }
        { pg8::Gemm g{OF, WFT, M, DM, 1024}; pg8::StaticOrder S; S.init(M, DM, G, bx); Epi3b E{TMP, GATES, MERGED};
          pg8::gemm_phase<Epi3b, pg8::StaticOrder>((PG8_LAS unsigned char*)lds, g, S, E, wid * 64 + fresh_lane()); }
    }
    SEAM(3);

    if (IN(4)) {
        pg8::Gemm g{MERGED, WOT, M, DM, DM}; pg8::StaticOrder S; S.init(M, DM, G, bx); Epi4 E{p.in[0], p.out, H1B, SSQ2};
        pg8::gemm_phase<Epi4, pg8::StaticOrder>((PG8_LAS unsigned char*)lds, g, S, E, wid * 64 + fresh_lane());
    }
    SEAM(4);

    for (int rep_ = 0; rep_ < (REP_PHASE == 5 ? 2 : 1); ++rep_) if (IN(5)) {
        if (rep_) grid.sync();
        pg8::Gemm g{H1B, W5T, M, N5, DM}; pg8::StaticOrder S; S.init(M, N5, G, bx); Epi5 E{SSQ2, ACT};
        pg8::gemm_phase<Epi5, pg8::StaticOrder>((PG8_LAS unsigned char*)lds, g, S, E, wid * 64 + fresh_lane());
    }
    SEAM(5);

    if (IN(6)) {
        pg8::Gemm g{ACT, WDT, M, DM, DFF}; pg8::StaticOrder S; S.init(M, DM, G, bx); Epi6 E{p.out, SSQ3};
        pg8::gemm_phase<Epi6, pg8::StaticOrder>((PG8_LAS unsigned char*)lds, g, S, E, wid * 64 + fresh_lane());
    }
    SEAM(6);

    if (IN(7)) {
        const int lane = fresh_lane();
        const float* gfin = p.in[17];
        f32x4 gv[8];
#pragma unroll
        for (int i = 0; i < 8; ++i) gv[i] = *(const f32x4*)(gfin + i * 256 + lane * 4);
        for (int orow = bx * 8 + wid; orow < NBATCH * SEQ; orow += G * 8) {
            const int row = orow;
            const float rs = __builtin_amdgcn_rsqf(SSQ3[row] * (1.0f / 2048.0f) + 1e-6f);
            float* d = p.out + (size_t)orow * DM + lane * 4;
#pragma unroll
            for (int i = 0; i < 8; ++i) { const f32x4 v = *(const f32x4*)(d + i * 256); *(f32x4*)(d + i * 256) = v * rs * gv[i]; }
        }
    }
#undef IN
#undef SEAM
}

extern "C" void kernel_launch(void* const* d_in, const int* in_sizes, int n_in, void* d_out, int out_size, void* d_ws, size_t ws_size, hipStream_t stream) {
    static int grid = 0;
    if (grid == 0) {
        if (n_in != 18 || ws_size < WS_END) { fprintf(stderr, "kernel_launch: need 18 inputs and >= %zu bytes of workspace (got %d, %zu)\n", (size_t)WS_END, n_in, ws_size); grid = -1; return; }
        int dev = 0, cus = 0, per_cu = 0;
        (void)hipGetDevice(&dev);
        if (hipDeviceGetAttribute(&cus, hipDeviceAttributeMultiprocessorCount, dev) != hipSuccess || cus <= 0) cus = 256;
        if (hipFuncSetAttribute((const void*)fwd_kernel, hipFuncAttributeMaxDynamicSharedMemorySize, LDS_BYTES) != hipSuccess) { fprintf(stderr, "kernel_launch: hipFuncSetAttribute failed\n"); }
        if (hipOccupancyMaxActiveBlocksPerMultiprocessor(&per_cu, (const void*)fwd_kernel, 512, LDS_BYTES) != hipSuccess || per_cu < 1) { fprintf(stderr, "kernel_launch: occupancy query says %d\n", per_cu); per_cu = 1; }
        (void)hipGetLastError();
        grid = cus * 1;
        if (grid > 256) grid = 256;
    }
    if (grid < 0) return;
    Params p{};
    for (int i = 0; i < 18; ++i) p.in[i] = (const float*)d_in[i];
    p.out = (float*)d_out; p.ws = (unsigned char*)d_ws;
#if ONE_LAUNCH
    p.ph_lo = 0; p.ph_hi = 8;
    void* args[] = {&p};
    hipError_t e = hipLaunchCooperativeKernel((const void*)fwd_kernel, dim3(grid), dim3(512), args, LDS_BYTES, stream);
    if (e != hipSuccess) fprintf(stderr, "cooperative launch failed: %s (grid %d)\n", hipGetErrorString(e), grid);
#else
    for (int ph = 0; ph < 8; ++ph) { p.ph_lo = ph; p.ph_hi = ph + 1; hipLaunchKernelGGL(fwd_kernel, dim3(grid), dim3(512), LDS_BYTES, stream, p); }
#endif
}
```

```cpp
#include <hip/hip_runtime.h>
#include <hip/hip_cooperative_groups.h>
#include <cstdio>
#include <cstdint>
namespace cg = cooperative_groups;

#ifndef REP_PHASE
#define REP_PHASE -1
#endif
#ifndef ONE_LAUNCH
#define ONE_LAUNCH 1
#endif

typedef unsigned short bf16_t;
typedef short bf16x8 __attribute__((ext_vector_type(8)));
typedef short s16x4 __attribute__((ext_vector_type(4)));
typedef float f32x4 __attribute__((ext_vector_type(4)));
typedef float f32x16 __attribute__((ext_vector_type(16)));
typedef unsigned u32x4 __attribute__((ext_vector_type(4)));
typedef unsigned u32x2 __attribute__((ext_vector_type(2)));

constexpr int DM = 2048, NBATCH = 4, SEQ = 8192, NMETA = 16;
constexpr int VPAD = 48;
constexpr int LB = 8256;
constexpr int M = NBATCH * SEQ;
constexpr int MQ = M + 64;
constexpr int NINC = 10248;
constexpr int N1 = 10240;
constexpr int DFF = 5632, N5 = 2 * DFF;
constexpr int NHD = 48;

constexpr size_t SZ_W1T = (size_t)N1 * DM * 2, SZ_WAT = (size_t)DM * 1024 * 2, SZ_WOT = (size_t)DM * DM * 2, SZ_W5T = (size_t)N5 * DM * 2, SZ_WDT = (size_t)DM * DFF * 2;
constexpr size_t WS_W1T = 0, WS_WAT = WS_W1T + SZ_W1T, WS_WFT = WS_WAT + SZ_WAT, WS_WOT = WS_WFT + SZ_WAT, WS_W5T = WS_WOT + SZ_WOT, WS_WDT = WS_W5T + SZ_W5T;
constexpr size_t WS_RA = WS_WDT + SZ_WDT;
constexpr size_t SZ_RA = (size_t)MQ * DM * 2;
constexpr size_t WS_RB = WS_RA + SZ_RA;
constexpr size_t SZ_RB = (size_t)NHD * MQ * 128 * 2;
constexpr size_t WS_RG = WS_RB + SZ_RB;
constexpr size_t SZ_RG = (size_t)M * 4096 * 2;
constexpr size_t WS_RSTD1 = WS_RG + SZ_RG, WS_SSQ2 = WS_RSTD1 + (size_t)MQ * 4, WS_SSQ3 = WS_SSQ2 + (size_t)M * 4;
constexpr size_t WS_LOGF = WS_SSQ3 + (size_t)M * 4, WS_CUM = WS_LOGF + (size_t)32 * LB * 4;
constexpr size_t WS_SCR = WS_CUM + (size_t)32 * LB * 4;
constexpr size_t WS_END = WS_SCR + (size_t)256 * 262144;
constexpr int LDS_BYTES = 131072;

namespace pg8 {
#define PG8_LAS __attribute__((address_space(3)))
constexpr int BM = 256, BK = 64, HALF = 128, HTB = HALF * BK * 2, STAGE_BYTES = 8 * HTB, NXCD = 8, WGM = 8;
__host__ __device__ __forceinline__ int lds_byte(int r, int c) { const int st = (r >> 4) * 2 + (c >> 5), rr = r & 15, cc = c & 31, ob = rr * 64 + cc * 2; return st * 1024 + (ob ^ (((ob >> 9) & 1) << 5)); }
__host__ __device__ __forceinline__ void stage_rc(int b, int& R, int& C) { const int st = b / 1024, sb = b % 1024, swz = sb ^ (((sb >> 9) & 1) << 5); R = (st >> 1) * 16 + swz / 64; C = (st & 1) * 32 + (swz % 64) / 2; }
__host__ __device__ __forceinline__ int perm32(int rho) { const int n = rho >> 4, i = rho & 15; return 8 * (i >> 2) + 4 * n + (i & 3); }
struct Unit { int pm, pn; };
struct Gemm { const bf16_t* A; const bf16_t* Bt; int M, N, K; };
struct StaticOrder {
    int nM, nN, nwg, G, c;
    __host__ __device__ void init(int M_, int N_, int G_, int c_) { nM = M_ / BM; nN = N_ / BM; nwg = nM * nN; G = G_; c = c_; }
    __host__ __device__ bool next(int i, Unit& u) const {
        const long L = (long)i * G + c; if (L >= nwg) return false;
        int wgid = (int)L; { const int q = nwg / NXCD, r = nwg % NXCD, xcd = wgid % NXCD, off = wgid / NXCD; wgid = (xcd < r ? xcd * (q + 1) : r * (q + 1) + (xcd - r) * q) + off; }
        const int nig = WGM * nN, gid = wgid / nig, fm = gid * WGM, gsz = (nM - fm) < WGM ? (nM - fm) : WGM;
        u.pm = fm + ((wgid % nig) % gsz); u.pn = (wgid % nig) / gsz; return true;
    }
    __device__ __forceinline__ void a_ready(const Unit&) const {}
    __device__ __forceinline__ void done(const Unit&) const {}
};
__device__ __forceinline__ unsigned cvt_pk_bf16(float lo, float hi) { unsigned r; asm volatile("v_cvt_pk_bf16_f32 %0, %1, %2" : "=v"(r) : "v"(lo), "v"(hi)); return r; }

template <class Epi, class Sched>
__device__ __forceinline__ void gemm_phase(PG8_LAS unsigned char* lds, const Gemm g, const Sched& S, const Epi& E, const int tid) {
    const int wid = __builtin_amdgcn_readfirstlane(tid >> 6), lane = tid & 63, wr = wid >> 2, wc = wid & 3, fr = lane & 15, fq = lane >> 4;
    const int K = g.K, nt = K / BK;
    unsigned voffA[2], voffB[2];
#pragma unroll
    for (int i = 0; i < 2; ++i) { int R, C; stage_rc(tid * 16 + i * 8192, R, C); const int Rb = Epi::PERM ? ((R & ~31) + perm32(R & 31)) : R;
        voffA[i] = (unsigned)(R * K + C) * 2u; voffB[i] = (unsigned)(Rb * K + C) * 2u; }
    const size_t kstep = (size_t)(BK * 2);
    const size_t hstep = (size_t)HALF * K * 2;
    const size_t tstep = 2 * hstep;
    const unsigned ldsw = (unsigned)wid * 1024u;
    const int aoff = lds_byte(wr * 64 + fr, fq * 8), boff = lds_byte(wc * 32 + fr, fq * 8);
#define PG8_SA(b, h) (((b) * 2 + (h)) * HTB)
#define PG8_SB(b, h) ((4 + (b) * 2 + (h)) * HTB)
#define PG8_STAGE(bufoff, gbase, voff) do { _Pragma("unroll") for (int _i = 0; _i < 2; ++_i) \
        __builtin_amdgcn_global_load_lds((const unsigned*)((const char*)(gbase) + (voff)[_i]), (PG8_LAS unsigned*)(lds + (bufoff) + ldsw + _i * 8192), 16, 0, 0); } while (0)
#define PG8_LDA(dst, b, h) do { _Pragma("unroll") for (int m = 0; m < 4; ++m) _Pragma("unroll") for (int k = 0; k < 2; ++k) dst[m][k] = *(const PG8_LAS bf16x8*)(lds + PG8_SA(b, h) + aoff + m * 2048 + k * 1024); } while (0)
#define PG8_LDB(dst, b, h) do { _Pragma("unroll") for (int n = 0; n < 2; ++n) _Pragma("unroll") for (int k = 0; k < 2; ++k) dst[n][k] = *(const PG8_LAS bf16x8*)(lds + PG8_SB(b, h) + boff + n * 2048 + k * 1024); } while (0)
#define PG8_MMA(ai, bj, At, Bt) do { __builtin_amdgcn_s_setprio(1); _Pragma("unroll") for (int m = 0; m < 4; ++m) _Pragma("unroll") for (int n = 0; n < 2; ++n) _Pragma("unroll") for (int k = 0; k < 2; ++k) \
        acc[ai][bj][m][n] = __builtin_amdgcn_mfma_f32_16x16x32_bf16(Bt[n][k], At[m][k], acc[ai][bj][m][n], 0, 0, 0); __builtin_amdgcn_s_setprio(0); } while (0)
#define PG8_WAIT_V(n) asm volatile("s_waitcnt vmcnt(" #n ")" ::: "memory")
#define PG8_WAIT_L(n) asm volatile("s_waitcnt lgkmcnt(" #n ")" ::: "memory")
#define PG8_BAR __builtin_amdgcn_s_barrier()
#define PG8_SCHED __builtin_amdgcn_sched_barrier(0)
    Unit cur, nxt; int ui = 0;
    if (!S.next(0, cur)) return;
    f32x4 acc[2][2][4][2];
#pragma unroll
    for (int a = 0; a < 2; ++a)
#pragma unroll
        for (int b = 0; b < 2; ++b)
#pragma unroll
            for (int m = 0; m < 4; ++m)
#pragma unroll
                for (int n = 0; n < 2; ++n) acc[a][b][m][n] = (f32x4){0.f, 0.f, 0.f, 0.f};
    bf16x8 At[4][2], B0[2][2], B1[2][2];
    const char* cA = (const char*)g.A + (size_t)cur.pm * tstep; const char* cB = (const char*)g.Bt + (size_t)cur.pn * tstep;
    S.a_ready(cur);
    PG8_STAGE(PG8_SB(0, 0), cB, voffB); PG8_STAGE(PG8_SA(0, 0), cA, voffA); PG8_STAGE(PG8_SB(0, 1), cB + hstep, voffB); PG8_STAGE(PG8_SA(0, 1), cA + hstep, voffA);
    if (wr == 1) PG8_BAR;
    PG8_WAIT_V(4); PG8_BAR;
    PG8_STAGE(PG8_SB(1, 0), cB + kstep, voffB); PG8_STAGE(PG8_SA(1, 0), cA + kstep, voffA); PG8_STAGE(PG8_SB(1, 1), cB + hstep + kstep, voffB);
    PG8_WAIT_V(6); PG8_BAR;
    for (;;) {
        const bool has_next = S.next(ui + 1, nxt);
        const char* nA = has_next ? (const char*)g.A + (size_t)nxt.pm * tstep : cA; const char* nB = has_next ? (const char*)g.Bt + (size_t)nxt.pn * tstep : cB;
        for (int t = 0; t < nt; t += 2) {
            const bool last = (t == nt - 2);
            const char* a1 = cA + (size_t)(t + 1) * kstep;
            const char* a2 = last ? nA : cA + (size_t)(t + 2) * kstep; const char* b2 = last ? nB : cB + (size_t)(t + 2) * kstep;
            const char* a3 = a2 + kstep; const char* b3 = b2 + kstep;
            if (last && has_next) S.a_ready(nxt);
            PG8_LDB(B0, 0, 0); PG8_SCHED; PG8_LDA(At, 0, 0); PG8_STAGE(PG8_SA(1, 1), a1 + hstep, voffA);
            PG8_WAIT_L(8); PG8_BAR; PG8_WAIT_L(0); PG8_MMA(0, 0, At, B0); PG8_BAR; PG8_SCHED;
            PG8_LDB(B1, 0, 1); PG8_STAGE(PG8_SB(0, 0), b2, voffB);
            PG8_BAR; PG8_WAIT_L(0); PG8_MMA(0, 1, At, B1); PG8_BAR;
            PG8_LDA(At, 0, 1); PG8_STAGE(PG8_SA(0, 0), a2, voffA);
            PG8_BAR; PG8_WAIT_L(0); PG8_MMA(1, 0, At, B0); PG8_BAR; PG8_SCHED;
            PG8_STAGE(PG8_SB(0, 1), b2 + hstep, voffB);
            PG8_WAIT_V(6); PG8_BAR; PG8_MMA(1, 1, At, B1); PG8_BAR;
            PG8_LDB(B0, 1, 0); PG8_SCHED; PG8_LDA(At, 1, 0); PG8_STAGE(PG8_SA(0, 1), a2 + hstep, voffA);
            PG8_WAIT_L(8); PG8_BAR; PG8_WAIT_L(0); PG8_MMA(0, 0, At, B0); PG8_BAR; PG8_SCHED;
            PG8_LDB(B1, 1, 1); PG8_STAGE(PG8_SB(1, 0), b3, voffB);
            PG8_BAR; PG8_WAIT_L(0); PG8_MMA(0, 1, At, B1); PG8_BAR;
            PG8_LDA(At, 1, 1); PG8_STAGE(PG8_SA(1, 0), a3, voffA);
            PG8_BAR; PG8_WAIT_L(0); PG8_MMA(1, 0, At, B0); PG8_BAR; PG8_SCHED;
            PG8_STAGE(PG8_SB(1, 1), b3 + hstep, voffB);
            PG8_WAIT_V(6); PG8_BAR; PG8_MMA(1, 1, At, B1); PG8_BAR;
        }
        E(acc, cur, wr, wc, fr, fq); S.done(cur);
        if (!has_next) break;
#pragma unroll
        for (int a = 0; a < 2; ++a)
#pragma unroll
            for (int b = 0; b < 2; ++b)
#pragma unroll
                for (int m = 0; m < 4; ++m)
#pragma unroll
                    for (int n = 0; n < 2; ++n) acc[a][b][m][n] = (f32x4){0.f, 0.f, 0.f, 0.f};
        cur = nxt; cA = nA; cB = nB; ++ui;
    }
    PG8_WAIT_V(0);
    if (wr == 0) PG8_BAR;
    PG8_BAR;
#undef PG8_SA
#undef PG8_SB
#undef PG8_STAGE
#undef PG8_LDA
#undef PG8_LDB
#undef PG8_MMA
#undef PG8_WAIT_V
#undef PG8_WAIT_L
#undef PG8_BAR
#undef PG8_SCHED
}
}

__device__ __forceinline__ int fresh_lane() { int l; asm volatile("v_mbcnt_lo_u32_b32 %0, -1, 0\n\tv_mbcnt_hi_u32_b32 %0, -1, %0" : "=v"(l)); return l; }
__device__ __forceinline__ float bf2f(unsigned short b) { return __uint_as_float(((unsigned)b) << 16); }
__device__ __forceinline__ float sigmoidf_(float x) { return __builtin_amdgcn_rcpf(1.0f + __builtin_amdgcn_exp2f(-1.4426950408889634f * x)); }
__device__ __forceinline__ u32x4 pack8u(f32x4 a, f32x4 b) { u32x4 w = {pg8::cvt_pk_bf16(a[0], a[1]), pg8::cvt_pk_bf16(a[2], a[3]), pg8::cvt_pk_bf16(b[0], b[1]), pg8::cvt_pk_bf16(b[2], b[3])}; return w; }
__device__ __forceinline__ void unpack8(u32x4 w, f32x4& a, f32x4& b) {
    a = (f32x4){__uint_as_float(w.x << 16), __uint_as_float(w.x & 0xffff0000u), __uint_as_float(w.y << 16), __uint_as_float(w.y & 0xffff0000u)};
    b = (f32x4){__uint_as_float(w.z << 16), __uint_as_float(w.z & 0xffff0000u), __uint_as_float(w.w << 16), __uint_as_float(w.w & 0xffff0000u)};
}
__device__ __forceinline__ float wave_sum(float v) {
#pragma unroll
    for (int o = 32; o >= 1; o >>= 1) v += __shfl_xor(v, o);
    return v;
}

typedef f32x4 Acc[2][2][4][2];
struct Epi1 { static constexpr bool PERM = true;
    bf16_t* QKV; bf16_t* GATES; const float* rstd;
    __device__ __forceinline__ void operator()(const Acc& acc, const pg8::Unit& u, int wr, int wc, int fr, int fq) const {
        const int row0 = u.pm * 256 + wr * 64 + fr;
        if (u.pn < 24) {
#pragma unroll
            for (int ai = 0; ai < 2; ++ai)
#pragma unroll
                for (int m = 0; m < 4; ++m) { const int row = row0 + ai * 128 + m * 16; const float rs = rstd[row];
#pragma unroll
                    for (int bj = 0; bj < 2; ++bj) { bf16_t* dst = QKV + ((size_t)(2 * u.pn + bj) * MQ + row) * 128 + wc * 32 + 8 * fq;
                        *(u32x4*)dst = pack8u(acc[ai][bj][m][0] * rs, acc[ai][bj][m][1] * rs); } }
        } else {
            const int colb = (u.pn - 24) * 256 + wc * 32 + 8 * fq;
#pragma unroll
            for (int ai = 0; ai < 2; ++ai)
#pragma unroll
                for (int m = 0; m < 4; ++m) { const int row = row0 + ai * 128 + m * 16; const float rs = rstd[row];
#pragma unroll
                    for (int bj = 0; bj < 2; ++bj) { f32x4 v0 = acc[ai][bj][m][0] * rs, v1 = acc[ai][bj][m][1] * rs;
#pragma unroll
                        for (int j = 0; j < 4; ++j) { v0[j] = sigmoidf_(v0[j]); v1[j] = sigmoidf_(v1[j]); }
                        *(u32x4*)(GATES + (size_t)row * 4096 + colb + bj * 128) = pack8u(v0, v1); } }
        }
    }
};
struct Epi3a { static constexpr bool PERM = true;
    float* TMP; const bf16_t* GATES;
    __device__ __forceinline__ void operator()(const Acc& acc, const pg8::Unit& u, int wr, int wc, int fr, int fq) const {
        const int row0 = u.pm * 256 + wr * 64 + fr, col0 = u.pn * 256 + wc * 32 + 8 * fq;
#pragma unroll
        for (int ai = 0; ai < 2; ++ai)
#pragma unroll
            for (int m = 0; m < 4; ++m) { const int row = row0 + ai * 128 + m * 16;
#pragma unroll
                for (int bj = 0; bj < 2; ++bj) { const int col = col0 + bj * 128; f32x4 g0, g1; unpack8(*(const u32x4*)(GATES + (size_t)row * 4096 + col), g0, g1);
                    float* d = TMP + (size_t)row * DM + col; *(f32x4*)d = acc[ai][bj][m][0] * g0; *(f32x4*)(d + 4) = acc[ai][bj][m][1] * g1; } }
    }
};
struct Epi3b { static constexpr bool PERM = true;
    const float* TMP; const bf16_t* GATES; bf16_t* MERGED;
    __device__ __forceinline__ void operator()(const Acc& acc, const pg8::Unit& u, int wr, int wc, int fr, int fq) const {
        const int row0 = u.pm * 256 + wr * 64 + fr, col0 = u.pn * 256 + wc * 32 + 8 * fq;
#pragma unroll
        for (int ai = 0; ai < 2; ++ai)
#pragma unroll
            for (int m = 0; m < 4; ++m) { const int row = row0 + ai * 128 + m * 16;
#pragma unroll
                for (int bj = 0; bj < 2; ++bj) { const int col = col0 + bj * 128; f32x4 g0, g1; unpack8(*(const u32x4*)(GATES + (size_t)row * 4096 + 2048 + col), g0, g1);
                    const float* s = TMP + (size_t)row * DM + col; const f32x4 t0 = *(const f32x4*)s, t1 = *(const f32x4*)(s + 4);
                    *(u32x4*)(MERGED + (size_t)row * DM + col) = pack8u(t0 + acc[ai][bj][m][0] * g0, t1 + acc[ai][bj][m][1] * g1); } }
    }
};
struct Epi4 { static constexpr bool PERM = true;
    const float* x; float* out; bf16_t* H1B; float* ssq;
    __device__ __forceinline__ void operator()(const Acc& acc, const pg8::Unit& u, int wr, int wc, int fr, int fq) const {
        const int row0 = u.pm * 256 + wr * 64 + fr, col0 = u.pn * 256 + wc * 32 + 8 * fq;
#pragma unroll
        for (int ai = 0; ai < 2; ++ai)
#pragma unroll
            for (int m = 0; m < 4; ++m) { const int row = row0 + ai * 128 + m * 16; const size_t orow = (size_t)row; float ss = 0.f;
#pragma unroll
                    for (int bj = 0; bj < 2; ++bj) { const int col = col0 + bj * 128; const float* xs = x + orow * DM + col;
                        const f32x4 h0 = *(const f32x4*)xs + acc[ai][bj][m][0], h1 = *(const f32x4*)(xs + 4) + acc[ai][bj][m][1];
                        float* d = out + orow * DM + col; *(f32x4*)d = h0; *(f32x4*)(d + 4) = h1;
                        *(u32x4*)(H1B + (size_t)row * DM + col) = pack8u(h0, h1);
                        ss += (h0[0] * h0[0] + h0[1] * h0[1]) + (h0[2] * h0[2] + h0[3] * h0[3]) + (h1[0] * h1[0] + h1[1] * h1[1]) + (h1[2] * h1[2] + h1[3] * h1[3]); }
                    ss += __shfl_xor(ss, 16); ss += __shfl_xor(ss, 32);
                    if (fq == 0) unsafeAtomicAdd(ssq + row, ss); }
    }
};
struct Epi5 { static constexpr bool PERM = true;
    const float* ssq; bf16_t* ACT;
    __device__ __forceinline__ void operator()(const Acc& acc, const pg8::Unit& u, int wr, int wc, int fr, int fq) const {
        const int row0 = u.pm * 256 + wr * 64 + fr, col0 = u.pn * 128 + wc * 32 + 8 * fq;
#pragma unroll
        for (int ai = 0; ai < 2; ++ai)
#pragma unroll
            for (int m = 0; m < 4; ++m) { const int row = row0 + ai * 128 + m * 16; const float rs = __builtin_amdgcn_rsqf(ssq[row] * (1.0f / 2048.0f) + 1e-6f);
                f32x4 o[2];
#pragma unroll
                for (int n = 0; n < 2; ++n) { const f32x4 g = acc[ai][0][m][n] * rs, up = acc[ai][1][m][n] * rs;
#pragma unroll
                    for (int j = 0; j < 4; ++j) o[n][j] = g[j] * sigmoidf_(g[j]) * up[j]; }
                *(u32x4*)(ACT + (size_t)row * DFF + col0) = pack8u(o[0], o[1]); }
    }
};
struct Epi6 { static constexpr bool PERM = true;
    float* out; float* ssq;
    __device__ __forceinline__ void operator()(const Acc& acc, const pg8::Unit& u, int wr, int wc, int fr, int fq) const {
        const int row0 = u.pm * 256 + wr * 64 + fr, col0 = u.pn * 256 + wc * 32 + 8 * fq;
#pragma unroll
        for (int ai = 0; ai < 2; ++ai)
#pragma unroll
            for (int m = 0; m < 4; ++m) { const int row = row0 + ai * 128 + m * 16; const size_t orow = (size_t)row; float ss = 0.f;
#pragma unroll
                    for (int bj = 0; bj < 2; ++bj) { const int col = col0 + bj * 128; float* d = out + orow * DM + col;
                        const f32x4 h0 = *(const f32x4*)d + acc[ai][bj][m][0], h1 = *(const f32x4*)(d + 4) + acc[ai][bj][m][1];
                        *(f32x4*)d = h0; *(f32x4*)(d + 4) = h1;
                        ss += (h0[0] * h0[0] + h0[1] * h0[1]) + (h0[2] * h0[2] + h0[3] * h0[3]) + (h1[0] * h1[0] + h1[1] * h1[1]) + (h1[2] * h1[2] + h1[3] * h1[3]); }
                    ss += __shfl_xor(ss, 16); ss += __shfl_xor(ss, 32);
                    if (fq == 0) unsafeAtomicAdd(ssq + row, ss); }
    }
};

namespace att {
constexpr int D = 128, NW = 8, QBLK = 32, KVBLK = 64, QB = 256;
constexpr int SHM_V = KVBLK * D * 2, SHM_K = KVBLK * D * 2;
constexpr int LDS_WS = 2 * SHM_V + 2 * SHM_K;
constexpr int LDS_TAB = LDS_WS + NW * 64 * 4;
constexpr float SCALE = 0.08838834764831845f;
constexpr float THR = 8.f;
#define KSWZ(row, colB) ((row) * 256 + ((colB) ^ (((row) & 7) << 4)))
#define SBAR() __builtin_amdgcn_sched_barrier(0)
__device__ __forceinline__ int v_st(int k, int c) { const int kk = (k & ~0xC) | ((k & 4) << 1) | ((k & 8) >> 1); return ((kk >> 3) * 4 + (c >> 5)) * 512 + ((kk & 7) * 32 + (c & 31)) * 2; }
__device__ __forceinline__ int v_rd_base(int lane) { return ((lane & 3) << 3) | (((lane >> 2) & 3) << 6) | (((lane >> 4) & 1) << 5) | (((lane >> 5) & 1) << 8); }
constexpr int v_rd_off(int d0, int ks, int half) { return d0 * 512 + ks * 4096 + half * 2048; }
__device__ __forceinline__ int crow(int r, int hi) { return (r & 3) + 8 * (r >> 2) + 4 * hi; }
__device__ __forceinline__ unsigned cvtpk(float lo, float hi) { unsigned r; asm volatile("v_cvt_pk_bf16_f32 %0, %1, %2" : "=v"(r) : "v"(lo), "v"(hi)); return r; }
__device__ __forceinline__ bf16x8 load8(const bf16_t* p) { return *reinterpret_cast<const bf16x8*>(p); }
__device__ __forceinline__ void mask_tile(f32x16& p0, f32x16& p1, int dqe, int dqt, unsigned W, float s2) {
    const float NEG = -__builtin_inff();
#pragma unroll
    for (int r = 0; r < 16; ++r) {
        const int c = (r & 3) + 8 * (r >> 2);
        const int a0 = c - dqt, a1 = c + 32 - dqt;
        p0[r] -= s2 * (float)(a0 > 0 ? a0 : 0);
        p1[r] -= s2 * (float)(a1 > 0 ? a1 : 0);
        if ((unsigned)(dqe - c) >= W) p0[r] = NEG;
        if ((unsigned)(dqe - c - 32) >= W) p1[r] = NEG;
    }
}
__device__ __forceinline__ void partialSM(f32x16& p0, f32x16& p1, float& m_reg, float& mn, float& alpha) {
    float pmax = p0[0]; for (int r = 1; r < 16; ++r) pmax = fmaxf(pmax, p0[r]); for (int r = 0; r < 16; ++r) pmax = fmaxf(pmax, p1[r]);
    { auto rr = __builtin_amdgcn_permlane32_swap(__float_as_uint(pmax), __float_as_uint(pmax), false, false);
      pmax = fmaxf(__uint_as_float(rr[0]), __uint_as_float(rr[1])); }
    constexpr float C2 = 1.4426950408889634f * SCALE;
    if (__builtin_expect(__all((pmax - m_reg) * SCALE <= THR), 1)) { mn = m_reg; alpha = 1.f; }
    else { mn = fmaxf(m_reg, pmax); alpha = __builtin_amdgcn_exp2f((m_reg - mn) * C2); m_reg = mn; }
    const float mnL = -mn * C2;
    for (int r = 0; r < 16; ++r) p0[r] = fmaf(p0[r], C2, mnL); for (int r = 0; r < 16; ++r) p1[r] = fmaf(p1[r], C2, mnL);
    for (int r = 0; r < 16; ++r) p0[r] = __builtin_amdgcn_exp2f(p0[r]);
}
__device__ __forceinline__ void finishSM(f32x16& p0, f32x16& p1, float alpha, float& l_reg, bf16x8& pa0, bf16x8& pa1, bf16x8& pa2, bf16x8& pa3) {
    for (int r = 0; r < 16; ++r) p1[r] = __builtin_amdgcn_exp2f(p1[r]);
    float ps = 0; for (int r = 0; r < 16; ++r) ps += p0[r]; for (int r = 0; r < 16; ++r) ps += p1[r];
    { auto rr = __builtin_amdgcn_permlane32_swap(__float_as_uint(ps), __float_as_uint(ps), false, false);
      ps = __uint_as_float(rr[0]) + __uint_as_float(rr[1]); }
    l_reg = l_reg * alpha + ps;
#define PK4(P, B_, OUT) do { unsigned a0 = cvtpk(P[B_+0], P[B_+1]), a1 = cvtpk(P[B_+2], P[B_+3]);                          \
        unsigned b0 = cvtpk(P[B_+4], P[B_+5]), b1 = cvtpk(P[B_+6], P[B_+7]);                                             \
        auto r0 = __builtin_amdgcn_permlane32_swap(a0, b0, false, false); auto r1 = __builtin_amdgcn_permlane32_swap(a1, b1, false, false); \
        u32x4 w = {r0[0], r1[0], r0[1], r1[1]}; OUT = *reinterpret_cast<bf16x8*>(&w); } while (0)
    PK4(p0, 0, pa0); PK4(p0, 8, pa1); PK4(p1, 0, pa2); PK4(p1, 8, pa3);
#undef PK4
}
template <int KB>
__device__ __forceinline__ void qkt(f32x16& p0, f32x16& p1, const char* K_lds, int r32, int hi, const bf16x8* qr) {
    p0 = f32x16{}; p1 = f32x16{};
    const char* kb[4];
#pragma unroll
    for (int dd = 0; dd < 4; ++dd) kb[dd] = K_lds + KB * SHM_K + KSWZ(r32, (dd * 16 + hi * 8) * 2);
#pragma unroll
    for (int d0 = 0; d0 < 8; ++d0) { const char* a = kb[d0 & 3] + (d0 >> 2) * 128;
        bf16x8 b0 = *reinterpret_cast<const bf16x8*>(a);
        bf16x8 b1 = *reinterpret_cast<const bf16x8*>(a + 32 * 256);
        p0 = __builtin_amdgcn_mfma_f32_32x32x16_bf16(b0, qr[d0], p0, 0, 0, 0);
        p1 = __builtin_amdgcn_mfma_f32_32x32x16_bf16(b1, qr[d0], p1, 0, 0, 0); }
}
template <int VB>
__device__ __forceinline__ void pv_tile(f32x16* o, int vb0, bf16x8 pa0, bf16x8 pa1, bf16x8 pa2, bf16x8 pa3) {
#define TRRD(dst, off) asm volatile("ds_read_b64_tr_b16 %0, %1 offset:%2" : "=&v"(dst) : "v"(vb0), "i"(off) : "memory")
#define PV_D0(d0) do { s16x4 l0, l1, l2, l3, h0, h1, h2, h3; constexpr int b_ = VB * SHM_V + v_rd_off(d0, 0, 0); \
        TRRD(l0, b_); TRRD(h0, b_ + 2048); TRRD(l1, b_ + 4096); TRRD(h1, b_ + 6144); TRRD(l2, b_ + 8192); TRRD(h2, b_ + 10240); TRRD(l3, b_ + 12288); TRRD(h3, b_ + 14336); \
        asm volatile("s_waitcnt lgkmcnt(0)" ::: "memory"); SBAR();   \
        o[d0] = __builtin_amdgcn_mfma_f32_32x32x16_bf16(pa0, (bf16x8){l0[0], l0[1], l0[2], l0[3], h0[0], h0[1], h0[2], h0[3]}, o[d0], 0, 0, 0);   \
        o[d0] = __builtin_amdgcn_mfma_f32_32x32x16_bf16(pa1, (bf16x8){l1[0], l1[1], l1[2], l1[3], h1[0], h1[1], h1[2], h1[3]}, o[d0], 0, 0, 0);   \
        o[d0] = __builtin_amdgcn_mfma_f32_32x32x16_bf16(pa2, (bf16x8){l2[0], l2[1], l2[2], l2[3], h2[0], h2[1], h2[2], h2[3]}, o[d0], 0, 0, 0);   \
        o[d0] = __builtin_amdgcn_mfma_f32_32x32x16_bf16(pa3, (bf16x8){l3[0], l3[1], l3[2], l3[3], h3[0], h3[1], h3[2], h3[3]}, o[d0], 0, 0, 0); } while (0)
    PV_D0(0); PV_D0(1); PV_D0(2); PV_D0(3);
#undef PV_D0
#undef TRRD
}
struct Blk { const bf16_t* Q; const bf16_t* K; const bf16_t* V; const bf16_t* K0; const bf16_t* V0; bf16_t* O; int P0; int mode; float s2; };
struct Seam { bf16x8 qr[8]; bf16x8 st_v0, st_v1, st_k0, st_k1; };
#define ROW(p, k0, rr) ((p) + (size_t)((k0) + (rr)) * D + sc)
#define VMW() asm volatile("s_waitcnt vmcnt(0)" ::: "memory")
#define VMWN(n) asm volatile("s_waitcnt vmcnt(%0)" :: "i"(n) : "memory")
#define SLOAD_H(Kp, Vp, k0) do { S.st_v0 = load8(ROW(Vp, k0, sr)); S.st_v1 = load8(ROW(Vp, k0, 32 + sr));              \
                         S.st_k0 = load8(ROW(Kp, k0, sr)); S.st_k1 = load8(ROW(Kp, k0, 32 + sr)); } while (0)
#define SWRITE_HK(bf) do { *(bf16x8*)(K_lds + (bf) * SHM_K + kws) = S.st_k0; *(bf16x8*)(K_lds + (bf) * SHM_K + kws + 32 * 256) = S.st_k1; } while (0)
#define SWRITE_HV(bf) do { *(bf16x8*)(V_lds + (bf) * SHM_V + vst0) = S.st_v0; *(bf16x8*)(V_lds + (bf) * SHM_V + vst1) = S.st_v1; } while (0)
#define SWRITE_H(bf) do { SWRITE_HV(bf); SWRITE_HK(bf); } while (0)
__device__ __forceinline__ void attn_prime(const Blk& cur, char* lds, Seam& S, const int tid) {
    const int wid = __builtin_amdgcn_readfirstlane(tid >> 6), lane = tid & 63, r32 = lane & 31, hi = lane >> 5;
    const int sr = tid >> 4, sc = (tid & 15) * 8, kws = KSWZ(sr, sc * 2); char* K_lds = lds + 2 * SHM_V;
    for (int d0 = 0; d0 < 8; ++d0) S.qr[d0] = load8(cur.Q + (size_t)(wid * QBLK + r32) * D + d0 * 16 + hi * 8);
    SLOAD_H(cur.K0, cur.V0, 0); VMW(); SWRITE_HK(0);
    __syncthreads();
}
__device__ __forceinline__ void attn_block(const Blk& cur, const Blk& nxt, char* lds, Seam& S, float lam, float* scrT, float* scrD, const float* g_subln, const int tid) {
    const int wid = __builtin_amdgcn_readfirstlane(tid >> 6), lane = tid & 63, r32 = lane & 31, hi = lane >> 5;
    const int NT = (cur.P0 + QB - 1) / KVBLK + 1;
    const int qlo = cur.P0 + wid * QBLK;
    const int qt4 = qlo + r32 - 4 * hi;
    const bool isdiff = cur.mode != 0;
    char* V_lds = lds; char* K_lds = lds + 2 * SHM_V;
    float* ws = (float*)(lds + LDS_WS) + wid * 64; float* li_l = ws, * al_l = ws + 32;
    float m_reg = ((const float*)(lds + LDS_TAB))[qlo + r32] - 226.27417f, l_reg = 0; f32x16 o[4] = {};
    const int sr = tid >> 4, sc = (tid & 15) * 8, vst0 = v_st(sr, sc), vst1 = v_st(32 + sr, sc), kws = KSWZ(sr, sc * 2);
    const int vb0 = (int)(uintptr_t)V_lds + v_rd_base(lane);
    const bf16_t* Kh = cur.K; const bf16_t* Vh = cur.V;
#define RESC(a) do { if (__any((a) < 1.f)) { if (hi == 0) al_l[r32] = (a); asm volatile("s_waitcnt lgkmcnt(0)" ::: "memory");              \
                     for (int d_ = 0; d_ < 4; ++d_) for (int r = 0; r < 16; ++r) o[d_][r] *= al_l[crow(r, hi)]; } } while (0)
#define KBASE(t) ((t) * KVBLK)
#define BIAS(P0_, P1_, t) do { int h_ = hi; asm volatile("" : "+v"(h_)); const float* tb_ = (const float*)(lds + LDS_TAB) + (4 * h_ + KBASE(t));         \
        _Pragma("unroll") for (int i_ = 0; i_ < 4; ++i_) { const f32x4 b0_ = *(const f32x4*)(tb_ + 8 * i_), b1_ = *(const f32x4*)(tb_ + 32 + 8 * i_); \
            _Pragma("unroll") for (int j_ = 0; j_ < 4; ++j_) { P0_[4 * i_ + j_] += b0_[j_]; P1_[4 * i_ + j_] += b1_[j_]; } } } while (0)
#define MASKT(P0_, P1_, t) do { const int kb_ = KBASE(t); BIAS(P0_, P1_, t); if (kb_ + KVBLK - 1 > qlo || kb_ == 0) { int q_ = qt4; asm volatile("" : "+v"(q_)); const int qt_ = q_ + 4 * hi, qe_ = isdiff ? (qt_ | 63) : qt_;      \
            mask_tile(P0_, P1_, qe_ - kb_ - 4 * hi, q_ - kb_, (unsigned)(qe_ - 47), cur.s2); } } while (0)
#define SEAM_K0() do { VMWN(8); SWRITE_HK(0); SBAR(); } while (0)
    f32x16 pA0, pA1, pB0, pB1; float mnA, mnB, alA, alB; bf16x8 pa0, pa1, pa2, pa3;
    SWRITE_HV(0); SBAR();
    if (NT > 1) { SLOAD_H(Kh, Vh, KBASE(1)); }
    SBAR(); qkt<0>(pA0, pA1, K_lds, r32, hi, S.qr);
    MASKT(pA0, pA1, 0); partialSM(pA0, pA1, m_reg, mnA, alA);
    if (NT > 1) { VMW(); SWRITE_H(1); }
    __syncthreads();
#define HALF_STEP(PX0, PX1, mnX, alX, PY0, PY1, alY, t, KB, VB, SB_) do {                                                      \
        SBAR(); qkt<KB>(PX0, PX1, K_lds, r32, hi, S.qr);                                             \
        finishSM(PY0, PY1, alY, l_reg, pa0, pa1, pa2, pa3); SBAR();                                                           \
        if ((t) + 1 < NT) { SLOAD_H(Kh, Vh, KBASE((t) + 1)); SBAR(); }                                               \
        pv_tile<VB>(o, vb0, pa0, pa1, pa2, pa3); MASKT(PX0, PX1, (t)); partialSM(PX0, PX1, m_reg, mnX, alX);                                        \
        __syncthreads();                                                                                                      \
        if ((t) + 1 < NT) { VMW(); SWRITE_H(SB_); }                                                                          \
        RESC(alX); __syncthreads(); } while (0)
    for (int t = 1; t + 1 < NT; t += 2) {
        HALF_STEP(pB0, pB1, mnB, alB, pA0, pA1, alA, t, 1, 0, 0);
        HALF_STEP(pA0, pA1, mnA, alA, pB0, pB1, alB, t + 1, 0, 1, 1);
    }
    const bool even = (NT & 1) == 0;
    if (even) { SBAR(); qkt<1>(pB0, pB1, K_lds, r32, hi, S.qr); SBAR(); }
    { int t2 = tid; asm volatile("" : "+v"(t2));
      const int sr2 = t2 >> 4, sc2 = (t2 & 15) * 8, l2 = t2 & 63;
      const unsigned off = (unsigned)(sr2 * D + sc2);
      S.st_v0 = load8(nxt.V0 + off); S.st_v1 = load8(nxt.V0 + off + 32 * D); S.st_k0 = load8(nxt.K0 + off); S.st_k1 = load8(nxt.K0 + off + 32 * D); SBAR();
      const unsigned qoff = (unsigned)((wid * QBLK + (l2 & 31)) * D + (l2 >> 5) * 8);
#pragma unroll
      for (int d0 = 0; d0 < 8; ++d0) S.qr[d0] = load8(nxt.Q + qoff + d0 * 16); }
    SBAR();
    finishSM(pA0, pA1, alA, l_reg, pa0, pa1, pa2, pa3); SBAR();
    pv_tile<0>(o, vb0, pa0, pa1, pa2, pa3);
    if (even) { MASKT(pB0, pB1, NT - 1); partialSM(pB0, pB1, m_reg, mnB, alB); __syncthreads(); RESC(alB);
        finishSM(pB0, pB1, alB, l_reg, pa0, pa1, pa2, pa3); SBAR(); pv_tile<1>(o, vb0, pa0, pa1, pa2, pa3); }
    SBAR(); SEAM_K0();
    int ln = lane; asm volatile("" : "+v"(ln));
    const int r32e = ln & 31;
    if (hi == 0) li_l[r32] = l_reg; asm volatile("s_waitcnt lgkmcnt(0)" ::: "memory");
    float rli[16];
#pragma unroll
    for (int r = 0; r < 16; ++r) rli[r] = __builtin_amdgcn_rcpf(li_l[crow(r, hi)]);
    const int mode = cur.mode;
    if (mode == 0) {
        bf16_t* Ow = cur.O + (size_t)(wid * QBLK) * 1024;
#pragma unroll
        for (int r = 0; r < 16; ++r) { const int orow = crow(r, hi);
#pragma unroll
            for (int d0 = 0; d0 < 4; ++d0) { const float v = o[d0][r] * rli[r]; const float vn = __shfl_xor(v, 1);
                if ((r32e & 1) == 0) *(unsigned*)(Ow + (orow * 1024 + d0 * 32 + r32e)) = cvtpk(v, vn); } }
    } else if (mode == 1) {
        float* T = scrT + (wid * 4096 + ln);
#pragma unroll
        for (int r = 0; r < 16; ++r)
#pragma unroll
            for (int d0 = 0; d0 < 4; ++d0) T[(r * 4 + d0) * 64] = o[d0][r] * rli[r];
    } else {
        const float* T = scrT + (wid * 4096 + ln); float* Dl = scrD + (wid * 4096 + ln);
#pragma unroll
        for (int r = 0; r < 16; ++r)
#pragma unroll
            for (int d0 = 0; d0 < 4; ++d0) o[d0][r] = __hip_atomic_load(T + (r * 4 + d0) * 64, __ATOMIC_RELAXED, __HIP_MEMORY_SCOPE_AGENT) - lam * (o[d0][r] * rli[r]);
        if (mode == 2) {
#pragma unroll
            for (int r = 0; r < 16; ++r)
#pragma unroll
                for (int d0 = 0; d0 < 4; ++d0) Dl[(r * 4 + d0) * 64] = o[d0][r];
        } else {
            bf16_t* Ow = cur.O + (size_t)(wid * QBLK) * 1024;
            float gs0[4], gs1[4];
#pragma unroll
            for (int d0 = 0; d0 < 4; ++d0) { gs0[d0] = g_subln[d0 * 32 + r32e] * 0.8f; gs1[d0] = g_subln[128 + d0 * 32 + r32e] * 0.8f; }
#pragma unroll
            for (int r = 0; r < 16; ++r) { const int orow = crow(r, hi);
                float e0[4]; float ss = 0.f;
#pragma unroll
                for (int d0 = 0; d0 < 4; ++d0) { e0[d0] = __hip_atomic_load(Dl + (r * 4 + d0) * 64, __ATOMIC_RELAXED, __HIP_MEMORY_SCOPE_AGENT); ss += e0[d0] * e0[d0] + o[d0][r] * o[d0][r]; }
                ss += __shfl_xor(ss, 1); ss += __shfl_xor(ss, 2); ss += __shfl_xor(ss, 4); ss += __shfl_xor(ss, 8); ss += __shfl_xor(ss, 16);
                const float rn = __builtin_amdgcn_rsqf(ss * (1.0f / 256.0f) + 1e-5f);
#pragma unroll
                for (int d0 = 0; d0 < 4; ++d0) { const float v0 = e0[d0] * rn * gs0[d0], v1 = o[d0][r] * rn * gs1[d0]; const float v0n = __shfl_xor(v0, 1), v1n = __shfl_xor(v1, 1);
                    if ((r32e & 1) == 0) { *(unsigned*)(Ow + (orow * 1024 + d0 * 32 + r32e)) = cvtpk(v0, v0n); *(unsigned*)(Ow + (orow * 1024 + 128 + d0 * 32 + r32e)) = cvtpk(v1, v1n); } }
                asm volatile("" ::: "memory"); }
        }
    }
    __syncthreads();
#undef RESC
#undef KBASE
#undef BIAS
#undef MASKT
#undef SEAM_K0
#undef HALF_STEP
}
#undef ROW
#undef VMW
#undef VMWN
#undef SLOAD_H
#undef SWRITE_HK
#undef SWRITE_HV
#undef SWRITE_H
}

struct Params { const float* in[18]; float* out; unsigned char* ws; int ph_lo, ph_hi; };

__device__ __forceinline__ void transpose_job(const float* __restrict__ src, int ld, int col0, int nN, int Kdim, bf16_t* __restrict__ dst, int up, const float* __restrict__ scale, float* tile, const int tid) {
    const int nK = Kdim / 64, total = nK * nN;
    f32x4 v[2];
    int t = blockIdx.x;
    if (t < total) { const int k0 = (t / nN) * 64, n0 = (t % nN) * 64;
#pragma unroll
        for (int i = 0; i < 2; ++i) { const int idx = tid + 512 * i, kk = idx >> 4, c4 = idx & 15; v[i] = *(const f32x4*)(src + (size_t)(k0 + kk) * ld + col0 + n0 + c4 * 4) * (scale ? scale[k0 + kk] : 1.0f); } }
    for (; t < total; t += gridDim.x) {
        const int k0 = (t / nN) * 64, n0 = (t % nN) * 64;
#pragma unroll
        for (int i = 0; i < 2; ++i) { const int idx = tid + 512 * i, kk = idx >> 4, c4 = idx & 15;
#pragma unroll
            for (int j = 0; j < 4; ++j) tile[kk * 65 + c4 * 4 + j] = v[i][j]; }
        const int tn = t + gridDim.x;
        if (tn < total) { const int k1 = (tn / nN) * 64, n1 = (tn % nN) * 64;
#pragma unroll
            for (int i = 0; i < 2; ++i) { const int idx = tid + 512 * i, kk = idx >> 4, c4 = idx & 15; v[i] = *(const f32x4*)(src + (size_t)(k1 + kk) * ld + col0 + n1 + c4 * 4) * (scale ? scale[k1 + kk] : 1.0f); } }
        __syncthreads();
        { const int n = tid >> 3, kc = (tid & 7) * 8; f32x4 a, b;
#pragma unroll
            for (int j = 0; j < 4; ++j) { a[j] = tile[(kc + j) * 65 + n]; b[j] = tile[(kc + 4 + j) * 65 + n]; }
            const int drow = (up < 0) ? (n0 + n) : (256 * (n0 >> 7) + (n0 & 127) + up * 128 + n);
            *(u32x4*)(dst + (size_t)drow * Kdim + k0 + kc) = pack8u(a, b); }
        __syncthreads();
    }
}

__global__ void __launch_bounds__(512, 2) fwd_kernel(Params p) {
    extern __shared__ __attribute__((aligned(16))) unsigned char lds[];
    cg::grid_group grid = cg::this_grid();
    const int wid = __builtin_amdgcn_readfirstlane(threadIdx.x >> 6), G = gridDim.x, bx = blockIdx.x;
    unsigned char* ws = p.ws;
    bf16_t* W1T = (bf16_t*)(ws + WS_W1T); bf16_t* WAT = (bf16_t*)(ws + WS_WAT); bf16_t* WFT = (bf16_t*)(ws + WS_WFT); bf16_t* WOT = (bf16_t*)(ws + WS_WOT);
    bf16_t* W5T = (bf16_t*)(ws + WS_W5T); bf16_t* WDT = (bf16_t*)(ws + WS_WDT);
    bf16_t* XB = (bf16_t*)(ws + WS_RA); bf16_t* OA = (bf16_t*)(ws + WS_RA); bf16_t* OF = (bf16_t*)(ws + WS_RA + (size_t)M * 1024 * 2); bf16_t* H1B = (bf16_t*)(ws + WS_RA);
    bf16_t* QKV = (bf16_t*)(ws + WS_RB); float* TMP = (float*)(ws + WS_RB); bf16_t* MERGED = (bf16_t*)(ws + WS_RB + (size_t)M * DM * 4); bf16_t* ACT = (bf16_t*)(ws + WS_RB);
    bf16_t* GATES = (bf16_t*)(ws + WS_RG);
    float* RSTD1 = (float*)(ws + WS_RSTD1); float* SSQ2 = (float*)(ws + WS_SSQ2); float* SSQ3 = (float*)(ws + WS_SSQ3);
    float* LOGF = (float*)(ws + WS_LOGF); float* CUM = (float*)(ws + WS_CUM);
    const int lo = p.ph_lo, hi_ = p.ph_hi;
#define IN(k) (lo <= (k) && (k) < hi_)
#define SEAM(k) do { if (IN(k) && IN((k) + 1)) grid.sync(); } while (0)

    for (int rep_ = 0; rep_ < (REP_PHASE == 0 ? 2 : 1); ++rep_) if (IN(0)) {
        if (rep_) grid.sync();
        const int lane = fresh_lane(), tid = wid * 64 + lane;
        float* tile = (float*)lds;
        const float* w_in = p.in[3];
        transpose_job(w_in, NINC, 0, 96, DM, W1T, -1, p.in[2], tile, tid);
        transpose_job(w_in, NINC, 6152, 64, DM, W1T + (size_t)6144 * DM, -1, p.in[2], tile, tid);
        transpose_job(p.in[10], DM, 0, 32, 1024, WAT, -1, nullptr, tile, tid);
        transpose_job(p.in[11], DM, 0, 32, 1024, WFT, -1, nullptr, tile, tid);
        transpose_job(p.in[12], DM, 0, 32, DM, WOT, -1, nullptr, tile, tid);
        transpose_job(p.in[14], DFF, 0, 88, DM, W5T, 0, p.in[13], tile, tid);
        transpose_job(p.in[15], DFF, 0, 88, DM, W5T, 1, p.in[13], tile, tid);
        transpose_job(p.in[16], DM, 0, 32, DFF, WDT, -1, nullptr, tile, tid);
        float* WF = (float*)lds;
        for (int k = tid; k < DM; k += 512) { const float g = p.in[2][k]; const f32x4 a = *(const f32x4*)(w_in + (size_t)k * NINC + 6144), b = *(const f32x4*)(w_in + (size_t)k * NINC + 6148);
#pragma unroll
            for (int j = 0; j < 4; ++j) { WF[j * DM + k] = a[j] * g; WF[(4 + j) * DM + k] = b[j] * g; } }
        __syncthreads();
        const float* x = p.in[0]; const float* meta = p.in[1]; const float* b_f = p.in[9];
        for (int job = bx * 8 + wid; job < M + NMETA; job += G * 8) {
            const bool ismeta = job >= M; const int row = ismeta ? job + VPAD : job;
            const float* src = ismeta ? meta + (size_t)(job - M) * DM : x + (size_t)job * DM;
            f32x4 v[8]; float ss = 0.f; float zf[8];
#pragma unroll
            for (int j = 0; j < 8; ++j) zf[j] = 0.f;
#pragma unroll
            for (int i = 0; i < 8; ++i) { v[i] = *(const f32x4*)(src + i * 256 + lane * 4);
                ss += (v[i][0] * v[i][0] + v[i][1] * v[i][1]) + (v[i][2] * v[i][2] + v[i][3] * v[i][3]); }
#pragma unroll
            for (int i = 0; i < 8; ++i) {
                u32x2 w; w.x = pg8::cvt_pk_bf16(v[i][0], v[i][1]); w.y = pg8::cvt_pk_bf16(v[i][2], v[i][3]);
                *(u32x2*)(XB + (size_t)row * DM + i * 256 + lane * 4) = w;
#pragma unroll
                for (int j = 0; j < 8; ++j) { const f32x4 wv = *(const f32x4*)(WF + j * DM + i * 256 + lane * 4); zf[j] += (v[i][0] * wv[0] + v[i][1] * wv[1]) + (v[i][2] * wv[2] + v[i][3] * wv[3]); } }
            ss = wave_sum(ss);
#pragma unroll
            for (int j = 0; j < 8; ++j) zf[j] = wave_sum(zf[j]);
            const float rs = __builtin_amdgcn_rsqf(ss * (1.0f / 2048.0f) + 1e-6f);
            if (lane == 0) { RSTD1[row] = rs; if (!ismeta) { SSQ2[row] = 0.f; SSQ3[row] = 0.f; } }
            if (lane < 8) { float zz = zf[0];
#pragma unroll
                for (int j = 1; j < 8; ++j) zz = (lane == j) ? zf[j] : zz;
                const float y = zz * rs + b_f[lane];
                const float lf = fminf(y, 0.f) - log1pf(__expf(-fabsf(y)));
                if (!ismeta) { const int b = job >> 13, t = job & (SEQ - 1); LOGF[(size_t)(b * 8 + lane) * LB + 64 + t] = lf; }
                else { const int vp = VPAD + (job - M);
#pragma unroll
                    for (int b = 0; b < NBATCH; ++b) LOGF[(size_t)(b * 8 + lane) * LB + vp] = lf; } }
        }
        if (bx == 0) for (int i = tid; i < 32 * VPAD; i += 512) LOGF[(size_t)(i / VPAD) * LB + (i % VPAD)] = 0.f;
        __syncthreads();
    }
    SEAM(0);

    for (int rep_ = 0; rep_ < (REP_PHASE == 1 ? 2 : 1); ++rep_) if (IN(1)) {
        if (rep_) grid.sync();
        const int lane = fresh_lane(), tid = wid * 64 + lane;
        if (bx < 32) {
            const float* srcp = LOGF + (size_t)bx * LB; float* dstp = CUM + (size_t)bx * LB; float* red = (float*)lds;
            const int i0 = tid * 17; float vals[17]; float s = 0.f;
#pragma unroll
            for (int i = 0; i < 17; ++i) { const int k = i0 + i; vals[i] = k < LB ? srcp[k] : 0.f; s += vals[i]; vals[i] = s; }
            float incl = s;
#pragma unroll
            for (int o = 1; o < 64; o <<= 1) { const float t = __shfl_up(incl, o); if (lane >= o) incl += t; }
            if (lane == 63) red[wid] = incl;
            __syncthreads();
            float base = incl - s;
            for (int w = 0; w < wid; ++w) base += red[w];
#pragma unroll
            for (int i = 0; i < 17; ++i) { const int k = i0 + i; if (k < LB) dstp[k] = (base + vals[i]) * 11.313708498984761f; }
            __syncthreads();
        }
        {
            bf16_t* xm = (bf16_t*)lds;
            for (int i = tid; i < 16 * 256; i += 512) *(u32x4*)(xm + (size_t)i * 8) = *(const u32x4*)(XB + (size_t)(M + VPAD) * DM + (size_t)i * 8);
            { const int i = bx * 512 + tid; if (i < 32 * VPAD * 16) { const int sl = i / (VPAD * 16), r = (i / 16) % VPAD, ch = i % 16; const int hd = sl < 16 ? 8 + sl : 16 + sl;
                *(u32x4*)(QKV + ((size_t)hd * MQ + M + r) * 128 + ch * 8) = (u32x4){0u, 0u, 0u, 0u}; } }
            __syncthreads();
            for (int c0 = bx * 16; c0 < 4096; c0 += G * 16) {
#pragma unroll 1
                for (int cc = 0; cc < 2; ++cc) { const int c = c0 + wid * 2 + cc, sl = c >> 7, hd = sl < 16 ? 8 + sl : 16 + sl, n = hd * 128 + (c & 127);
                    f32x4 wa[8];
#pragma unroll
                    for (int q = 0; q < 4; ++q) unpack8(*(const u32x4*)(W1T + (size_t)n * DM + lane * 32 + q * 8), wa[2 * q], wa[2 * q + 1]);
                    float mine = 0.f;
#pragma unroll 1
                    for (int j = 0; j < 16; ++j) { float a = 0.f;
#pragma unroll
                        for (int q = 0; q < 4; ++q) { f32x4 x0, x1; unpack8(*(const u32x4*)(xm + (size_t)j * DM + lane * 32 + q * 8), x0, x1);
                            a += (x0[0] * wa[2 * q][0] + x0[1] * wa[2 * q][1]) + (x0[2] * wa[2 * q][2] + x0[3] * wa[2 * q][3]) + (x1[0] * wa[2 * q + 1][0] + x1[1] * wa[2 * q + 1][1]) + (x1[2] * wa[2 * q + 1][2] + x1[3] * wa[2 * q + 1][3]); }
                        a = wave_sum(a); mine = (lane == j) ? a : mine; }
                    if (lane < 16) { const float v = mine * RSTD1[M + VPAD + lane]; QKV[((size_t)hd * MQ + M + VPAD + lane) * 128 + (c & 127)] = (bf16_t)(pg8::cvt_pk_bf16(v, v) & 0xffffu); } }
            }
            __syncthreads();
        }
        pg8::Gemm g{XB, W1T, M, N1, DM}; pg8::StaticOrder S; S.init(M, N1, G, bx);
        Epi1 E{QKV, GATES, RSTD1};
        pg8::gemm_phase<Epi1, pg8::StaticOrder>((PG8_LAS unsigned char*)lds, g, S, E, wid * 64 + fresh_lane());
    }
    SEAM(1);

    for (int rep_ = 0; rep_ < (REP_PHASE == 2 ? 2 : 1); ++rep_) if (IN(2)) {
        if (rep_) grid.sync();
        const int lane = fresh_lane(), tid = wid * 64 + lane;
        float lam;
        { const float* q1 = p.in[4]; const float* k1 = p.in[5]; const float* q2 = p.in[6]; const float* k2 = p.in[7];
          float s1 = q1[lane] * k1[lane] + q1[lane + 64] * k1[lane + 64], s2 = q2[lane] * k2[lane] + q2[lane + 64] * k2[lane + 64];
          s1 = wave_sum(s1); s2 = wave_sum(s2); lam = __expf(s1) - __expf(s2) + 0.2f; lam = __uint_as_float(__builtin_amdgcn_readfirstlane(__float_as_uint(lam))); }
        const float* g_subln = p.in[8];
        float* scrT = (float*)(ws + WS_SCR + (size_t)bx * 262144); float* scrD = scrT + 32768;
        float* tabw = (float*)(lds + att::LDS_TAB);
        const int vcu = (G % 8 == 0) ? (bx % 8) * (G / 8) + bx / 8 : bx;
        const int nsi = (256 - vcu + G - 1) / G;
        const int nbp = nsi * 12;
        auto desc = [&](int bp) -> att::Blk {
            const int s = vcu + (bp / 12) * G, idx = bp % 12; att::Blk r;
            if (idx < 4) { const int pr = (s & ~31) * 2 + (s & 31) + 32 * (idx >> 1), bh = pr >> 4, y = pr & 15, qb = (idx & 1) ? 31 - y : y, b = bh >> 3, h = bh & 7;
                const size_t rb = (size_t)b * SEQ + 256 * qb; r.P0 = 64 + 256 * qb; r.mode = 0; r.s2 = 0.f;
                r.Q = QKV + ((size_t)(24 + h) * MQ + rb) * 128; r.K = QKV + ((size_t)(32 + h) * MQ + (size_t)b * SEQ) * 128 - 64 * 128; r.V = QKV + ((size_t)(40 + h) * MQ + (size_t)b * SEQ) * 128 - 64 * 128;
                r.K0 = QKV + ((size_t)(32 + h) * MQ + M) * 128; r.V0 = QKV + ((size_t)(40 + h) * MQ + M) * 128;
                r.O = OF + rb * 1024 + h * 128; }
            else { const int j = idx - 4, sel = j >> 2, pass = j & 3, e = pass >> 1, c = pass & 1, bh = s >> 4, y = s & 15, qb = sel ? 31 - y : y, b = bh >> 2, h = bh & 3;
                const size_t rb = (size_t)b * SEQ + 256 * qb; r.P0 = 64 + 256 * qb; r.mode = (c == 0) ? 1 : (e == 0 ? 2 : 3);
                r.s2 = 2.0f * 11.313708498984761f * (h == 0 ? 0.25f : h == 1 ? 0.0625f : h == 2 ? 0.015625f : 0.00390625f);
                r.Q = QKV + ((size_t)(2 * h + c) * MQ + rb) * 128; r.K = QKV + ((size_t)(8 + 2 * h + c) * MQ + (size_t)b * SEQ) * 128 - 64 * 128; r.V = QKV + ((size_t)(16 + 2 * h + e) * MQ + (size_t)b * SEQ) * 128 - 64 * 128;
                r.K0 = QKV + ((size_t)(8 + 2 * h + c) * MQ + M) * 128; r.V0 = QKV + ((size_t)(16 + 2 * h + e) * MQ + M) * 128;
                r.O = OA + rb * 1024 + h * 256; }
            return r; };
        if (nbp > 0) {
            att::Seam S;
            att::Blk cur = desc(0);
            att::attn_prime(cur, (char*)lds, S, wid * 64 + fresh_lane());
            for (int bp = 0; bp < nbp; ++bp) {
                const att::Blk nxt = desc(bp + 1 < nbp ? bp + 1 : bp);
                { const int s = vcu + (bp / 12) * G, idx = bp % 12; const int nk = cur.P0 + 256; const int tt = wid * 64 + fresh_lane();
                  if (idx < 4) { const int pr = (s & ~31) * 2 + (s & 31) + 32 * (idx >> 1), bh = pr >> 4; const float* cm = CUM + (size_t)bh * LB; const float cref = cm[cur.P0];
                      for (int k = tt; k < nk; k += 512) tabw[k] = cref - cm[k]; }
                  else { const float sl = 0.5f * cur.s2; for (int k = tt; k < nk; k += 512) tabw[k] = sl * (float)(k - cur.P0); } }
                __syncthreads();
                att::attn_block(cur, nxt, (char*)lds, S, lam, scrT, scrD, g_subln, wid * 64 + fresh_lane());
                cur = nxt;
            }
        }
        asm volatile("s_waitcnt vmcnt(0)" ::: "memory");
        __syncthreads();
    }
    SEAM(2);

    for (int rep_ = 0; rep_ < (REP_PHASE == 3 ? 2 : 1); ++rep_) if (IN(3)) {
        if (rep_) grid.sync();
        { pg8::Gemm g{OA, WAT, M, DM, 1024}; pg8::StaticOrder S; S.init(M, DM, G, bx); Epi3a E{TMP, GATES};
          pg8::gemm_phase<Epi3a, pg8::StaticOrder>((PG8_LAS unsigned char*)lds, g, S, E, wid * 64 + fresh_lane()); }
        { pg8::Gemm g{OF, WFT, M, DM, 1024}; pg8::StaticOrder S; S.init(M, DM, G, bx); Epi3b E{TMP, GATES, MERGED};
          pg8::gemm_phase<Epi3b, pg8::StaticOrder>((PG8_LAS unsigned char*)lds, g, S, E, wid * 64 + fresh_lane()); }
    }
    SEAM(3);

    if (IN(4)) {
        pg8::Gemm g{MERGED, WOT, M, DM, DM}; pg8::StaticOrder S; S.init(M, DM, G, bx); Epi4 E{p.in[0], p.out, H1B, SSQ2};
        pg8::gemm_phase<Epi4, pg8::StaticOrder>((PG8_LAS unsigned char*)lds, g, S, E, wid * 64 + fresh_lane());
    }
    SEAM(4);

    for (int rep_ = 0; rep_ < (REP_PHASE == 5 ? 2 : 1); ++rep_) if (IN(5)) {
        if (rep_) grid.sync();
        pg8::Gemm g{H1B, W5T, M, N5, DM}; pg8::StaticOrder S; S.init(M, N5, G, bx); Epi5 E{SSQ2, ACT};
        pg8::gemm_phase<Epi5, pg8::StaticOrder>((PG8_LAS unsigned char*)lds, g, S, E, wid * 64 + fresh_lane());
    }
    SEAM(5);

    if (IN(6)) {
        pg8::Gemm g{ACT, WDT, M, DM, DFF}; pg8::StaticOrder S; S.init(M, DM, G, bx); Epi6 E{p.out, SSQ3};
        pg8::gemm_phase<Epi6, pg8::StaticOrder>((PG8_LAS unsigned char*)lds, g, S, E, wid * 64 + fresh_lane());
    }
    SEAM(6);

    if (IN(7)) {
        const int lane = fresh_lane();
        const float* gfin = p.in[17];
        f32x4 gv[8];
#pragma unroll
        for (int i = 0; i < 8; ++i) gv[i] = *(const f32x4*)(gfin + i * 256 + lane * 4);
        for (int orow = bx * 8 + wid; orow < NBATCH * SEQ; orow += G * 8) {
            const int row = orow;
            const float rs = __builtin_amdgcn_rsqf(SSQ3[row] * (1.0f / 2048.0f) + 1e-6f);
            float* d = p.out + (size_t)orow * DM + lane * 4;
#pragma unroll
            for (int i = 0; i < 8; ++i) { const f32x4 v = *(const f32x4*)(d + i * 256); *(f32x4*)(d + i * 256) = v * rs * gv[i]; }
        }
    }
#undef IN
#undef SEAM
}

extern "C" void kernel_launch(void* const* d_in, const int* in_sizes, int n_in, void* d_out, int out_size, void* d_ws, size_t ws_size, hipStream_t stream) {
    static int grid = 0;
    if (grid == 0) {
        if (n_in != 18 || ws_size < WS_END) { fprintf(stderr, "kernel_launch: need 18 inputs and >= %zu bytes of workspace (got %d, %zu)\n", (size_t)WS_END, n_in, ws_size); grid = -1; return; }
        int dev = 0, cus = 0, per_cu = 0;
        (void)hipGetDevice(&dev);
        if (hipDeviceGetAttribute(&cus, hipDeviceAttributeMultiprocessorCount, dev) != hipSuccess || cus <= 0) cus = 256;
        if (hipFuncSetAttribute((const void*)fwd_kernel, hipFuncAttributeMaxDynamicSharedMemorySize, LDS_BYTES) != hipSuccess) { fprintf(stderr, "kernel_launch: hipFuncSetAttribute failed\n"); }
        if (hipOccupancyMaxActiveBlocksPerMultiprocessor(&per_cu, (const void*)fwd_kernel, 512, LDS_BYTES) != hipSuccess || per_cu < 1) { fprintf(stderr, "kernel_launch: occupancy query says %d\n", per_cu); per_cu = 1; }
        (void)hipGetLastError();
        grid = cus * 1;
        if (grid > 256) grid = 256;
    }
    if (grid < 0) return;
    Params p{};
    for (int i = 0; i < 18; ++i) p.in[i] = (const float*)d_in[i];
    p.out = (float*)d_out; p.ws = (unsigned char*)d_ws;
#if ONE_LAUNCH
    p.ph_lo = 0; p.ph_hi = 8;
    void* args[] = {&p};
    hipError_t e = hipLaunchCooperativeKernel((const void*)fwd_kernel, dim3(grid), dim3(512), args, LDS_BYTES, stream);
    if (e != hipSuccess) fprintf(stderr, "cooperative launch failed: %s (grid %d)\n", hipGetErrorString(e), grid);
#else
    for (int ph = 0; ph < 8; ++ph) { p.ph_lo = ph; p.ph_hi = ph + 1; hipLaunchKernelGGL(fwd_kernel, dim3(grid), dim3(512), LDS_BYTES, stream, p); }
#endif
}
```

```cpp
#include <hip/hip_runtime.h>
#include <hip/hip_cooperative_groups.h>
#include <cstdio>
#include <cstdint>
namespace cg = cooperative_groups;

#ifndef REP_PHASE
#define REP_PHASE -1
#endif
#ifndef ONE_LAUNCH
#define ONE_LAUNCH 1
#endif

typedef unsigned short bf16_t;
typedef short bf16x8 __attribute__((ext_vector_type(8)));
typedef short s16x4 __attribute__((ext_vector_type(4)));
typedef float f32x4 __attribute__((ext_vector_type(4)));
typedef float f32x16 __attribute__((ext_vector_type(16)));
typedef unsigned u32x4 __attribute__((ext_vector_type(4)));
typedef unsigned u32x2 __attribute__((ext_vector_type(2)));

constexpr int DM = 2048, NBATCH = 4, SEQ = 8192, NMETA = 16;
constexpr int VPAD = 48;
constexpr int LB = 8256;
constexpr int M = NBATCH * SEQ;
constexpr int MQ = M + 64;
constexpr int NINC = 10248;
constexpr int N1 = 10240;
constexpr int DFF = 5632, N5 = 2 * DFF;
constexpr int NHD = 48;

constexpr size_t SZ_W1T = (size_t)N1 * DM * 2, SZ_WAT = (size_t)DM * 1024 * 2, SZ_WOT = (size_t)DM * DM * 2, SZ_W5T = (size_t)N5 * DM * 2, SZ_WDT = (size_t)DM * DFF * 2;
constexpr size_t WS_W1T = 0, WS_WAT = WS_W1T + SZ_W1T, WS_WFT = WS_WAT + SZ_WAT, WS_WOT = WS_WFT + SZ_WAT, WS_W5T = WS_WOT + SZ_WOT, WS_WDT = WS_W5T + SZ_W5T;
constexpr size_t WS_RA = WS_WDT + SZ_WDT;
constexpr size_t SZ_RA = (size_t)MQ * DM * 2;
constexpr size_t WS_RB = WS_RA + SZ_RA;
constexpr size_t SZ_RB = (size_t)NHD * MQ * 128 * 2;
constexpr size_t WS_RG = WS_RB + SZ_RB;
constexpr size_t SZ_RG = (size_t)M * 4096 * 2;
constexpr size_t WS_RSTD1 = WS_RG + SZ_RG, WS_SSQ2 = WS_RSTD1 + (size_t)MQ * 4, WS_SSQ3 = WS_SSQ2 + (size_t)M * 4;
constexpr size_t WS_LOGF = WS_SSQ3 + (size_t)M * 4, WS_CUM = WS_LOGF + (size_t)32 * LB * 4;
constexpr size_t WS_SCR = WS_CUM + (size_t)32 * LB * 4;
constexpr size_t WS_KSQ = WS_SCR + (size_t)256 * 262144;
constexpr size_t WS_QCTR = WS_KSQ + (size_t)16 * MQ * 4;
constexpr size_t WS_END = WS_QCTR + 256;
constexpr int LDS_BYTES = 131072;

namespace pg8 {
#define PG8_LAS __attribute__((address_space(3)))
constexpr int BM = 256, BK = 64, HALF = 128, HTB = HALF * BK * 2, STAGE_BYTES = 8 * HTB, NXCD = 8, WGM = 8;
__host__ __device__ __forceinline__ int lds_byte(int r, int c) { const int st = (r >> 4) * 2 + (c >> 5), rr = r & 15, cc = c & 31, ob = rr * 64 + cc * 2; return st * 1024 + (ob ^ (((ob >> 9) & 1) << 5)); }
__host__ __device__ __forceinline__ void stage_rc(int b, int& R, int& C) { const int st = b / 1024, sb = b % 1024, swz = sb ^ (((sb >> 9) & 1) << 5); R = (st >> 1) * 16 + swz / 64; C = (st & 1) * 32 + (swz % 64) / 2; }
__host__ __device__ __forceinline__ int perm32(int rho) { const int n = rho >> 4, i = rho & 15; return 8 * (i >> 2) + 4 * n + (i & 3); }
struct Unit { int pm, pn; };
struct Gemm { const bf16_t* A; const bf16_t* Bt; int M, N, K; };
struct StaticOrder {
    int nM, nN, nwg, G, c;
    __host__ __device__ void init(int M_, int N_, int G_, int c_) { nM = M_ / BM; nN = N_ / BM; nwg = nM * nN; G = G_; c = c_; }
    __host__ __device__ bool next(int i, Unit& u) const {
        const long L = (long)i * G + c; if (L >= nwg) return false;
        int wgid = (int)L; { const int q = nwg / NXCD, r = nwg % NXCD, xcd = wgid % NXCD, off = wgid / NXCD; wgid = (xcd < r ? xcd * (q + 1) : r * (q + 1) + (xcd - r) * q) + off; }
        const int nig = WGM * nN, gid = wgid / nig, fm = gid * WGM, gsz = (nM - fm) < WGM ? (nM - fm) : WGM;
        u.pm = fm + ((wgid % nig) % gsz); u.pn = (wgid % nig) / gsz; return true;
    }
    __device__ __forceinline__ void a_ready(const Unit&) const {}
    __device__ __forceinline__ void done(const Unit&) const {}
};
__device__ __forceinline__ unsigned cvt_pk_bf16(float lo, float hi) { unsigned r; asm volatile("v_cvt_pk_bf16_f32 %0, %1, %2" : "=v"(r) : "v"(lo), "v"(hi)); return r; }

template <class Epi, class Sched>
__device__ __forceinline__ void gemm_phase(PG8_LAS unsigned char* lds, const Gemm g, const Sched& S, const Epi& E, const int tid) {
    const int wid = __builtin_amdgcn_readfirstlane(tid >> 6), lane = tid & 63, wr = wid >> 2, wc = wid & 3, fr = lane & 15, fq = lane >> 4;
    const int K = g.K, nt = K / BK;
    unsigned voffA[2], voffB[2];
#pragma unroll
    for (int i = 0; i < 2; ++i) { int R, C; stage_rc(tid * 16 + i * 8192, R, C); const int Rb = Epi::PERM ? ((R & ~31) + perm32(R & 31)) : R;
        voffA[i] = (unsigned)(R * K + C) * 2u; voffB[i] = (unsigned)(Rb * K + C) * 2u; }
    const size_t kstep = (size_t)(BK * 2);
    const size_t hstep = (size_t)HALF * K * 2;
    const size_t tstep = 2 * hstep;
    const unsigned ldsw = (unsigned)wid * 1024u;
    const int aoff = lds_byte(wr * 64 + fr, fq * 8), boff = lds_byte(wc * 32 + fr, fq * 8);
#define PG8_SA(b, h) (((b) * 2 + (h)) * HTB)
#define PG8_SB(b, h) ((4 + (b) * 2 + (h)) * HTB)
#define PG8_STAGE(bufoff, gbase, voff) do { _Pragma("unroll") for (int _i = 0; _i < 2; ++_i) \
        __builtin_amdgcn_global_load_lds((const unsigned*)((const char*)(gbase) + (voff)[_i]), (PG8_LAS unsigned*)(lds + (bufoff) + ldsw + _i * 8192), 16, 0, 0); } while (0)
#define PG8_LDA(dst, b, h) do { _Pragma("unroll") for (int m = 0; m < 4; ++m) _Pragma("unroll") for (int k = 0; k < 2; ++k) dst[m][k] = *(const PG8_LAS bf16x8*)(lds + PG8_SA(b, h) + aoff + m * 2048 + k * 1024); } while (0)
#define PG8_LDB(dst, b, h) do { _Pragma("unroll") for (int n = 0; n < 2; ++n) _Pragma("unroll") for (int k = 0; k < 2; ++k) dst[n][k] = *(const PG8_LAS bf16x8*)(lds + PG8_SB(b, h) + boff + n * 2048 + k * 1024); } while (0)
#define PG8_MMA(ai, bj, At, Bt) do { __builtin_amdgcn_s_setprio(1); _Pragma("unroll") for (int m = 0; m < 4; ++m) _Pragma("unroll") for (int n = 0; n < 2; ++n) _Pragma("unroll") for (int k = 0; k < 2; ++k) \
        acc[ai][bj][m][n] = __builtin_amdgcn_mfma_f32_16x16x32_bf16(Bt[n][k], At[m][k], acc[ai][bj][m][n], 0, 0, 0); __builtin_amdgcn_s_setprio(0); } while (0)
#define PG8_WAIT_V(n) asm volatile("s_waitcnt vmcnt(" #n ")" ::: "memory")
#define PG8_WAIT_L(n) asm volatile("s_waitcnt lgkmcnt(" #n ")" ::: "memory")
#define PG8_BAR __builtin_amdgcn_s_barrier()
#define PG8_SCHED __builtin_amdgcn_sched_barrier(0)
    Unit cur, nxt; int ui = 0;
    if (!S.next(0, cur)) return;
    f32x4 acc[2][2][4][2];
#pragma unroll
    for (int a = 0; a < 2; ++a)
#pragma unroll
        for (int b = 0; b < 2; ++b)
#pragma unroll
            for (int m = 0; m < 4; ++m)
#pragma unroll
                for (int n = 0; n < 2; ++n) acc[a][b][m][n] = (f32x4){0.f, 0.f, 0.f, 0.f};
    bf16x8 At[4][2], B0[2][2], B1[2][2];
    const char* cA = (const char*)g.A + (size_t)cur.pm * tstep; const char* cB = (const char*)g.Bt + (size_t)cur.pn * tstep;
    S.a_ready(cur);
    PG8_STAGE(PG8_SB(0, 0), cB, voffB); PG8_STAGE(PG8_SA(0, 0), cA, voffA); PG8_STAGE(PG8_SB(0, 1), cB + hstep, voffB); PG8_STAGE(PG8_SA(0, 1), cA + hstep, voffA);
    if (wr == 1) PG8_BAR;
    PG8_WAIT_V(4); PG8_BAR;
    PG8_STAGE(PG8_SB(1, 0), cB + kstep, voffB); PG8_STAGE(PG8_SA(1, 0), cA + kstep, voffA); PG8_STAGE(PG8_SB(1, 1), cB + hstep + kstep, voffB);
    PG8_WAIT_V(6); PG8_BAR;
    for (;;) {
        const bool has_next = S.next(ui + 1, nxt);
        const char* nA = has_next ? (const char*)g.A + (size_t)nxt.pm * tstep : cA; const char* nB = has_next ? (const char*)g.Bt + (size_t)nxt.pn * tstep : cB;
        for (int t = 0; t < nt; t += 2) {
            const bool last = (t == nt - 2);
            const char* a1 = cA + (size_t)(t + 1) * kstep;
            const char* a2 = last ? nA : cA + (size_t)(t + 2) * kstep; const char* b2 = last ? nB : cB + (size_t)(t + 2) * kstep;
            const char* a3 = a2 + kstep; const char* b3 = b2 + kstep;
            if (last && has_next) S.a_ready(nxt);
            PG8_LDB(B0, 0, 0); PG8_SCHED; PG8_LDA(At, 0, 0); PG8_STAGE(PG8_SA(1, 1), a1 + hstep, voffA);
            PG8_WAIT_L(8); PG8_BAR; PG8_WAIT_L(0); PG8_MMA(0, 0, At, B0); PG8_BAR; PG8_SCHED;
            PG8_LDB(B1, 0, 1); PG8_STAGE(PG8_SB(0, 0), b2, voffB);
            PG8_BAR; PG8_WAIT_L(0); PG8_MMA(0, 1, At, B1); PG8_BAR;
            PG8_LDA(At, 0, 1); PG8_STAGE(PG8_SA(0, 0), a2, voffA);
            PG8_BAR; PG8_WAIT_L(0); PG8_MMA(1, 0, At, B0); PG8_BAR; PG8_SCHED;
            PG8_STAGE(PG8_SB(0, 1), b2 + hstep, voffB);
            PG8_WAIT_V(6); PG8_BAR; PG8_MMA(1, 1, At, B1); PG8_BAR;
            PG8_LDB(B0, 1, 0); PG8_SCHED; PG8_LDA(At, 1, 0); PG8_STAGE(PG8_SA(0, 1), a2 + hstep, voffA);
            PG8_WAIT_L(8); PG8_BAR; PG8_WAIT_L(0); PG8_MMA(0, 0, At, B0); PG8_BAR; PG8_SCHED;
            PG8_LDB(B1, 1, 1); PG8_STAGE(PG8_SB(1, 0), b3, voffB);
            PG8_BAR; PG8_WAIT_L(0); PG8_MMA(0, 1, At, B1); PG8_BAR;
            PG8_LDA(At, 1, 1); PG8_STAGE(PG8_SA(1, 0), a3, voffA);
            PG8_BAR; PG8_WAIT_L(0); PG8_MMA(1, 0, At, B0); PG8_BAR; PG8_SCHED;
            PG8_STAGE(PG8_SB(1, 1), b3 + hstep, voffB);
            PG8_WAIT_V(6); PG8_BAR; PG8_MMA(1, 1, At, B1); PG8_BAR;
        }
        E(acc, cur, wr, wc, fr, fq); S.done(cur);
        if (!has_next) break;
#pragma unroll
        for (int a = 0; a < 2; ++a)
#pragma unroll
            for (int b = 0; b < 2; ++b)
#pragma unroll
                for (int m = 0; m < 4; ++m)
#pragma unroll
                    for (int n = 0; n < 2; ++n) acc[a][b][m][n] = (f32x4){0.f, 0.f, 0.f, 0.f};
        cur = nxt; cA = nA; cB = nB; ++ui;
    }
    PG8_WAIT_V(0);
    if (wr == 0) PG8_BAR;
    PG8_BAR;
#undef PG8_SA
#undef PG8_SB
#undef PG8_STAGE
#undef PG8_LDA
#undef PG8_LDB
#undef PG8_MMA
#undef PG8_WAIT_V
#undef PG8_WAIT_L
#undef PG8_BAR
#undef PG8_SCHED
}
}

__device__ __forceinline__ int fresh_lane() { int l; asm volatile("v_mbcnt_lo_u32_b32 %0, -1, 0\n\tv_mbcnt_hi_u32_b32 %0, -1, %0" : "=v"(l)); return l; }
__device__ __forceinline__ float bf2f(unsigned short b) { return __uint_as_float(((unsigned)b) << 16); }
__device__ __forceinline__ float sigmoidf_(float x) { return __builtin_amdgcn_rcpf(1.0f + __builtin_amdgcn_exp2f(-1.4426950408889634f * x)); }
__device__ __forceinline__ u32x4 pack8u(f32x4 a, f32x4 b) { u32x4 w = {pg8::cvt_pk_bf16(a[0], a[1]), pg8::cvt_pk_bf16(a[2], a[3]), pg8::cvt_pk_bf16(b[0], b[1]), pg8::cvt_pk_bf16(b[2], b[3])}; return w; }
__device__ __forceinline__ void unpack8(u32x4 w, f32x4& a, f32x4& b) {
    a = (f32x4){__uint_as_float(w.x << 16), __uint_as_float(w.x & 0xffff0000u), __uint_as_float(w.y << 16), __uint_as_float(w.y & 0xffff0000u)};
    b = (f32x4){__uint_as_float(w.z << 16), __uint_as_float(w.z & 0xffff0000u), __uint_as_float(w.w << 16), __uint_as_float(w.w & 0xffff0000u)};
}
__device__ __forceinline__ float wave_sum(float v) {
#pragma unroll
    for (int o = 32; o >= 1; o >>= 1) v += __shfl_xor(v, o);
    return v;
}

typedef f32x4 Acc[2][2][4][2];
struct Epi1 { static constexpr bool PERM = true;
    bf16_t* QKV; bf16_t* GATES; const float* rstd; float* KSQ;
    __device__ __forceinline__ void operator()(const Acc& acc, const pg8::Unit& u, int wr, int wc, int fr, int fq) const {
        const int row0 = u.pm * 256 + wr * 64 + fr;
        if (u.pn < 24) {
            const bool iskh = (u.pn >= 4 && u.pn < 8) || (u.pn >= 16 && u.pn < 20);
            const int ks0 = u.pn < 8 ? 2 * u.pn - 8 : 2 * u.pn - 32 + 8;
#pragma unroll
            for (int ai = 0; ai < 2; ++ai)
#pragma unroll
                for (int m = 0; m < 4; ++m) { const int row = row0 + ai * 128 + m * 16; const float rs = rstd[row];
#pragma unroll
                    for (int bj = 0; bj < 2; ++bj) { bf16_t* dst = QKV + ((size_t)(2 * u.pn + bj) * MQ + row) * 128 + wc * 32 + 8 * fq;
                        const f32x4 v0 = acc[ai][bj][m][0] * rs, v1 = acc[ai][bj][m][1] * rs;
                        *(u32x4*)dst = pack8u(v0, v1);
                        if (iskh) { float ss = (v0[0] * v0[0] + v0[1] * v0[1]) + (v0[2] * v0[2] + v0[3] * v0[3]) + (v1[0] * v1[0] + v1[1] * v1[1]) + (v1[2] * v1[2] + v1[3] * v1[3]);
                            ss += __shfl_xor(ss, 16); ss += __shfl_xor(ss, 32);
                            if (fq == 0) unsafeAtomicAdd(KSQ + (size_t)(ks0 + bj) * MQ + row, ss); } } }
        } else {
            const int colb = (u.pn - 24) * 256 + wc * 32 + 8 * fq;
#pragma unroll
            for (int ai = 0; ai < 2; ++ai)
#pragma unroll
                for (int m = 0; m < 4; ++m) { const int row = row0 + ai * 128 + m * 16; const float rs = rstd[row];
#pragma unroll
                    for (int bj = 0; bj < 2; ++bj) { f32x4 v0 = acc[ai][bj][m][0] * rs, v1 = acc[ai][bj][m][1] * rs;
#pragma unroll
                        for (int j = 0; j < 4; ++j) { v0[j] = sigmoidf_(v0[j]); v1[j] = sigmoidf_(v1[j]); }
                        *(u32x4*)(GATES + (size_t)row * 4096 + colb + bj * 128) = pack8u(v0, v1); } }
        }
    }
};
struct Epi3a { static constexpr bool PERM = true;
    float* TMP; const bf16_t* GATES;
    __device__ __forceinline__ void operator()(const Acc& acc, const pg8::Unit& u, int wr, int wc, int fr, int fq) const {
        const int row0 = u.pm * 256 + wr * 64 + fr, col0 = u.pn * 256 + wc * 32 + 8 * fq;
#pragma unroll
        for (int ai = 0; ai < 2; ++ai)
#pragma unroll
            for (int m = 0; m < 4; ++m) { const int row = row0 + ai * 128 + m * 16;
#pragma unroll
                for (int bj = 0; bj < 2; ++bj) { const int col = col0 + bj * 128; f32x4 g0, g1; unpack8(*(const u32x4*)(GATES + (size_t)row * 4096 + col), g0, g1);
                    float* d = TMP + (size_t)row * DM + col; *(f32x4*)d = acc[ai][bj][m][0] * g0; *(f32x4*)(d + 4) = acc[ai][bj][m][1] * g1; } }
    }
};
struct Epi3b { static constexpr bool PERM = true;
    const float* TMP; const bf16_t* GATES; bf16_t* MERGED;
    __device__ __forceinline__ void operator()(const Acc& acc, const pg8::Unit& u, int wr, int wc, int fr, int fq) const {
        const int row0 = u.pm * 256 + wr * 64 + fr, col0 = u.pn * 256 + wc * 32 + 8 * fq;
#pragma unroll
        for (int ai = 0; ai < 2; ++ai)
#pragma unroll
            for (int m = 0; m < 4; ++m) { const int row = row0 + ai * 128 + m * 16;
#pragma unroll
                for (int bj = 0; bj < 2; ++bj) { const int col = col0 + bj * 128; f32x4 g0, g1; unpack8(*(const u32x4*)(GATES + (size_t)row * 4096 + 2048 + col), g0, g1);
                    const float* s = TMP + (size_t)row * DM + col; const f32x4 t0 = *(const f32x4*)s, t1 = *(const f32x4*)(s + 4);
                    *(u32x4*)(MERGED + (size_t)row * DM + col) = pack8u(t0 + acc[ai][bj][m][0] * g0, t1 + acc[ai][bj][m][1] * g1); } }
    }
};
struct Epi4 { static constexpr bool PERM = true;
    const float* x; float* out; bf16_t* H1B; float* ssq;
    __device__ __forceinline__ void operator()(const Acc& acc, const pg8::Unit& u, int wr, int wc, int fr, int fq) const {
        const int row0 = u.pm * 256 + wr * 64 + fr, col0 = u.pn * 256 + wc * 32 + 8 * fq;
#pragma unroll
        for (int ai = 0; ai < 2; ++ai)
#pragma unroll
            for (int m = 0; m < 4; ++m) { const int row = row0 + ai * 128 + m * 16; const size_t orow = (size_t)row; float ss = 0.f;
#pragma unroll
                    for (int bj = 0; bj < 2; ++bj) { const int col = col0 + bj * 128; const float* xs = x + orow * DM + col;
                        const f32x4 h0 = *(const f32x4*)xs + acc[ai][bj][m][0], h1 = *(const f32x4*)(xs + 4) + acc[ai][bj][m][1];
                        float* d = out + orow * DM + col; *(f32x4*)d = h0; *(f32x4*)(d + 4) = h1;
                        *(u32x4*)(H1B + (size_t)row * DM + col) = pack8u(h0, h1);
                        ss += (h0[0] * h0[0] + h0[1] * h0[1]) + (h0[2] * h0[2] + h0[3] * h0[3]) + (h1[0] * h1[0] + h1[1] * h1[1]) + (h1[2] * h1[2] + h1[3] * h1[3]); }
                    ss += __shfl_xor(ss, 16); ss += __shfl_xor(ss, 32);
                    if (fq == 0) unsafeAtomicAdd(ssq + row, ss); }
    }
};
struct Epi5 { static constexpr bool PERM = true;
    const float* ssq; bf16_t* ACT;
    __device__ __forceinline__ void operator()(const Acc& acc, const pg8::Unit& u, int wr, int wc, int fr, int fq) const {
        const int row0 = u.pm * 256 + wr * 64 + fr, col0 = u.pn * 128 + wc * 32 + 8 * fq;
#pragma unroll
        for (int ai = 0; ai < 2; ++ai)
#pragma unroll
            for (int m = 0; m < 4; ++m) { const int row = row0 + ai * 128 + m * 16; const float rs = __builtin_amdgcn_rsqf(ssq[row] * (1.0f / 2048.0f) + 1e-6f);
                f32x4 o[2];
#pragma unroll
                for (int n = 0; n < 2; ++n) { const f32x4 g = acc[ai][0][m][n] * rs, up = acc[ai][1][m][n] * rs;
#pragma unroll
                    for (int j = 0; j < 4; ++j) o[n][j] = g[j] * sigmoidf_(g[j]) * up[j]; }
                *(u32x4*)(ACT + (size_t)row * DFF + col0) = pack8u(o[0], o[1]); }
    }
};
struct Epi6 { static constexpr bool PERM = true;
    float* out; float* ssq;
    __device__ __forceinline__ void operator()(const Acc& acc, const pg8::Unit& u, int wr, int wc, int fr, int fq) const {
        const int row0 = u.pm * 256 + wr * 64 + fr, col0 = u.pn * 256 + wc * 32 + 8 * fq;
#pragma unroll
        for (int ai = 0; ai < 2; ++ai)
#pragma unroll
            for (int m = 0; m < 4; ++m) { const int row = row0 + ai * 128 + m * 16; const size_t orow = (size_t)row; float ss = 0.f;
#pragma unroll
                    for (int bj = 0; bj < 2; ++bj) { const int col = col0 + bj * 128; float* d = out + orow * DM + col;
                        const f32x4 h0 = *(const f32x4*)d + acc[ai][bj][m][0], h1 = *(const f32x4*)(d + 4) + acc[ai][bj][m][1];
                        *(f32x4*)d = h0; *(f32x4*)(d + 4) = h1;
                        ss += (h0[0] * h0[0] + h0[1] * h0[1]) + (h0[2] * h0[2] + h0[3] * h0[3]) + (h1[0] * h1[0] + h1[1] * h1[1]) + (h1[2] * h1[2] + h1[3] * h1[3]); }
                    ss += __shfl_xor(ss, 16); ss += __shfl_xor(ss, 32);
                    if (fq == 0) unsafeAtomicAdd(ssq + row, ss); }
    }
};

namespace att {
constexpr int D = 128, NW = 8, QBLK = 32, KVBLK = 64, QB = 256;
constexpr int SHM_V = KVBLK * D * 2, SHM_K = KVBLK * D * 2;
constexpr int LDS_WS = 2 * SHM_V + 2 * SHM_K;
constexpr int LDS_TAB = LDS_WS + NW * 64 * 4;
constexpr float SCALE = 0.08838834764831845f;
constexpr float THR = 8.f;
#define KSWZ(row, colB) ((row) * 256 + ((colB) ^ (((row) & 7) << 4)))
#define SBAR() __builtin_amdgcn_sched_barrier(0)
__device__ __forceinline__ int v_st(int k, int c) { const int kk = (k & ~0xC) | ((k & 4) << 1) | ((k & 8) >> 1); return ((kk >> 3) * 4 + (c >> 5)) * 512 + ((kk & 7) * 32 + (c & 31)) * 2; }
__device__ __forceinline__ int v_rd_base(int lane) { return ((lane & 3) << 3) | (((lane >> 2) & 3) << 6) | (((lane >> 4) & 1) << 5) | (((lane >> 5) & 1) << 8); }
constexpr int v_rd_off(int d0, int ks, int half) { return d0 * 512 + ks * 4096 + half * 2048; }
__device__ __forceinline__ int crow(int r, int hi) { return (r & 3) + 8 * (r >> 2) + 4 * hi; }
__device__ __forceinline__ unsigned cvtpk(float lo, float hi) { unsigned r; asm volatile("v_cvt_pk_bf16_f32 %0, %1, %2" : "=v"(r) : "v"(lo), "v"(hi)); return r; }
__device__ __forceinline__ bf16x8 load8(const bf16_t* p) { return *reinterpret_cast<const bf16x8*>(p); }
__device__ __forceinline__ void mask_tile(f32x16& p0, f32x16& p1, int dqe, int dqt, unsigned W, float s2) {
    const float NEG = -__builtin_inff();
#pragma unroll
    for (int r = 0; r < 16; ++r) {
        const int c = (r & 3) + 8 * (r >> 2);
        const int a0 = c - dqt, a1 = c + 32 - dqt;
        p0[r] -= s2 * (float)(a0 > 0 ? a0 : 0);
        p1[r] -= s2 * (float)(a1 > 0 ? a1 : 0);
        if ((unsigned)(dqe - c) >= W) p0[r] = NEG;
        if ((unsigned)(dqe - c - 32) >= W) p1[r] = NEG;
    }
}
__device__ __forceinline__ void partialSM(f32x16& p0, f32x16& p1, float& m_reg, float& mn, float& alpha, bool& skip) {
    float pmax = p0[0]; for (int r = 1; r < 16; ++r) pmax = fmaxf(pmax, p0[r]); for (int r = 0; r < 16; ++r) pmax = fmaxf(pmax, p1[r]);
    { auto rr = __builtin_amdgcn_permlane32_swap(__float_as_uint(pmax), __float_as_uint(pmax), false, false);
      pmax = fmaxf(__uint_as_float(rr[0]), __uint_as_float(rr[1])); }
    constexpr float C2 = 1.4426950408889634f * SCALE;
    skip = __all((pmax - m_reg) * C2 < -150.f);
    if (skip) { mn = m_reg; alpha = 1.f; return; }
    if (__builtin_expect(__all((pmax - m_reg) * SCALE <= THR), 1)) { mn = m_reg; alpha = 1.f; }
    else { mn = fmaxf(m_reg, pmax); alpha = __builtin_amdgcn_exp2f((m_reg - mn) * C2); m_reg = mn; }
    const float mnL = -mn * C2;
    for (int r = 0; r < 16; ++r) p0[r] = fmaf(p0[r], C2, mnL); for (int r = 0; r < 16; ++r) p1[r] = fmaf(p1[r], C2, mnL);
    for (int r = 0; r < 16; ++r) p0[r] = __builtin_amdgcn_exp2f(p0[r]);
}
__device__ __forceinline__ void finishSM(f32x16& p0, f32x16& p1, float alpha, float& l_reg, bf16x8& pa0, bf16x8& pa1, bf16x8& pa2, bf16x8& pa3) {
    for (int r = 0; r < 16; ++r) p1[r] = __builtin_amdgcn_exp2f(p1[r]);
    float ps = 0; for (int r = 0; r < 16; ++r) ps += p0[r]; for (int r = 0; r < 16; ++r) ps += p1[r];
    { auto rr = __builtin_amdgcn_permlane32_swap(__float_as_uint(ps), __float_as_uint(ps), false, false);
      ps = __uint_as_float(rr[0]) + __uint_as_float(rr[1]); }
    l_reg = l_reg * alpha + ps;
#define PK4(P, B_, OUT) do { unsigned a0 = cvtpk(P[B_+0], P[B_+1]), a1 = cvtpk(P[B_+2], P[B_+3]);                          \
        unsigned b0 = cvtpk(P[B_+4], P[B_+5]), b1 = cvtpk(P[B_+6], P[B_+7]);                                             \
        auto r0 = __builtin_amdgcn_permlane32_swap(a0, b0, false, false); auto r1 = __builtin_amdgcn_permlane32_swap(a1, b1, false, false); \
        u32x4 w = {r0[0], r1[0], r0[1], r1[1]}; OUT = *reinterpret_cast<bf16x8*>(&w); } while (0)
    PK4(p0, 0, pa0); PK4(p0, 8, pa1); PK4(p1, 0, pa2); PK4(p1, 8, pa3);
#undef PK4
}
template <int KB>
__device__ __forceinline__ void qkt(f32x16& p0, f32x16& p1, const char* K_lds, int r32, int hi, const bf16x8* qr) {
    p0 = f32x16{}; p1 = f32x16{};
    const char* kb[4];
#pragma unroll
    for (int dd = 0; dd < 4; ++dd) kb[dd] = K_lds + KB * SHM_K + KSWZ(r32, (dd * 16 + hi * 8) * 2);
#pragma unroll
    for (int d0 = 0; d0 < 8; ++d0) { const char* a = kb[d0 & 3] + (d0 >> 2) * 128;
        bf16x8 b0 = *reinterpret_cast<const bf16x8*>(a);
        bf16x8 b1 = *reinterpret_cast<const bf16x8*>(a + 32 * 256);
        p0 = __builtin_amdgcn_mfma_f32_32x32x16_bf16(b0, qr[d0], p0, 0, 0, 0);
        p1 = __builtin_amdgcn_mfma_f32_32x32x16_bf16(b1, qr[d0], p1, 0, 0, 0); }
}
template <int VB>
__device__ __forceinline__ void pv_tile(f32x16* o, int vb0, bf16x8 pa0, bf16x8 pa1, bf16x8 pa2, bf16x8 pa3) {
#define TRRD(dst, off) asm volatile("ds_read_b64_tr_b16 %0, %1 offset:%2" : "=&v"(dst) : "v"(vb0), "i"(off) : "memory")
#define PV_D0(d0) do { s16x4 l0, l1, l2, l3, h0, h1, h2, h3; constexpr int b_ = VB * SHM_V + v_rd_off(d0, 0, 0); \
        TRRD(l0, b_); TRRD(h0, b_ + 2048); TRRD(l1, b_ + 4096); TRRD(h1, b_ + 6144); TRRD(l2, b_ + 8192); TRRD(h2, b_ + 10240); TRRD(l3, b_ + 12288); TRRD(h3, b_ + 14336); \
        asm volatile("s_waitcnt lgkmcnt(0)" ::: "memory"); SBAR();   \
        o[d0] = __builtin_amdgcn_mfma_f32_32x32x16_bf16(pa0, (bf16x8){l0[0], l0[1], l0[2], l0[3], h0[0], h0[1], h0[2], h0[3]}, o[d0], 0, 0, 0);   \
        o[d0] = __builtin_amdgcn_mfma_f32_32x32x16_bf16(pa1, (bf16x8){l1[0], l1[1], l1[2], l1[3], h1[0], h1[1], h1[2], h1[3]}, o[d0], 0, 0, 0);   \
        o[d0] = __builtin_amdgcn_mfma_f32_32x32x16_bf16(pa2, (bf16x8){l2[0], l2[1], l2[2], l2[3], h2[0], h2[1], h2[2], h2[3]}, o[d0], 0, 0, 0);   \
        o[d0] = __builtin_amdgcn_mfma_f32_32x32x16_bf16(pa3, (bf16x8){l3[0], l3[1], l3[2], l3[3], h3[0], h3[1], h3[2], h3[3]}, o[d0], 0, 0, 0); } while (0)
    PV_D0(0); PV_D0(1); PV_D0(2); PV_D0(3);
#undef PV_D0
#undef TRRD
}
struct Blk { const bf16_t* Q; const bf16_t* K; const bf16_t* V; const bf16_t* K0; const bf16_t* V0; bf16_t* O; int P0; int mode; float s2; };
struct Seam { bf16x8 qr[8]; bf16x8 st_v0, st_v1, st_k0, st_k1; };
#define ROW(p, k0, rr) ((p) + (size_t)((k0) + (rr)) * D + sc)
#define VMW() asm volatile("s_waitcnt vmcnt(0)" ::: "memory")
#define VMWN(n) asm volatile("s_waitcnt vmcnt(%0)" :: "i"(n) : "memory")
#define SLOAD_H(Kp, Vp, k0) do { S.st_v0 = load8(ROW(Vp, k0, sr)); S.st_v1 = load8(ROW(Vp, k0, 32 + sr));              \
                         S.st_k0 = load8(ROW(Kp, k0, sr)); S.st_k1 = load8(ROW(Kp, k0, 32 + sr)); } while (0)
#define SWRITE_HK(bf) do { *(bf16x8*)(K_lds + (bf) * SHM_K + kws) = S.st_k0; *(bf16x8*)(K_lds + (bf) * SHM_K + kws + 32 * 256) = S.st_k1; } while (0)
#define SWRITE_HV(bf) do { *(bf16x8*)(V_lds + (bf) * SHM_V + vst0) = S.st_v0; *(bf16x8*)(V_lds + (bf) * SHM_V + vst1) = S.st_v1; } while (0)
#define SWRITE_H(bf) do { SWRITE_HV(bf); SWRITE_HK(bf); } while (0)
__device__ __forceinline__ void attn_prime(const Blk& cur, char* lds, Seam& S, const int tid) {
    const int wid = __builtin_amdgcn_readfirstlane(tid >> 6), lane = tid & 63, r32 = lane & 31, hi = lane >> 5;
    for (int d0 = 0; d0 < 8; ++d0) S.qr[d0] = load8(cur.Q + (size_t)(wid * QBLK + r32) * D + d0 * 16 + hi * 8);
}
__device__ __forceinline__ void attn_block(const Blk& cur, const bf16_t* nxtQ, char* lds, Seam& S, float lam, float* scrT, float* scrD, const float* g_subln, const int tid, const int j_lo) {
    const int wid = __builtin_amdgcn_readfirstlane(tid >> 6), lane = tid & 63, r32 = lane & 31, hi = lane >> 5;
    const int NT = (cur.P0 + QB - 1) / KVBLK + 1 - j_lo;
    const int qlo = cur.P0 + wid * QBLK;
    const int qt4 = qlo + r32 - 4 * hi;
    const bool isdiff = cur.mode != 0;
    char* V_lds = lds; char* K_lds = lds + 2 * SHM_V;
    float* ws = (float*)(lds + LDS_WS) + wid * 64; float* li_l = ws, * al_l = ws + 32;
    float m_reg = ((const float*)(lds + LDS_TAB))[qlo + r32] - 226.27417f, l_reg = 0; f32x16 o[4] = {};
    const int sr = tid >> 4, sc = (tid & 15) * 8, vst0 = v_st(sr, sc), vst1 = v_st(32 + sr, sc), kws = KSWZ(sr, sc * 2);
    const int vb0 = (int)(uintptr_t)V_lds + v_rd_base(lane);
    const bf16_t* Kh = cur.K; const bf16_t* Vh = cur.V;
#define RESC(a) do { if (__any((a) < 1.f)) { if (hi == 0) al_l[r32] = (a); asm volatile("s_waitcnt lgkmcnt(0)" ::: "memory");              \
                     for (int d_ = 0; d_ < 4; ++d_) for (int r = 0; r < 16; ++r) o[d_][r] *= al_l[crow(r, hi)]; } } while (0)
#define KBASE(t) ((j_lo + (t)) * KVBLK)
#define BIAS(P0_, P1_, t) do { int h_ = hi; asm volatile("" : "+v"(h_)); const float* tb_ = (const float*)(lds + LDS_TAB) + (4 * h_ + KBASE(t));         \
        _Pragma("unroll") for (int i_ = 0; i_ < 4; ++i_) { const f32x4 b0_ = *(const f32x4*)(tb_ + 8 * i_), b1_ = *(const f32x4*)(tb_ + 32 + 8 * i_); \
            _Pragma("unroll") for (int j_ = 0; j_ < 4; ++j_) { P0_[4 * i_ + j_] += b0_[j_]; P1_[4 * i_ + j_] += b1_[j_]; } } } while (0)
#define MASKT(P0_, P1_, t) do { const int kb_ = KBASE(t); BIAS(P0_, P1_, t); if (kb_ + KVBLK - 1 > qlo || kb_ == 0) { int q_ = qt4; asm volatile("" : "+v"(q_)); const int qt_ = q_ + 4 * hi, qe_ = isdiff ? (qt_ | 63) : qt_;      \
            mask_tile(P0_, P1_, qe_ - kb_ - 4 * hi, q_ - kb_, (unsigned)(qe_ - 47), cur.s2); } } while (0)
#define SEAM_K0() do { VMWN(8); SWRITE_HK(0); SBAR(); } while (0)
    f32x16 pA0, pA1, pB0, pB1; float mnA, mnB, alA, alB; bf16x8 pa0, pa1, pa2, pa3; bool skA, skB;
    { const bf16_t* kp = j_lo == 0 ? cur.K0 : Kh + (size_t)j_lo * KVBLK * D; const bf16_t* vp = j_lo == 0 ? cur.V0 : Vh + (size_t)j_lo * KVBLK * D;
      SLOAD_H(kp, vp, 0); VMW(); SWRITE_H(0); SBAR(); }
    if (NT > 1) { SLOAD_H(Kh, Vh, KBASE(1)); }
    __syncthreads();
    SBAR(); qkt<0>(pA0, pA1, K_lds, r32, hi, S.qr);
    MASKT(pA0, pA1, 0); partialSM(pA0, pA1, m_reg, mnA, alA, skA);
    if (NT > 1) { VMW(); SWRITE_H(1); }
    __syncthreads();
#define HALF_STEP(PX0, PX1, mnX, alX, skX, PY0, PY1, alY, skY, t, KB, VB, SB_) do {                                                      \
        SBAR(); qkt<KB>(PX0, PX1, K_lds, r32, hi, S.qr);                                             \
        if (!(skY)) finishSM(PY0, PY1, alY, l_reg, pa0, pa1, pa2, pa3); SBAR();                                               \
        if ((t) + 1 < NT) { SLOAD_H(Kh, Vh, KBASE((t) + 1)); SBAR(); }                                               \
        if (!(skY)) pv_tile<VB>(o, vb0, pa0, pa1, pa2, pa3); MASKT(PX0, PX1, (t)); partialSM(PX0, PX1, m_reg, mnX, alX, skX);                                        \
        __syncthreads();                                                                                                      \
        if ((t) + 1 < NT) { VMW(); SWRITE_H(SB_); }                                                                          \
        RESC(alX); __syncthreads(); } while (0)
    for (int t = 1; t + 1 < NT; t += 2) {
        HALF_STEP(pB0, pB1, mnB, alB, skB, pA0, pA1, alA, skA, t, 1, 0, 0);
        HALF_STEP(pA0, pA1, mnA, alA, skA, pB0, pB1, alB, skB, t + 1, 0, 1, 1);
    }
    const bool even = (NT & 1) == 0;
    if (even) { SBAR(); qkt<1>(pB0, pB1, K_lds, r32, hi, S.qr); SBAR(); }
    { int t2 = tid; asm volatile("" : "+v"(t2));
      const int l2 = t2 & 63;
      const unsigned qoff = (unsigned)((wid * QBLK + (l2 & 31)) * D + (l2 >> 5) * 8);
#pragma unroll
      for (int d0 = 0; d0 < 8; ++d0) S.qr[d0] = load8(nxtQ + qoff + d0 * 16); }
    SBAR();
    if (!skA) finishSM(pA0, pA1, alA, l_reg, pa0, pa1, pa2, pa3); SBAR();
    if (!skA) pv_tile<0>(o, vb0, pa0, pa1, pa2, pa3);
    if (even) { MASKT(pB0, pB1, NT - 1); partialSM(pB0, pB1, m_reg, mnB, alB, skB); __syncthreads(); RESC(alB);
        if (!skB) { finishSM(pB0, pB1, alB, l_reg, pa0, pa1, pa2, pa3); SBAR(); pv_tile<1>(o, vb0, pa0, pa1, pa2, pa3); } }
    SBAR();
    int ln = lane; asm volatile("" : "+v"(ln));
    const int r32e = ln & 31;
    if (hi == 0) li_l[r32] = l_reg; asm volatile("s_waitcnt lgkmcnt(0)" ::: "memory");
    float rli[16];
#pragma unroll
    for (int r = 0; r < 16; ++r) rli[r] = __builtin_amdgcn_rcpf(li_l[crow(r, hi)]);
    const int mode = cur.mode;
    if (mode == 0) {
        bf16_t* Ow = cur.O + (size_t)(wid * QBLK) * 1024;
#pragma unroll
        for (int r = 0; r < 16; ++r) { const int orow = crow(r, hi);
#pragma unroll
            for (int d0 = 0; d0 < 4; ++d0) { const float v = o[d0][r] * rli[r]; const float vn = __shfl_xor(v, 1);
                if ((r32e & 1) == 0) *(unsigned*)(Ow + (orow * 1024 + d0 * 32 + r32e)) = cvtpk(v, vn); } }
    } else if (mode == 1) {
        float* T = scrT + (wid * 4096 + ln);
#pragma unroll
        for (int r = 0; r < 16; ++r)
#pragma unroll
            for (int d0 = 0; d0 < 4; ++d0) T[(r * 4 + d0) * 64] = o[d0][r] * rli[r];
    } else {
        const float* T = scrT + (wid * 4096 + ln); float* Dl = scrD + (wid * 4096 + ln);
#pragma unroll
        for (int r = 0; r < 16; ++r)
#pragma unroll
            for (int d0 = 0; d0 < 4; ++d0) o[d0][r] = __hip_atomic_load(T + (r * 4 + d0) * 64, __ATOMIC_RELAXED, __HIP_MEMORY_SCOPE_AGENT) - lam * (o[d0][r] * rli[r]);
        if (mode == 2) {
#pragma unroll
            for (int r = 0; r < 16; ++r)
#pragma unroll
                for (int d0 = 0; d0 < 4; ++d0) Dl[(r * 4 + d0) * 64] = o[d0][r];
        } else {
            bf16_t* Ow = cur.O + (size_t)(wid * QBLK) * 1024;
            float gs0[4], gs1[4];
#pragma unroll
            for (int d0 = 0; d0 < 4; ++d0) { gs0[d0] = g_subln[d0 * 32 + r32e] * 0.8f; gs1[d0] = g_subln[128 + d0 * 32 + r32e] * 0.8f; }
#pragma unroll
            for (int r = 0; r < 16; ++r) { const int orow = crow(r, hi);
                float e0[4]; float ss = 0.f;
#pragma unroll
                for (int d0 = 0; d0 < 4; ++d0) { e0[d0] = __hip_atomic_load(Dl + (r * 4 + d0) * 64, __ATOMIC_RELAXED, __HIP_MEMORY_SCOPE_AGENT); ss += e0[d0] * e0[d0] + o[d0][r] * o[d0][r]; }
                ss += __shfl_xor(ss, 1); ss += __shfl_xor(ss, 2); ss += __shfl_xor(ss, 4); ss += __shfl_xor(ss, 8); ss += __shfl_xor(ss, 16);
                const float rn = __builtin_amdgcn_rsqf(ss * (1.0f / 256.0f) + 1e-5f);
#pragma unroll
                for (int d0 = 0; d0 < 4; ++d0) { const float v0 = e0[d0] * rn * gs0[d0], v1 = o[d0][r] * rn * gs1[d0]; const float v0n = __shfl_xor(v0, 1), v1n = __shfl_xor(v1, 1);
                    if ((r32e & 1) == 0) { *(unsigned*)(Ow + (orow * 1024 + d0 * 32 + r32e)) = cvtpk(v0, v0n); *(unsigned*)(Ow + (orow * 1024 + 128 + d0 * 32 + r32e)) = cvtpk(v1, v1n); } }
                asm volatile("" ::: "memory"); }
        }
    }
    __syncthreads();
#undef RESC
#undef KBASE
#undef BIAS
#undef MASKT
#undef SEAM_K0
#undef HALF_STEP
}
#undef ROW
#undef VMW
#undef VMWN
#undef SLOAD_H
#undef SWRITE_HK
#undef SWRITE_HV
#undef SWRITE_H
}

struct Params { const float* in[18]; float* out; unsigned char* ws; int ph_lo, ph_hi; };

__device__ __forceinline__ void transpose_job(const float* __restrict__ src, int ld, int col0, int nN, int Kdim, bf16_t* __restrict__ dst, int up, const float* __restrict__ scale, float* tile, const int tid) {
    const int nK = Kdim / 64, total = nK * nN;
    f32x4 v[2];
    int t = blockIdx.x;
    if (t < total) { const int k0 = (t / nN) * 64, n0 = (t % nN) * 64;
#pragma unroll
        for (int i = 0; i < 2; ++i) { const int idx = tid + 512 * i, kk = idx >> 4, c4 = idx & 15; v[i] = *(const f32x4*)(src + (size_t)(k0 + kk) * ld + col0 + n0 + c4 * 4) * (scale ? scale[k0 + kk] : 1.0f); } }
    for (; t < total; t += gridDim.x) {
        const int k0 = (t / nN) * 64, n0 = (t % nN) * 64;
#pragma unroll
        for (int i = 0; i < 2; ++i) { const int idx = tid + 512 * i, kk = idx >> 4, c4 = idx & 15;
#pragma unroll
            for (int j = 0; j < 4; ++j) tile[kk * 65 + c4 * 4 + j] = v[i][j]; }
        const int tn = t + gridDim.x;
        if (tn < total) { const int k1 = (tn / nN) * 64, n1 = (tn % nN) * 64;
#pragma unroll
            for (int i = 0; i < 2; ++i) { const int idx = tid + 512 * i, kk = idx >> 4, c4 = idx & 15; v[i] = *(const f32x4*)(src + (size_t)(k1 + kk) * ld + col0 + n1 + c4 * 4) * (scale ? scale[k1 + kk] : 1.0f); } }
        __syncthreads();
        { const int n = tid >> 3, kc = (tid & 7) * 8; f32x4 a, b;
#pragma unroll
            for (int j = 0; j < 4; ++j) { a[j] = tile[(kc + j) * 65 + n]; b[j] = tile[(kc + 4 + j) * 65 + n]; }
            const int drow = (up < 0) ? (n0 + n) : (256 * (n0 >> 7) + (n0 & 127) + up * 128 + n);
            *(u32x4*)(dst + (size_t)drow * Kdim + k0 + kc) = pack8u(a, b); }
        __syncthreads();
    }
}

__global__ void __launch_bounds__(512, 2) fwd_kernel(Params p) {
    extern __shared__ __attribute__((aligned(16))) unsigned char lds[];
    cg::grid_group grid = cg::this_grid();
    const int wid = __builtin_amdgcn_readfirstlane(threadIdx.x >> 6), G = gridDim.x, bx = blockIdx.x;
    unsigned char* ws = p.ws;
    bf16_t* W1T = (bf16_t*)(ws + WS_W1T); bf16_t* WAT = (bf16_t*)(ws + WS_WAT); bf16_t* WFT = (bf16_t*)(ws + WS_WFT); bf16_t* WOT = (bf16_t*)(ws + WS_WOT);
    bf16_t* W5T = (bf16_t*)(ws + WS_W5T); bf16_t* WDT = (bf16_t*)(ws + WS_WDT);
    bf16_t* XB = (bf16_t*)(ws + WS_RA); bf16_t* OA = (bf16_t*)(ws + WS_RA); bf16_t* OF = (bf16_t*)(ws + WS_RA + (size_t)M * 1024 * 2); bf16_t* H1B = (bf16_t*)(ws + WS_RA);
    bf16_t* QKV = (bf16_t*)(ws + WS_RB); float* TMP = (float*)(ws + WS_RB); bf16_t* MERGED = (bf16_t*)(ws + WS_RB + (size_t)M * DM * 4); bf16_t* ACT = (bf16_t*)(ws + WS_RB);
    bf16_t* GATES = (bf16_t*)(ws + WS_RG);
    float* RSTD1 = (float*)(ws + WS_RSTD1); float* SSQ2 = (float*)(ws + WS_SSQ2); float* SSQ3 = (float*)(ws + WS_SSQ3);
    float* LOGF = (float*)(ws + WS_LOGF); float* CUM = (float*)(ws + WS_CUM); float* KSQ = (float*)(ws + WS_KSQ);
    const int lo = p.ph_lo, hi_ = p.ph_hi;
#define IN(k) (lo <= (k) && (k) < hi_)
#define SEAM(k) do { if (IN(k) && IN((k) + 1)) grid.sync(); } while (0)

    for (int rep_ = 0; rep_ < (REP_PHASE == 0 ? 2 : 1); ++rep_) if (IN(0)) {
        if (rep_) grid.sync();
        const int lane = fresh_lane(), tid = wid * 64 + lane;
        float* tile = (float*)lds;
        const float* w_in = p.in[3];
        transpose_job(w_in, NINC, 0, 96, DM, W1T, -1, p.in[2], tile, tid);
        transpose_job(w_in, NINC, 6152, 64, DM, W1T + (size_t)6144 * DM, -1, p.in[2], tile, tid);
        transpose_job(p.in[10], DM, 0, 32, 1024, WAT, -1, nullptr, tile, tid);
        transpose_job(p.in[11], DM, 0, 32, 1024, WFT, -1, nullptr, tile, tid);
        transpose_job(p.in[12], DM, 0, 32, DM, WOT, -1, nullptr, tile, tid);
        transpose_job(p.in[14], DFF, 0, 88, DM, W5T, 0, p.in[13], tile, tid);
        transpose_job(p.in[15], DFF, 0, 88, DM, W5T, 1, p.in[13], tile, tid);
        transpose_job(p.in[16], DM, 0, 32, DFF, WDT, -1, nullptr, tile, tid);
        float* WF = (float*)lds;
        for (int k = tid; k < DM; k += 512) { const float g = p.in[2][k]; const f32x4 a = *(const f32x4*)(w_in + (size_t)k * NINC + 6144), b = *(const f32x4*)(w_in + (size_t)k * NINC + 6148);
#pragma unroll
            for (int j = 0; j < 4; ++j) { WF[j * DM + k] = a[j] * g; WF[(4 + j) * DM + k] = b[j] * g; } }
        __syncthreads();
        const float* x = p.in[0]; const float* meta = p.in[1]; const float* b_f = p.in[9];
        for (int job = bx * 8 + wid; job < M + NMETA; job += G * 8) {
            const bool ismeta = job >= M; const int row = ismeta ? job + VPAD : job;
            const float* src = ismeta ? meta + (size_t)(job - M) * DM : x + (size_t)job * DM;
            f32x4 v[8]; float ss = 0.f; float zf[8];
#pragma unroll
            for (int j = 0; j < 8; ++j) zf[j] = 0.f;
#pragma unroll
            for (int i = 0; i < 8; ++i) { v[i] = *(const f32x4*)(src + i * 256 + lane * 4);
                ss += (v[i][0] * v[i][0] + v[i][1] * v[i][1]) + (v[i][2] * v[i][2] + v[i][3] * v[i][3]); }
#pragma unroll
            for (int i = 0; i < 8; ++i) {
                u32x2 w; w.x = pg8::cvt_pk_bf16(v[i][0], v[i][1]); w.y = pg8::cvt_pk_bf16(v[i][2], v[i][3]);
                *(u32x2*)(XB + (size_t)row * DM + i * 256 + lane * 4) = w;
#pragma unroll
                for (int j = 0; j < 8; ++j) { const f32x4 wv = *(const f32x4*)(WF + j * DM + i * 256 + lane * 4); zf[j] += (v[i][0] * wv[0] + v[i][1] * wv[1]) + (v[i][2] * wv[2] + v[i][3] * wv[3]); } }
            ss = wave_sum(ss);
#pragma unroll
            for (int j = 0; j < 8; ++j) zf[j] = wave_sum(zf[j]);
            const float rs = __builtin_amdgcn_rsqf(ss * (1.0f / 2048.0f) + 1e-6f);
            if (lane == 0) { RSTD1[row] = rs; if (!ismeta) { SSQ2[row] = 0.f; SSQ3[row] = 0.f; } }
            if (lane < 8) { float zz = zf[0];
#pragma unroll
                for (int j = 1; j < 8; ++j) zz = (lane == j) ? zf[j] : zz;
                const float y = zz * rs + b_f[lane];
                const float lf = fminf(y, 0.f) - log1pf(__expf(-fabsf(y)));
                if (!ismeta) { const int b = job >> 13, t = job & (SEQ - 1); LOGF[(size_t)(b * 8 + lane) * LB + 64 + t] = lf; }
                else { const int vp = VPAD + (job - M);
#pragma unroll
                    for (int b = 0; b < NBATCH; ++b) LOGF[(size_t)(b * 8 + lane) * LB + vp] = lf; } }
        }
        for (int i = bx * 512 + tid; i < 16 * MQ; i += G * 512) KSQ[i] = 0.f;
        if (bx == 0 && tid == 0) *(unsigned*)(ws + WS_QCTR) = 0u;
        if (bx == 0) for (int i = tid; i < 32 * VPAD; i += 512) LOGF[(size_t)(i / VPAD) * LB + (i % VPAD)] = 0.f;
        __syncthreads();
    }
    SEAM(0);

    for (int rep_ = 0; rep_ < (REP_PHASE == 1 ? 2 : 1); ++rep_) if (IN(1)) {
        if (rep_) grid.sync();
        const int lane = fresh_lane(), tid = wid * 64 + lane;
        if (bx < 32) {
            const float* srcp = LOGF + (size_t)bx * LB; float* dstp = CUM + (size_t)bx * LB; float* red = (float*)lds;
            const int i0 = tid * 17; float vals[17]; float s = 0.f;
#pragma unroll
            for (int i = 0; i < 17; ++i) { const int k = i0 + i; vals[i] = k < LB ? srcp[k] : 0.f; s += vals[i]; vals[i] = s; }
            float incl = s;
#pragma unroll
            for (int o = 1; o < 64; o <<= 1) { const float t = __shfl_up(incl, o); if (lane >= o) incl += t; }
            if (lane == 63) red[wid] = incl;
            __syncthreads();
            float base = incl - s;
            for (int w = 0; w < wid; ++w) base += red[w];
#pragma unroll
            for (int i = 0; i < 17; ++i) { const int k = i0 + i; if (k < LB) dstp[k] = (base + vals[i]) * 11.313708498984761f; }
            __syncthreads();
        }
        {
            bf16_t* xm = (bf16_t*)lds;
            for (int i = tid; i < 16 * 256; i += 512) *(u32x4*)(xm + (size_t)i * 8) = *(const u32x4*)(XB + (size_t)(M + VPAD) * DM + (size_t)i * 8);
            { const int i = bx * 512 + tid; if (i < 32 * VPAD * 16) { const int sl = i / (VPAD * 16), r = (i / 16) % VPAD, ch = i % 16; const int hd = sl < 16 ? 8 + sl : 16 + sl;
                *(u32x4*)(QKV + ((size_t)hd * MQ + M + r) * 128 + ch * 8) = (u32x4){0u, 0u, 0u, 0u}; } }
            __syncthreads();
            for (int c0 = bx * 16; c0 < 4096; c0 += G * 16) {
#pragma unroll 1
                for (int cc = 0; cc < 2; ++cc) { const int c = c0 + wid * 2 + cc, sl = c >> 7, hd = sl < 16 ? 8 + sl : 16 + sl, n = hd * 128 + (c & 127);
                    f32x4 wa[8];
#pragma unroll
                    for (int q = 0; q < 4; ++q) unpack8(*(const u32x4*)(W1T + (size_t)n * DM + lane * 32 + q * 8), wa[2 * q], wa[2 * q + 1]);
                    float mine = 0.f;
#pragma unroll 1
                    for (int j = 0; j < 16; ++j) { float a = 0.f;
#pragma unroll
                        for (int q = 0; q < 4; ++q) { f32x4 x0, x1; unpack8(*(const u32x4*)(xm + (size_t)j * DM + lane * 32 + q * 8), x0, x1);
                            a += (x0[0] * wa[2 * q][0] + x0[1] * wa[2 * q][1]) + (x0[2] * wa[2 * q][2] + x0[3] * wa[2 * q][3]) + (x1[0] * wa[2 * q + 1][0] + x1[1] * wa[2 * q + 1][1]) + (x1[2] * wa[2 * q + 1][2] + x1[3] * wa[2 * q + 1][3]); }
                        a = wave_sum(a); mine = (lane == j) ? a : mine; }
                    if (lane < 16) { const float v = mine * RSTD1[M + VPAD + lane]; QKV[((size_t)hd * MQ + M + VPAD + lane) * 128 + (c & 127)] = (bf16_t)(pg8::cvt_pk_bf16(v, v) & 0xffffu);
                        if (sl < 8 || (sl >= 16 && sl < 24)) unsafeAtomicAdd(KSQ + (size_t)(sl < 8 ? sl : sl - 8) * MQ + M + VPAD + lane, v * v); } }
            }
            __syncthreads();
        }
        pg8::Gemm g{XB, W1T, M, N1, DM}; pg8::StaticOrder S; S.init(M, N1, G, bx);
        Epi1 E{QKV, GATES, RSTD1, KSQ};
        pg8::gemm_phase<Epi1, pg8::StaticOrder>((PG8_LAS unsigned char*)lds, g, S, E, wid * 64 + fresh_lane());
    }
    SEAM(1);

    for (int rep_ = 0; rep_ < (REP_PHASE == 2 ? 2 : 1); ++rep_) if (IN(2)) {
        if (rep_) grid.sync();
        const int lane = fresh_lane(), tid = wid * 64 + lane;
        float lam;
        { const float* q1 = p.in[4]; const float* k1 = p.in[5]; const float* q2 = p.in[6]; const float* k2 = p.in[7];
          float s1 = q1[lane] * k1[lane] + q1[lane + 64] * k1[lane + 64], s2 = q2[lane] * k2[lane] + q2[lane + 64] * k2[lane + 64];
          s1 = wave_sum(s1); s2 = wave_sum(s2); lam = __expf(s1) - __expf(s2) + 0.2f; lam = __uint_as_float(__builtin_amdgcn_readfirstlane(__float_as_uint(lam))); }
        const float* g_subln = p.in[8];
        float* scrT = (float*)(ws + WS_SCR + (size_t)bx * 262144); float* scrD = scrT + 32768;
        float* tabw = (float*)(lds + att::LDS_TAB);
        constexpr int NITEM = 1536;
        unsigned* qctr = (unsigned*)(ws + WS_QCTR);
        float* red = (float*)(lds + att::LDS_TAB + 8256 * 4);
        auto grab = [&]() -> int { if (wid == 0 && fresh_lane() == 0) red[16] = __uint_as_float(atomicAdd(qctr, 1u)); __syncthreads();
                                   const int v = __builtin_amdgcn_readfirstlane((int)__float_as_uint(red[16])); __syncthreads(); return v; };
        auto desc = [&](int item, int ps) -> att::Blk {
            att::Blk r;
            if (item >= 512) { const int j = item - 512, h = j >> 7, b = (j >> 5) & 3, qb = 31 - (j & 31);
                const size_t rb = (size_t)b * SEQ + 256 * qb; r.P0 = 64 + 256 * qb; r.mode = 0; r.s2 = 0.f;
                r.Q = QKV + ((size_t)(24 + h) * MQ + rb) * 128; r.K = QKV + ((size_t)(32 + h) * MQ + (size_t)b * SEQ) * 128 - 64 * 128; r.V = QKV + ((size_t)(40 + h) * MQ + (size_t)b * SEQ) * 128 - 64 * 128;
                r.K0 = QKV + ((size_t)(32 + h) * MQ + M) * 128; r.V0 = QKV + ((size_t)(40 + h) * MQ + M) * 128;
                r.O = OF + rb * 1024 + h * 128; }
            else { const int h = 3 - (item >> 7), b = (item >> 5) & 3, qb = 31 - (item & 31), e = ps >> 1, c = ps & 1;
                const size_t rb = (size_t)b * SEQ + 256 * qb; r.P0 = 64 + 256 * qb; r.mode = (c == 0) ? 1 : (e == 0 ? 2 : 3);
                r.s2 = 2.0f * 11.313708498984761f * (h == 0 ? 0.25f : h == 1 ? 0.0625f : h == 2 ? 0.015625f : 0.00390625f);
                r.Q = QKV + ((size_t)(2 * h + c) * MQ + rb) * 128; r.K = QKV + ((size_t)(8 + 2 * h + c) * MQ + (size_t)b * SEQ) * 128 - 64 * 128; r.V = QKV + ((size_t)(16 + 2 * h + e) * MQ + (size_t)b * SEQ) * 128 - 64 * 128;
                r.K0 = QKV + ((size_t)(8 + 2 * h + c) * MQ + M) * 128; r.V0 = QKV + ((size_t)(16 + 2 * h + e) * MQ + M) * 128;
                r.O = OA + rb * 1024 + h * 256; }
            return r; };
        int item = grab();
        if (item < NITEM) {
            att::Seam S;
            { const att::Blk first = desc(item, 0); att::attn_prime(first, (char*)lds, S, wid * 64 + fresh_lane()); }
            while (item < NITEM) {
              const int item_next = grab();
              const int np = item < 512 ? 4 : 1;
              for (int ps = 0; ps < np; ++ps) {
                const att::Blk cur = desc(item, ps);
                const bf16_t* nxtQ = (ps + 1 < np) ? desc(item, ps + 1).Q : (item_next < NITEM ? desc(item_next, 0).Q : cur.Q);
                const int tt = wid * 64 + fresh_lane(), ln_ = tt & 63;
                float km = 0.f;
                { const int nk = cur.P0 + 256;
                  if (item >= 512) { const int j = item - 512, h = j >> 7, b = (j >> 5) & 3; const float* cm = CUM + (size_t)(b * 8 + h) * LB; const float cref = cm[cur.P0];
                      const float* kq = KSQ + (size_t)(8 + h) * MQ;
                      for (int k = tt; k < nk; k += 512) { tabw[k] = cref - cm[k]; km = fmaxf(km, kq[k < 64 ? M + k : b * SEQ + k - 64]); } }
                  else { const int h = 3 - (item >> 7), b = (item >> 5) & 3, c = ps & 1; const float sl = 0.5f * cur.s2; const float* kq = KSQ + (size_t)(2 * h + c) * MQ;
                      for (int k = tt; k < nk; k += 512) { tabw[k] = sl * (float)(k - cur.P0); km = fmaxf(km, kq[k < 64 ? M + k : b * SEQ + k - 64]); } } }
                float qs = 0.f;
#pragma unroll
                for (int d0 = 0; d0 < 8; ++d0) { f32x4 a, b2; unpack8(*reinterpret_cast<const u32x4*>(&S.qr[d0]), a, b2); qs += (a[0] * a[0] + a[1] * a[1]) + (a[2] * a[2] + a[3] * a[3]) + (b2[0] * b2[0] + b2[1] * b2[1]) + (b2[2] * b2[2] + b2[3] * b2[3]); }
                qs += __shfl_xor(qs, 32);
#pragma unroll
                for (int o = 32; o >= 1; o >>= 1) { qs = fmaxf(qs, __shfl_xor(qs, o)); km = fmaxf(km, __shfl_xor(km, o)); }
                if (ln_ == 0) { red[wid] = qs; red[8 + wid] = km; }
                __syncthreads();
                int j_lo;
                { float q2 = red[0], k2 = red[8];
#pragma unroll
                  for (int w = 1; w < 8; ++w) { q2 = fmaxf(q2, red[w]); k2 = fmaxf(k2, red[8 + w]); }
                  const float Bnd = sqrtf(q2 * k2) * 1.05f + 1.0f; const float thr = -(1176.3f + 226.3f + Bnd);
                  int lo_ = 0, hi_2 = (cur.P0 + 255) / 64;
                  while (lo_ < hi_2) { const int mid = (lo_ + hi_2) >> 1; if (tabw[64 * mid + 63] < thr) lo_ = mid + 1; else hi_2 = mid; }
                  j_lo = __builtin_amdgcn_readfirstlane(lo_); }
                att::attn_block(cur, nxtQ, (char*)lds, S, lam, scrT, scrD, g_subln, wid * 64 + fresh_lane(), j_lo);
              }
              item = item_next;
            }
        }
        asm volatile("s_waitcnt vmcnt(0)" ::: "memory");
        __syncthreads();
    }
    SEAM(2);

    for (int rep_ = 0; rep_ < (REP_PHASE == 3 ? 2 : 1); ++rep_) if (IN(3)) {
        if (rep_) grid.sync();
        { pg8::Gemm g{OA, WAT, M, DM, 1024}; pg8::StaticOrder S; S.init(M, DM, G, bx); Epi3a E{TMP, GATES};
          pg8::gemm_phase<Epi3a, pg8::StaticOrder>((PG8_LAS unsigned char*)lds, g, S, E, wid * 64 + fresh_lane()); }
        { pg8::Gemm g{OF, WFT, M, DM, 1024}; pg8::StaticOrder S; S.init(M, DM, G, bx); Epi3b E{TMP, GATES, MERGED};
          pg8::gemm_phase<Epi3b, pg8::StaticOrder>((PG8_LAS unsigned char*)lds, g, S, E, wid * 64 + fresh_lane()); }
    }
    SEAM(3);

    if (IN(4)) {
        pg8::Gemm g{MERGED, WOT, M, DM, DM}; pg8::StaticOrder S; S.init(M, DM, G, bx); Epi4 E{p.in[0], p.out, H1B, SSQ2};
        pg8::gemm_phase<Epi4, pg8::StaticOrder>((PG8_LAS unsigned char*)lds, g, S, E, wid * 64 + fresh_lane());
    }
    SEAM(4);

    for (int rep_ = 0; rep_ < (REP_PHASE == 5 ? 2 : 1); ++rep_) if (IN(5)) {
        if (rep_) grid.sync();
        pg8::Gemm g{H1B, W5T, M, N5, DM}; pg8::StaticOrder S; S.init(M, N5, G, bx); Epi5 E{SSQ2, ACT};
        pg8::gemm_phase<Epi5, pg8::StaticOrder>((PG8_LAS unsigned char*)lds, g, S, E, wid * 64 + fresh_lane());
    }
    SEAM(5);

    if (IN(6)) {
        pg8::Gemm g{ACT, WDT, M, DM, DFF}; pg8::StaticOrder S; S.init(M, DM, G, bx); Epi6 E{p.out, SSQ3};
        pg8::gemm_phase<Epi6, pg8::StaticOrder>((PG8_LAS unsigned char*)lds, g, S, E, wid * 64 + fresh_lane());
    }
    SEAM(6);

    if (IN(7)) {
        const int lane = fresh_lane();
        const float* gfin = p.in[17];
        f32x4 gv[8];
#pragma unroll
        for (int i = 0; i < 8; ++i) gv[i] = *(const f32x4*)(gfin + i * 256 + lane * 4);
        for (int orow = bx * 8 + wid; orow < NBATCH * SEQ; orow += G * 8) {
            const int row = orow;
            const float rs = __builtin_amdgcn_rsqf(SSQ3[row] * (1.0f / 2048.0f) + 1e-6f);
            float* d = p.out + (size_t)orow * DM + lane * 4;
#pragma unroll
            for (int i = 0; i < 8; ++i) { const f32x4 v = *(const f32x4*)(d + i * 256); *(f32x4*)(d + i * 256) = v * rs * gv[i]; }
        }
    }
#undef IN
#undef SEAM
}

extern "C" void kernel_launch(void* const* d_in, const int* in_sizes, int n_in, void* d_out, int out_size, void* d_ws, size_t ws_size, hipStream_t stream) {
    static int grid = 0;
    if (grid == 0) {
        if (n_in != 18 || ws_size < WS_END) { fprintf(stderr, "kernel_launch: need 18 inputs and >= %zu bytes of workspace (got %d, %zu)\n", (size_t)WS_END, n_in, ws_size); grid = -1; return; }
        int dev = 0, cus = 0, per_cu = 0;
        (void)hipGetDevice(&dev);
        if (hipDeviceGetAttribute(&cus, hipDeviceAttributeMultiprocessorCount, dev) != hipSuccess || cus <= 0) cus = 256;
        if (hipFuncSetAttribute((const void*)fwd_kernel, hipFuncAttributeMaxDynamicSharedMemorySize, LDS_BYTES) != hipSuccess) { fprintf(stderr, "kernel_launch: hipFuncSetAttribute failed\n"); }
        if (hipOccupancyMaxActiveBlocksPerMultiprocessor(&per_cu, (const void*)fwd_kernel, 512, LDS_BYTES) != hipSuccess || per_cu < 1) { fprintf(stderr, "kernel_launch: occupancy query says %d\n", per_cu); per_cu = 1; }
        (void)hipGetLastError();
        grid = cus * 1;
        if (grid > 256) grid = 256;
    }
    if (grid < 0) return;
    Params p{};
    for (int i = 0; i < 18; ++i) p.in[i] = (const float*)d_in[i];
    p.out = (float*)d_out; p.ws = (unsigned char*)d_ws;
#if ONE_LAUNCH
    p.ph_lo = 0; p.ph_hi = 8;
    void* args[] = {&p};
    hipError_t e = hipLaunchCooperativeKernel((const void*)fwd_kernel, dim3(grid), dim3(512), args, LDS_BYTES, stream);
    if (e != hipSuccess) fprintf(stderr, "cooperative launch failed: %s (grid %d)\n", hipGetErrorString(e), grid);
#else
    for (int ph = 0; ph < 8; ++ph) { p.ph_lo = ph; p.ph_hi = ph + 1; hipLaunchKernelGGL(fwd_kernel, dim3(grid), dim3(512), LDS_BYTES, stream, p); }
#endif
}
```

```cpp
#include <hip/hip_runtime.h>
#include <hip/hip_cooperative_groups.h>
#include <cstdio>
#include <cstdint>
namespace cg = cooperative_groups;

#ifndef REP_PHASE
#define REP_PHASE -1
#endif
#ifndef ONE_LAUNCH
#define ONE_LAUNCH 1
#endif

typedef unsigned short bf16_t;
typedef short bf16x8 __attribute__((ext_vector_type(8)));
typedef short s16x4 __attribute__((ext_vector_type(4)));
typedef float f32x4 __attribute__((ext_vector_type(4)));
typedef float f32x16 __attribute__((ext_vector_type(16)));
typedef unsigned u32x4 __attribute__((ext_vector_type(4)));
typedef unsigned u32x2 __attribute__((ext_vector_type(2)));

constexpr int DM = 2048, NBATCH = 4, SEQ = 8192, NMETA = 16;
constexpr int VPAD = 48;
constexpr int LB = 8256;
constexpr int M = NBATCH * SEQ;
constexpr int MQ = M + 64;
constexpr int NINC = 10248;
constexpr int N1 = 10240;
constexpr int DFF = 5632, N5 = 2 * DFF;
constexpr int NHD = 48;

constexpr size_t SZ_W1T = (size_t)N1 * DM * 2, SZ_WAT = (size_t)DM * 1024 * 2, SZ_WOT = (size_t)DM * DM * 2, SZ_W5T = (size_t)N5 * DM * 2, SZ_WDT = (size_t)DM * DFF * 2;
constexpr size_t WS_W1T = 0, WS_WAT = WS_W1T + SZ_W1T, WS_WFT = WS_WAT + SZ_WAT, WS_WOT = WS_WFT + SZ_WAT, WS_W5T = WS_WOT + SZ_WOT, WS_WDT = WS_W5T + SZ_W5T;
constexpr size_t WS_RA = WS_WDT + SZ_WDT;
constexpr size_t SZ_RA = (size_t)MQ * DM * 2;
constexpr size_t WS_RB = WS_RA + SZ_RA;
constexpr size_t SZ_RB = (size_t)NHD * MQ * 128 * 2;
constexpr size_t WS_RG = WS_RB + SZ_RB;
constexpr size_t SZ_RG = (size_t)M * 4096 * 2;
constexpr size_t WS_RSTD1 = WS_RG + SZ_RG, WS_SSQ2 = WS_RSTD1 + (size_t)MQ * 4, WS_SSQ3 = WS_SSQ2 + (size_t)M * 8 * 4;
constexpr size_t WS_LOGF = WS_SSQ3 + (size_t)M * 8 * 4, WS_CUM = WS_LOGF + (size_t)32 * LB * 4;
constexpr size_t WS_SCR = WS_CUM + (size_t)32 * LB * 4;
constexpr size_t WS_KSQ = WS_SCR + (size_t)256 * 262144;
constexpr size_t WS_QCTR = WS_KSQ + (size_t)16 * MQ * 4;
constexpr size_t WS_SSQA = WS_QCTR + 256;
constexpr size_t WS_END = WS_SSQA + (size_t)M * 8 * 4;
constexpr int LDS_BYTES = 131072;

namespace pg8 {
#define PG8_LAS __attribute__((address_space(3)))
constexpr int BM = 256, BK = 64, HALF = 128, HTB = HALF * BK * 2, STAGE_BYTES = 8 * HTB, NXCD = 8, WGM = 8;
__host__ __device__ __forceinline__ int lds_byte(int r, int c) { const int st = (r >> 4) * 2 + (c >> 5), rr = r & 15, cc = c & 31, ob = rr * 64 + cc * 2; return st * 1024 + (ob ^ (((ob >> 9) & 1) << 5)); }
__host__ __device__ __forceinline__ void stage_rc(int b, int& R, int& C) { const int st = b / 1024, sb = b % 1024, swz = sb ^ (((sb >> 9) & 1) << 5); R = (st >> 1) * 16 + swz / 64; C = (st & 1) * 32 + (swz % 64) / 2; }
__host__ __device__ __forceinline__ int perm32(int rho) { const int n = rho >> 4, i = rho & 15; return 8 * (i >> 2) + 4 * n + (i & 3); }
struct Unit { int pm, pn; };
struct Gemm { const bf16_t* A; const bf16_t* Bt; int M, N, K; };
struct StaticOrder {
    int nM, nN, nwg, G, c;
    __host__ __device__ void init(int M_, int N_, int G_, int c_) { nM = M_ / BM; nN = N_ / BM; nwg = nM * nN; G = G_; c = c_; }
    __host__ __device__ bool next(int i, Unit& u) const {
        const long L = (long)i * G + c; if (L >= nwg) return false;
        int wgid = (int)L; { const int q = nwg / NXCD, r = nwg % NXCD, xcd = wgid % NXCD, off = wgid / NXCD; wgid = (xcd < r ? xcd * (q + 1) : r * (q + 1) + (xcd - r) * q) + off; }
        const int nig = WGM * nN, gid = wgid / nig, fm = gid * WGM, gsz = (nM - fm) < WGM ? (nM - fm) : WGM;
        u.pm = fm + ((wgid % nig) % gsz); u.pn = (wgid % nig) / gsz; return true;
    }
    __device__ __forceinline__ void a_ready(const Unit&) const {}
    __device__ __forceinline__ void done(const Unit&) const {}
};
__device__ __forceinline__ unsigned cvt_pk_bf16(float lo, float hi) { unsigned r; asm volatile("v_cvt_pk_bf16_f32 %0, %1, %2" : "=v"(r) : "v"(lo), "v"(hi)); return r; }

template <class Epi, class Sched>
__device__ __forceinline__ void gemm_phase(PG8_LAS unsigned char* lds, const Gemm g, const Sched& S, const Epi& E, const int tid) {
    const int wid = __builtin_amdgcn_readfirstlane(tid >> 6), lane = tid & 63, wr = wid >> 2, wc = wid & 3, fr = lane & 15, fq = lane >> 4;
    const int K = g.K, nt = K / BK;
    unsigned voffA[2], voffB[2];
#pragma unroll
    for (int i = 0; i < 2; ++i) { int R, C; stage_rc(tid * 16 + i * 8192, R, C); const int Rb = Epi::PERM ? ((R & ~31) + perm32(R & 31)) : R;
        voffA[i] = (unsigned)(R * K + C) * 2u; voffB[i] = (unsigned)(Rb * K + C) * 2u; }
    const size_t kstep = (size_t)(BK * 2);
    const size_t hstep = (size_t)HALF * K * 2;
    const size_t tstep = 2 * hstep;
    const unsigned ldsw = (unsigned)wid * 1024u;
    const int aoff = lds_byte(wr * 64 + fr, fq * 8), boff = lds_byte(wc * 32 + fr, fq * 8);
#define PG8_SA(b, h) (((b) * 2 + (h)) * HTB)
#define PG8_SB(b, h) ((4 + (b) * 2 + (h)) * HTB)
#define PG8_STAGE(bufoff, gbase, voff) do { _Pragma("unroll") for (int _i = 0; _i < 2; ++_i) \
        __builtin_amdgcn_global_load_lds((const unsigned*)((const char*)(gbase) + (voff)[_i]), (PG8_LAS unsigned*)(lds + (bufoff) + ldsw + _i * 8192), 16, 0, 0); } while (0)
#define PG8_LDA(dst, b, h) do { _Pragma("unroll") for (int m = 0; m < 4; ++m) _Pragma("unroll") for (int k = 0; k < 2; ++k) dst[m][k] = *(const PG8_LAS bf16x8*)(lds + PG8_SA(b, h) + aoff + m * 2048 + k * 1024); } while (0)
#define PG8_LDB(dst, b, h) do { _Pragma("unroll") for (int n = 0; n < 2; ++n) _Pragma("unroll") for (int k = 0; k < 2; ++k) dst[n][k] = *(const PG8_LAS bf16x8*)(lds + PG8_SB(b, h) + boff + n * 2048 + k * 1024); } while (0)
#define PG8_MMA(ai, bj, At, Bt) do { __builtin_amdgcn_s_setprio(1); _Pragma("unroll") for (int m = 0; m < 4; ++m) _Pragma("unroll") for (int n = 0; n < 2; ++n) _Pragma("unroll") for (int k = 0; k < 2; ++k) \
        acc[ai][bj][m][n] = __builtin_amdgcn_mfma_f32_16x16x32_bf16(Bt[n][k], At[m][k], acc[ai][bj][m][n], 0, 0, 0); __builtin_amdgcn_s_setprio(0); } while (0)
#define PG8_WAIT_V(n) asm volatile("s_waitcnt vmcnt(" #n ")" ::: "memory")
#define PG8_WAIT_L(n) asm volatile("s_waitcnt lgkmcnt(" #n ")" ::: "memory")
#define PG8_BAR __builtin_amdgcn_s_barrier()
#define PG8_SCHED __builtin_amdgcn_sched_barrier(0)
    Unit cur, nxt; int ui = 0;
    if (!S.next(0, cur)) return;
    f32x4 acc[2][2][4][2];
#pragma unroll
    for (int a = 0; a < 2; ++a)
#pragma unroll
        for (int b = 0; b < 2; ++b)
#pragma unroll
            for (int m = 0; m < 4; ++m)
#pragma unroll
                for (int n = 0; n < 2; ++n) acc[a][b][m][n] = (f32x4){0.f, 0.f, 0.f, 0.f};
    bf16x8 At[4][2], B0[2][2], B1[2][2];
    const char* cA = (const char*)g.A + (size_t)cur.pm * tstep; const char* cB = (const char*)g.Bt + (size_t)cur.pn * tstep;
    S.a_ready(cur);
    PG8_STAGE(PG8_SB(0, 0), cB, voffB); PG8_STAGE(PG8_SA(0, 0), cA, voffA); PG8_STAGE(PG8_SB(0, 1), cB + hstep, voffB); PG8_STAGE(PG8_SA(0, 1), cA + hstep, voffA);
    if (wr == 1) PG8_BAR;
    PG8_WAIT_V(4); PG8_BAR;
    PG8_STAGE(PG8_SB(1, 0), cB + kstep, voffB); PG8_STAGE(PG8_SA(1, 0), cA + kstep, voffA); PG8_STAGE(PG8_SB(1, 1), cB + hstep + kstep, voffB);
    PG8_WAIT_V(6); PG8_BAR;
    for (;;) {
        const bool has_next = S.next(ui + 1, nxt);
        const char* nA = has_next ? (const char*)g.A + (size_t)nxt.pm * tstep : cA; const char* nB = has_next ? (const char*)g.Bt + (size_t)nxt.pn * tstep : cB;
        for (int t = 0; t < nt; t += 2) {
            const bool last = (t == nt - 2);
            const char* a1 = cA + (size_t)(t + 1) * kstep;
            const char* a2 = last ? nA : cA + (size_t)(t + 2) * kstep; const char* b2 = last ? nB : cB + (size_t)(t + 2) * kstep;
            const char* a3 = a2 + kstep; const char* b3 = b2 + kstep;
            if (last && has_next) S.a_ready(nxt);
            PG8_LDB(B0, 0, 0); PG8_SCHED; PG8_LDA(At, 0, 0); PG8_STAGE(PG8_SA(1, 1), a1 + hstep, voffA);
            PG8_WAIT_L(8); PG8_BAR; PG8_WAIT_L(0); PG8_MMA(0, 0, At, B0); PG8_BAR; PG8_SCHED;
            PG8_LDB(B1, 0, 1); PG8_STAGE(PG8_SB(0, 0), b2, voffB);
            PG8_BAR; PG8_WAIT_L(0); PG8_MMA(0, 1, At, B1); PG8_BAR;
            PG8_LDA(At, 0, 1); PG8_STAGE(PG8_SA(0, 0), a2, voffA);
            PG8_BAR; PG8_WAIT_L(0); PG8_MMA(1, 0, At, B0); PG8_BAR; PG8_SCHED;
            PG8_STAGE(PG8_SB(0, 1), b2 + hstep, voffB);
            PG8_WAIT_V(6); PG8_BAR; PG8_MMA(1, 1, At, B1); PG8_BAR;
            PG8_LDB(B0, 1, 0); PG8_SCHED; PG8_LDA(At, 1, 0); PG8_STAGE(PG8_SA(0, 1), a2 + hstep, voffA);
            PG8_WAIT_L(8); PG8_BAR; PG8_WAIT_L(0); PG8_MMA(0, 0, At, B0); PG8_BAR; PG8_SCHED;
            PG8_LDB(B1, 1, 1); PG8_STAGE(PG8_SB(1, 0), b3, voffB);
            PG8_BAR; PG8_WAIT_L(0); PG8_MMA(0, 1, At, B1); PG8_BAR;
            PG8_LDA(At, 1, 1); PG8_STAGE(PG8_SA(1, 0), a3, voffA);
            PG8_BAR; PG8_WAIT_L(0); PG8_MMA(1, 0, At, B0); PG8_BAR; PG8_SCHED;
            PG8_STAGE(PG8_SB(1, 1), b3 + hstep, voffB);
            PG8_WAIT_V(6); PG8_BAR; PG8_MMA(1, 1, At, B1); PG8_BAR;
        }
        E(acc, cur, wr, wc, fr, fq); S.done(cur);
        if (!has_next) break;
#pragma unroll
        for (int a = 0; a < 2; ++a)
#pragma unroll
            for (int b = 0; b < 2; ++b)
#pragma unroll
                for (int m = 0; m < 4; ++m)
#pragma unroll
                    for (int n = 0; n < 2; ++n) acc[a][b][m][n] = (f32x4){0.f, 0.f, 0.f, 0.f};
        cur = nxt; cA = nA; cB = nB; ++ui;
    }
    PG8_WAIT_V(0);
    if (wr == 0) PG8_BAR;
    PG8_BAR;
#undef PG8_SA
#undef PG8_SB
#undef PG8_STAGE
#undef PG8_LDA
#undef PG8_LDB
#undef PG8_MMA
#undef PG8_WAIT_V
#undef PG8_WAIT_L
#undef PG8_BAR
#undef PG8_SCHED
}
}

__device__ __forceinline__ int fresh_lane() { int l; asm volatile("v_mbcnt_lo_u32_b32 %0, -1, 0\n\tv_mbcnt_hi_u32_b32 %0, -1, %0" : "=v"(l)); return l; }
__device__ __forceinline__ float bf2f(unsigned short b) { return __uint_as_float(((unsigned)b) << 16); }
__device__ __forceinline__ float sigmoidf_(float x) { return __builtin_amdgcn_rcpf(1.0f + __builtin_amdgcn_exp2f(-1.4426950408889634f * x)); }
__device__ __forceinline__ u32x4 pack8u(f32x4 a, f32x4 b) { u32x4 w = {pg8::cvt_pk_bf16(a[0], a[1]), pg8::cvt_pk_bf16(a[2], a[3]), pg8::cvt_pk_bf16(b[0], b[1]), pg8::cvt_pk_bf16(b[2], b[3])}; return w; }
__device__ __forceinline__ void unpack8(u32x4 w, f32x4& a, f32x4& b) {
    a = (f32x4){__uint_as_float(w.x << 16), __uint_as_float(w.x & 0xffff0000u), __uint_as_float(w.y << 16), __uint_as_float(w.y & 0xffff0000u)};
    b = (f32x4){__uint_as_float(w.z << 16), __uint_as_float(w.z & 0xffff0000u), __uint_as_float(w.w << 16), __uint_as_float(w.w & 0xffff0000u)};
}
__device__ __forceinline__ float wave_sum(float v) {
#pragma unroll
    for (int o = 32; o >= 1; o >>= 1) v += __shfl_xor(v, o);
    return v;
}

typedef f32x4 Acc[2][2][4][2];
struct Epi1 { static constexpr bool PERM = true;
    bf16_t* QKV; bf16_t* GATES; const float* rstd; float* KSQ;
    __device__ __forceinline__ void operator()(const Acc& acc, const pg8::Unit& u, int wr, int wc, int fr, int fq) const {
        const int row0 = u.pm * 256 + wr * 64 + fr;
        if (u.pn < 24) {
            const bool iskh = (u.pn >= 4 && u.pn < 8) || (u.pn >= 16 && u.pn < 20);
            const int ks0 = u.pn < 8 ? 2 * u.pn - 8 : 2 * u.pn - 32 + 8;
#pragma unroll
            for (int ai = 0; ai < 2; ++ai)
#pragma unroll
                for (int m = 0; m < 4; ++m) { const int row = row0 + ai * 128 + m * 16; const float rs = rstd[row];
#pragma unroll
                    for (int bj = 0; bj < 2; ++bj) { bf16_t* dst = QKV + ((size_t)(2 * u.pn + bj) * MQ + row) * 128 + wc * 32 + 8 * fq;
                        const f32x4 v0 = acc[ai][bj][m][0] * rs, v1 = acc[ai][bj][m][1] * rs;
                        *(u32x4*)dst = pack8u(v0, v1);
                        if (iskh) { float ss = (v0[0] * v0[0] + v0[1] * v0[1]) + (v0[2] * v0[2] + v0[3] * v0[3]) + (v1[0] * v1[0] + v1[1] * v1[1]) + (v1[2] * v1[2] + v1[3] * v1[3]);
                            ss += __shfl_xor(ss, 16); ss += __shfl_xor(ss, 32);
                            if (fq == 0) atomicAdd(KSQ + (size_t)(ks0 + bj) * MQ + row, ss); } } }
        } else {
            const int colb = (u.pn - 24) * 256 + wc * 32 + 8 * fq;
#pragma unroll
            for (int ai = 0; ai < 2; ++ai)
#pragma unroll
                for (int m = 0; m < 4; ++m) { const int row = row0 + ai * 128 + m * 16; const float rs = rstd[row];
#pragma unroll
                    for (int bj = 0; bj < 2; ++bj) { f32x4 v0 = acc[ai][bj][m][0] * rs, v1 = acc[ai][bj][m][1] * rs;
#pragma unroll
                        for (int j = 0; j < 4; ++j) { v0[j] = sigmoidf_(v0[j]); v1[j] = sigmoidf_(v1[j]); }
                        *(u32x4*)(GATES + (size_t)row * 4096 + colb + bj * 128) = pack8u(v0, v1); } }
        }
    }
};
struct Epi3a { static constexpr bool PERM = true;
    float* TMP; const bf16_t* GATES;
    __device__ __forceinline__ void operator()(const Acc& acc, const pg8::Unit& u, int wr, int wc, int fr, int fq) const {
        const int row0 = u.pm * 256 + wr * 64 + fr, col0 = u.pn * 256 + wc * 32 + 8 * fq;
#pragma unroll
        for (int ai = 0; ai < 2; ++ai)
#pragma unroll
            for (int m = 0; m < 4; ++m) { const int row = row0 + ai * 128 + m * 16;
#pragma unroll
                for (int bj = 0; bj < 2; ++bj) { const int col = col0 + bj * 128; f32x4 g0, g1; unpack8(*(const u32x4*)(GATES + (size_t)row * 4096 + col), g0, g1);
                    float* d = TMP + (size_t)row * DM + col; *(f32x4*)d = acc[ai][bj][m][0] * g0; *(f32x4*)(d + 4) = acc[ai][bj][m][1] * g1; } }
    }
};
struct Epi3b { static constexpr bool PERM = true;
    const float* TMP; const bf16_t* GATES; bf16_t* MERGED;
    __device__ __forceinline__ void operator()(const Acc& acc, const pg8::Unit& u, int wr, int wc, int fr, int fq) const {
        const int row0 = u.pm * 256 + wr * 64 + fr, col0 = u.pn * 256 + wc * 32 + 8 * fq;
#pragma unroll
        for (int ai = 0; ai < 2; ++ai)
#pragma unroll
            for (int m = 0; m < 4; ++m) { const int row = row0 + ai * 128 + m * 16;
#pragma unroll
                for (int bj = 0; bj < 2; ++bj) { const int col = col0 + bj * 128; f32x4 g0, g1; unpack8(*(const u32x4*)(GATES + (size_t)row * 4096 + 2048 + col), g0, g1);
                    const float* s = TMP + (size_t)row * DM + col; const f32x4 t0 = *(const f32x4*)s, t1 = *(const f32x4*)(s + 4);
                    *(u32x4*)(MERGED + (size_t)row * DM + col) = pack8u(t0 + acc[ai][bj][m][0] * g0, t1 + acc[ai][bj][m][1] * g1); } }
    }
};
struct Epi4 { static constexpr bool PERM = true;
    const float* x; float* out; bf16_t* H1B; float* ssq;
    __device__ __forceinline__ void operator()(const Acc& acc, const pg8::Unit& u, int wr, int wc, int fr, int fq) const {
        const int row0 = u.pm * 256 + wr * 64 + fr, col0 = u.pn * 256 + wc * 32 + 8 * fq;
#pragma unroll
        for (int ai = 0; ai < 2; ++ai)
#pragma unroll
            for (int m = 0; m < 4; ++m) { const int row = row0 + ai * 128 + m * 16; const size_t orow = (size_t)row; float ss = 0.f;
#pragma unroll
                    for (int bj = 0; bj < 2; ++bj) { const int col = col0 + bj * 128; const float* xs = x + orow * DM + col;
                        const f32x4 h0 = *(const f32x4*)xs + acc[ai][bj][m][0], h1 = *(const f32x4*)(xs + 4) + acc[ai][bj][m][1];
                        float* d = out + orow * DM + col; *(f32x4*)d = h0; *(f32x4*)(d + 4) = h1;
                        *(u32x4*)(H1B + (size_t)row * DM + col) = pack8u(h0, h1);
                        ss += (h0[0] * h0[0] + h0[1] * h0[1]) + (h0[2] * h0[2] + h0[3] * h0[3]) + (h1[0] * h1[0] + h1[1] * h1[1]) + (h1[2] * h1[2] + h1[3] * h1[3]); }
                    ss += __shfl_xor(ss, 16); ss += __shfl_xor(ss, 32);
                    if (fq == 0) atomicAdd(ssq + (size_t)u.pn * M + row, ss); }
    }
};
struct Epi5 { static constexpr bool PERM = true;
    const float* ssq; bf16_t* ACT;
    __device__ __forceinline__ void operator()(const Acc& acc, const pg8::Unit& u, int wr, int wc, int fr, int fq) const {
        const int row0 = u.pm * 256 + wr * 64 + fr, col0 = u.pn * 128 + wc * 32 + 8 * fq;
#pragma unroll
        for (int ai = 0; ai < 2; ++ai)
#pragma unroll
            for (int m = 0; m < 4; ++m) { const int row = row0 + ai * 128 + m * 16; float sq = 0.f;
#pragma unroll
                for (int t = 0; t < 8; ++t) sq += ssq[(size_t)t * M + row];
                const float rs = __builtin_amdgcn_rsqf(sq * (1.0f / 2048.0f) + 1e-6f);
                f32x4 o[2];
#pragma unroll
                for (int n = 0; n < 2; ++n) { const f32x4 g = acc[ai][0][m][n] * rs, up = acc[ai][1][m][n] * rs;
#pragma unroll
                    for (int j = 0; j < 4; ++j) o[n][j] = g[j] * sigmoidf_(g[j]) * up[j]; }
                *(u32x4*)(ACT + (size_t)row * DFF + col0) = pack8u(o[0], o[1]); }
    }
};
struct Epi6 { static constexpr bool PERM = true;
    float* out; float* ssq;
    __device__ __forceinline__ void operator()(const Acc& acc, const pg8::Unit& u, int wr, int wc, int fr, int fq) const {
        const int row0 = u.pm * 256 + wr * 64 + fr, col0 = u.pn * 256 + wc * 32 + 8 * fq;
#pragma unroll
        for (int ai = 0; ai < 2; ++ai)
#pragma unroll
            for (int m = 0; m < 4; ++m) { const int row = row0 + ai * 128 + m * 16; const size_t orow = (size_t)row; float ss = 0.f;
#pragma unroll
                    for (int bj = 0; bj < 2; ++bj) { const int col = col0 + bj * 128; float* d = out + orow * DM + col;
                        const f32x4 h0 = *(const f32x4*)d + acc[ai][bj][m][0], h1 = *(const f32x4*)(d + 4) + acc[ai][bj][m][1];
                        *(f32x4*)d = h0; *(f32x4*)(d + 4) = h1;
                        ss += (h0[0] * h0[0] + h0[1] * h0[1]) + (h0[2] * h0[2] + h0[3] * h0[3]) + (h1[0] * h1[0] + h1[1] * h1[1]) + (h1[2] * h1[2] + h1[3] * h1[3]); }
                    ss += __shfl_xor(ss, 16); ss += __shfl_xor(ss, 32);
                    if (fq == 0) atomicAdd(ssq + (size_t)u.pn * M + row, ss); }
    }
};

namespace att {
constexpr int D = 128, NW = 8, QBLK = 32, KVBLK = 64, QB = 256;
constexpr int SHM_V = KVBLK * D * 2, SHM_K = KVBLK * D * 2;
constexpr int LDS_WS = 2 * SHM_V + 2 * SHM_K;
constexpr int LDS_TAB = LDS_WS + NW * 64 * 4;
constexpr float SCALE = 0.08838834764831845f;
constexpr float THR = 8.f;
#define KSWZ(row, colB) ((row) * 256 + ((colB) ^ (((row) & 7) << 4)))
#define SBAR() __builtin_amdgcn_sched_barrier(0)
__device__ __forceinline__ int v_st(int k, int c) { const int kk = (k & ~0xC) | ((k & 4) << 1) | ((k & 8) >> 1); return ((kk >> 3) * 4 + (c >> 5)) * 512 + ((kk & 7) * 32 + (c & 31)) * 2; }
__device__ __forceinline__ int v_rd_base(int lane) { return ((lane & 3) << 3) | (((lane >> 2) & 3) << 6) | (((lane >> 4) & 1) << 5) | (((lane >> 5) & 1) << 8); }
constexpr int v_rd_off(int d0, int ks, int half) { return d0 * 512 + ks * 4096 + half * 2048; }
__device__ __forceinline__ int crow(int r, int hi) { return (r & 3) + 8 * (r >> 2) + 4 * hi; }
__device__ __forceinline__ unsigned cvtpk(float lo, float hi) { unsigned r; asm volatile("v_cvt_pk_bf16_f32 %0, %1, %2" : "=v"(r) : "v"(lo), "v"(hi)); return r; }
__device__ __forceinline__ bf16x8 load8(const bf16_t* p) { return *reinterpret_cast<const bf16x8*>(p); }
__device__ __forceinline__ void mask_tile(f32x16& p0, f32x16& p1, int dqe, int dqt, unsigned W, float s2) {
    const float NEG = -__builtin_inff();
#pragma unroll
    for (int r = 0; r < 16; ++r) {
        const int c = (r & 3) + 8 * (r >> 2);
        const int a0 = c - dqt, a1 = c + 32 - dqt;
        p0[r] -= s2 * (float)(a0 > 0 ? a0 : 0);
        p1[r] -= s2 * (float)(a1 > 0 ? a1 : 0);
        if ((unsigned)(dqe - c) >= W) p0[r] = NEG;
        if ((unsigned)(dqe - c - 32) >= W) p1[r] = NEG;
    }
}
__device__ __forceinline__ void partialSM(f32x16& p0, f32x16& p1, float& m_reg, float& mn, float& alpha, bool& skip) {
    float pmax = p0[0]; for (int r = 1; r < 16; ++r) pmax = fmaxf(pmax, p0[r]); for (int r = 0; r < 16; ++r) pmax = fmaxf(pmax, p1[r]);
    { auto rr = __builtin_amdgcn_permlane32_swap(__float_as_uint(pmax), __float_as_uint(pmax), false, false);
      pmax = fmaxf(__uint_as_float(rr[0]), __uint_as_float(rr[1])); }
    constexpr float C2 = 1.4426950408889634f * SCALE;
    skip = __all((pmax - m_reg) * C2 < -150.f);
    if (skip) { mn = m_reg; alpha = 1.f; return; }
    if (__builtin_expect(__all((pmax - m_reg) * SCALE <= THR), 1)) { mn = m_reg; alpha = 1.f; }
    else { mn = fmaxf(m_reg, pmax); alpha = __builtin_amdgcn_exp2f((m_reg - mn) * C2); m_reg = mn; }
    const float mnL = -mn * C2;
    for (int r = 0; r < 16; ++r) p0[r] = fmaf(p0[r], C2, mnL); for (int r = 0; r < 16; ++r) p1[r] = fmaf(p1[r], C2, mnL);
    for (int r = 0; r < 16; ++r) p0[r] = __builtin_amdgcn_exp2f(p0[r]);
}
__device__ __forceinline__ void finishSM(f32x16& p0, f32x16& p1, float alpha, float& l_reg, bf16x8& pa0, bf16x8& pa1, bf16x8& pa2, bf16x8& pa3) {
    for (int r = 0; r < 16; ++r) p1[r] = __builtin_amdgcn_exp2f(p1[r]);
    float ps = 0; for (int r = 0; r < 16; ++r) ps += p0[r]; for (int r = 0; r < 16; ++r) ps += p1[r];
    { auto rr = __builtin_amdgcn_permlane32_swap(__float_as_uint(ps), __float_as_uint(ps), false, false);
      ps = __uint_as_float(rr[0]) + __uint_as_float(rr[1]); }
    l_reg = l_reg * alpha + ps;
#define PK4(P, B_, OUT) do { unsigned a0 = cvtpk(P[B_+0], P[B_+1]), a1 = cvtpk(P[B_+2], P[B_+3]);                          \
        unsigned b0 = cvtpk(P[B_+4], P[B_+5]), b1 = cvtpk(P[B_+6], P[B_+7]);                                             \
        auto r0 = __builtin_amdgcn_permlane32_swap(a0, b0, false, false); auto r1 = __builtin_amdgcn_permlane32_swap(a1, b1, false, false); \
        u32x4 w = {r0[0], r1[0], r0[1], r1[1]}; OUT = *reinterpret_cast<bf16x8*>(&w); } while (0)
    PK4(p0, 0, pa0); PK4(p0, 8, pa1); PK4(p1, 0, pa2); PK4(p1, 8, pa3);
#undef PK4
}
template <int KB>
__device__ __forceinline__ void qkt(f32x16& p0, f32x16& p1, const char* K_lds, int r32, int hi, const bf16x8* qr) {
    p0 = f32x16{}; p1 = f32x16{};
    const char* kb[4];
#pragma unroll
    for (int dd = 0; dd < 4; ++dd) kb[dd] = K_lds + KB * SHM_K + KSWZ(r32, (dd * 16 + hi * 8) * 2);
#pragma unroll
    for (int d0 = 0; d0 < 8; ++d0) { const char* a = kb[d0 & 3] + (d0 >> 2) * 128;
        bf16x8 b0 = *reinterpret_cast<const bf16x8*>(a);
        bf16x8 b1 = *reinterpret_cast<const bf16x8*>(a + 32 * 256);
        p0 = __builtin_amdgcn_mfma_f32_32x32x16_bf16(b0, qr[d0], p0, 0, 0, 0);
        p1 = __builtin_amdgcn_mfma_f32_32x32x16_bf16(b1, qr[d0], p1, 0, 0, 0); }
}
template <int VB>
__device__ __forceinline__ void pv_tile(f32x16* o, int vb0, bf16x8 pa0, bf16x8 pa1, bf16x8 pa2, bf16x8 pa3) {
#define TRRD(dst, off) asm volatile("ds_read_b64_tr_b16 %0, %1 offset:%2" : "=&v"(dst) : "v"(vb0), "i"(off) : "memory")
#define PV_D0(d0) do { s16x4 l0, l1, l2, l3, h0, h1, h2, h3; constexpr int b_ = VB * SHM_V + v_rd_off(d0, 0, 0); \
        TRRD(l0, b_); TRRD(h0, b_ + 2048); TRRD(l1, b_ + 4096); TRRD(h1, b_ + 6144); TRRD(l2, b_ + 8192); TRRD(h2, b_ + 10240); TRRD(l3, b_ + 12288); TRRD(h3, b_ + 14336); \
        asm volatile("s_waitcnt lgkmcnt(0)" ::: "memory"); SBAR();   \
        o[d0] = __builtin_amdgcn_mfma_f32_32x32x16_bf16(pa0, (bf16x8){l0[0], l0[1], l0[2], l0[3], h0[0], h0[1], h0[2], h0[3]}, o[d0], 0, 0, 0);   \
        o[d0] = __builtin_amdgcn_mfma_f32_32x32x16_bf16(pa1, (bf16x8){l1[0], l1[1], l1[2], l1[3], h1[0], h1[1], h1[2], h1[3]}, o[d0], 0, 0, 0);   \
        o[d0] = __builtin_amdgcn_mfma_f32_32x32x16_bf16(pa2, (bf16x8){l2[0], l2[1], l2[2], l2[3], h2[0], h2[1], h2[2], h2[3]}, o[d0], 0, 0, 0);   \
        o[d0] = __builtin_amdgcn_mfma_f32_32x32x16_bf16(pa3, (bf16x8){l3[0], l3[1], l3[2], l3[3], h3[0], h3[1], h3[2], h3[3]}, o[d0], 0, 0, 0); } while (0)
    PV_D0(0); PV_D0(1); PV_D0(2); PV_D0(3);
#undef PV_D0
#undef TRRD
}
struct Blk { const bf16_t* Q; const bf16_t* K; const bf16_t* V; const bf16_t* K0; const bf16_t* V0; bf16_t* O; int P0; int mode; float s2; };
struct Seam { bf16x8 qr[8]; bf16x8 st_v0, st_v1, st_k0, st_k1; };
#define ROW(p, k0, rr) ((p) + (size_t)((k0) + (rr)) * D + sc)
#define VMW() asm volatile("s_waitcnt vmcnt(0)" ::: "memory")
#define VMWN(n) asm volatile("s_waitcnt vmcnt(%0)" :: "i"(n) : "memory")
#define SLOAD_H(Kp, Vp, k0) do { S.st_v0 = load8(ROW(Vp, k0, sr)); S.st_v1 = load8(ROW(Vp, k0, 32 + sr));              \
                         S.st_k0 = load8(ROW(Kp, k0, sr)); S.st_k1 = load8(ROW(Kp, k0, 32 + sr)); } while (0)
#define SWRITE_HK(bf) do { *(bf16x8*)(K_lds + (bf) * SHM_K + kws) = S.st_k0; *(bf16x8*)(K_lds + (bf) * SHM_K + kws + 32 * 256) = S.st_k1; } while (0)
#define SWRITE_HV(bf) do { *(bf16x8*)(V_lds + (bf) * SHM_V + vst0) = S.st_v0; *(bf16x8*)(V_lds + (bf) * SHM_V + vst1) = S.st_v1; } while (0)
#define SWRITE_H(bf) do { SWRITE_HV(bf); SWRITE_HK(bf); } while (0)
__device__ __forceinline__ void attn_prime(const Blk& cur, char* lds, Seam& S, const int tid) {
    const int wid = __builtin_amdgcn_readfirstlane(tid >> 6), lane = tid & 63, r32 = lane & 31, hi = lane >> 5;
    for (int d0 = 0; d0 < 8; ++d0) S.qr[d0] = load8(cur.Q + (size_t)(wid * QBLK + r32) * D + d0 * 16 + hi * 8);
}
__device__ __forceinline__ void attn_block(const Blk& cur, const bf16_t* nxtQ, char* lds, Seam& S, float lam, float* scrT, const bf16_t* OAb, float* SSQAb, const int tid, const int j_lo) {
    const int wid = __builtin_amdgcn_readfirstlane(tid >> 6), lane = tid & 63, r32 = lane & 31, hi = lane >> 5;
    const int NT = (cur.P0 + QB - 1) / KVBLK + 1 - j_lo;
    const int qlo = cur.P0 + wid * QBLK;
    const int qt4 = qlo + r32 - 4 * hi;
    const bool isdiff = cur.mode != 0;
    char* V_lds = lds; char* K_lds = lds + 2 * SHM_V;
    float* ws = (float*)(lds + LDS_WS) + wid * 64; float* li_l = ws, * al_l = ws + 32;
    float m_reg = ((const float*)(lds + LDS_TAB))[qlo + r32] - 226.27417f, l_reg = 0; f32x16 o[4] = {};
    const int sr = tid >> 4, sc = (tid & 15) * 8, vst0 = v_st(sr, sc), vst1 = v_st(32 + sr, sc), kws = KSWZ(sr, sc * 2);
    const int vb0 = (int)(uintptr_t)V_lds + v_rd_base(lane);
    const bf16_t* Kh = cur.K; const bf16_t* Vh = cur.V;
#define RESC(a) do { if (__any((a) < 1.f)) { if (hi == 0) al_l[r32] = (a); asm volatile("s_waitcnt lgkmcnt(0)" ::: "memory");              \
                     for (int d_ = 0; d_ < 4; ++d_) for (int r = 0; r < 16; ++r) o[d_][r] *= al_l[crow(r, hi)]; } } while (0)
#define KBASE(t) ((j_lo + (t)) * KVBLK)
#define BIAS(P0_, P1_, t) do { int h_ = hi; asm volatile("" : "+v"(h_)); const float* tb_ = (const float*)(lds + LDS_TAB) + (4 * h_ + KBASE(t));         \
        _Pragma("unroll") for (int i_ = 0; i_ < 4; ++i_) { const f32x4 b0_ = *(const f32x4*)(tb_ + 8 * i_), b1_ = *(const f32x4*)(tb_ + 32 + 8 * i_); \
            _Pragma("unroll") for (int j_ = 0; j_ < 4; ++j_) { P0_[4 * i_ + j_] += b0_[j_]; P1_[4 * i_ + j_] += b1_[j_]; } } } while (0)
#define MASKT(P0_, P1_, t) do { const int kb_ = KBASE(t); BIAS(P0_, P1_, t); if (kb_ + KVBLK - 1 > qlo || kb_ == 0) { int q_ = qt4; asm volatile("" : "+v"(q_)); const int qt_ = q_ + 4 * hi, qe_ = isdiff ? (qt_ | 63) : qt_;      \
            mask_tile(P0_, P1_, qe_ - kb_ - 4 * hi, q_ - kb_, (unsigned)(qe_ - 47), cur.s2); } } while (0)
#define SEAM_K0() do { VMWN(8); SWRITE_HK(0); SBAR(); } while (0)
    f32x16 pA0, pA1, pB0, pB1; float mnA, mnB, alA, alB; bf16x8 pa0, pa1, pa2, pa3; bool skA, skB;
    { const bf16_t* kp = j_lo == 0 ? cur.K0 : Kh + (size_t)j_lo * KVBLK * D; const bf16_t* vp = j_lo == 0 ? cur.V0 : Vh + (size_t)j_lo * KVBLK * D;
      SLOAD_H(kp, vp, 0); VMW(); SWRITE_H(0); SBAR(); }
    if (NT > 1) { SLOAD_H(Kh, Vh, KBASE(1)); }
    __syncthreads();
    SBAR(); qkt<0>(pA0, pA1, K_lds, r32, hi, S.qr);
    MASKT(pA0, pA1, 0); partialSM(pA0, pA1, m_reg, mnA, alA, skA);
    if (NT > 1) { VMW(); SWRITE_H(1); }
    __syncthreads();
#define HALF_STEP(PX0, PX1, mnX, alX, skX, PY0, PY1, alY, skY, t, KB, VB, SB_) do {                                                      \
        SBAR(); qkt<KB>(PX0, PX1, K_lds, r32, hi, S.qr);                                             \
        if (!(skY)) finishSM(PY0, PY1, alY, l_reg, pa0, pa1, pa2, pa3); SBAR();                                               \
        if ((t) + 1 < NT) { SLOAD_H(Kh, Vh, KBASE((t) + 1)); SBAR(); }                                               \
        if (!(skY)) pv_tile<VB>(o, vb0, pa0, pa1, pa2, pa3); MASKT(PX0, PX1, (t)); partialSM(PX0, PX1, m_reg, mnX, alX, skX);                                        \
        __syncthreads();                                                                                                      \
        if ((t) + 1 < NT) { VMW(); SWRITE_H(SB_); }                                                                          \
        RESC(alX); __syncthreads(); } while (0)
    for (int t = 1; t + 1 < NT; t += 2) {
        HALF_STEP(pB0, pB1, mnB, alB, skB, pA0, pA1, alA, skA, t, 1, 0, 0);
        HALF_STEP(pA0, pA1, mnA, alA, skA, pB0, pB1, alB, skB, t + 1, 0, 1, 1);
    }
    const bool even = (NT & 1) == 0;
    if (even) { SBAR(); qkt<1>(pB0, pB1, K_lds, r32, hi, S.qr); SBAR(); }
    { int t2 = tid; asm volatile("" : "+v"(t2));
      const int l2 = t2 & 63;
      const unsigned qoff = (unsigned)((wid * QBLK + (l2 & 31)) * D + (l2 >> 5) * 8);
#pragma unroll
      for (int d0 = 0; d0 < 8; ++d0) S.qr[d0] = load8(nxtQ + qoff + d0 * 16); }
    SBAR();
    if (!skA) finishSM(pA0, pA1, alA, l_reg, pa0, pa1, pa2, pa3); SBAR();
    if (!skA) pv_tile<0>(o, vb0, pa0, pa1, pa2, pa3);
    if (even) { MASKT(pB0, pB1, NT - 1); partialSM(pB0, pB1, m_reg, mnB, alB, skB); __syncthreads(); RESC(alB);
        if (!skB) { finishSM(pB0, pB1, alB, l_reg, pa0, pa1, pa2, pa3); SBAR(); pv_tile<1>(o, vb0, pa0, pa1, pa2, pa3); } }
    SBAR();
    int ln = lane; asm volatile("" : "+v"(ln));
    const int r32e = ln & 31;
    if (hi == 0) li_l[r32] = l_reg; asm volatile("s_waitcnt lgkmcnt(0)" ::: "memory");
    float rli[16];
#pragma unroll
    for (int r = 0; r < 16; ++r) rli[r] = __builtin_amdgcn_rcpf(li_l[crow(r, hi)]);
    const int mode = cur.mode;
    if (mode == 0) {
        bf16_t* Ow = cur.O + (size_t)(wid * QBLK) * 1024;
#pragma unroll
        for (int r = 0; r < 16; ++r) { const int orow = crow(r, hi);
#pragma unroll
            for (int d0 = 0; d0 < 4; ++d0) { const float v = o[d0][r] * rli[r]; const float vn = __shfl_xor(v, 1);
                if ((r32e & 1) == 0) *(unsigned*)(Ow + (orow * 1024 + d0 * 32 + r32e)) = cvtpk(v, vn); } }
    } else if (mode == 1) {
        float* T = scrT + (wid * 4096 + ln);
#pragma unroll
        for (int r = 0; r < 16; ++r)
#pragma unroll
            for (int d0 = 0; d0 < 4; ++d0) T[(r * 4 + d0) * 64] = o[d0][r] * rli[r];
    } else {
        const float* T = scrT + (wid * 4096 + ln);
        bf16_t* Ow = cur.O + (size_t)(wid * QBLK) * 1024; const size_t oo = (size_t)(cur.O - OAb); float* SSw = SSQAb + (oo >> 10) * 8 + ((oo >> 7) & 7) + (wid * QBLK) * 8;
#pragma unroll
        for (int r = 0; r < 16; ++r) { const int orow = crow(r, hi); float ss = 0.f;
#pragma unroll
            for (int d0 = 0; d0 < 4; ++d0) { const float v = __hip_atomic_load(T + (r * 4 + d0) * 64, __ATOMIC_RELAXED, __HIP_MEMORY_SCOPE_AGENT) - lam * (o[d0][r] * rli[r]); ss += v * v;
                const float vn = __shfl_xor(v, 1);
                if ((r32e & 1) == 0) *(unsigned*)(Ow + (orow * 1024 + d0 * 32 + r32e)) = cvtpk(v, vn); }
            ss += __shfl_xor(ss, 1); ss += __shfl_xor(ss, 2); ss += __shfl_xor(ss, 4); ss += __shfl_xor(ss, 8); ss += __shfl_xor(ss, 16);
            if (r32e == 0) SSw[orow * 8] = ss; }
    }
    __syncthreads();
#undef RESC
#undef KBASE
#undef BIAS
#undef MASKT
#undef SEAM_K0
#undef HALF_STEP
}
#undef ROW
#undef VMW
#undef VMWN
#undef SLOAD_H
#undef SWRITE_HK
#undef SWRITE_HV
#undef SWRITE_H
}

__device__ __forceinline__ float metak2(const bf16_t* K0, int k) {
    if (k < VPAD) return 0.f;
    float a = 0.f;
    for (int q = 0; q < 16; ++q) { f32x4 x0, x1; unpack8(*(const u32x4*)(K0 + (size_t)k * 128 + q * 8), x0, x1); a += (x0[0] * x0[0] + x0[1] * x0[1]) + (x0[2] * x0[2] + x0[3] * x0[3]) + (x1[0] * x1[0] + x1[1] * x1[1]) + (x1[2] * x1[2] + x1[3] * x1[3]); }
    return a;
}
struct Params { const float* in[18]; float* out; unsigned char* ws; int ph_lo, ph_hi; };

__device__ __forceinline__ void transpose_job(const float* __restrict__ src, int ld, int col0, int nN, int Kdim, bf16_t* __restrict__ dst, int up, const float* __restrict__ scale, float* tile, const int tid) {
    const int nK = Kdim / 64, total = nK * nN;
    f32x4 v[2];
    int t = blockIdx.x;
    if (t < total) { const int k0 = (t / nN) * 64, n0 = (t % nN) * 64;
#pragma unroll
        for (int i = 0; i < 2; ++i) { const int idx = tid + 512 * i, kk = idx >> 4, c4 = idx & 15; v[i] = *(const f32x4*)(src + (size_t)(k0 + kk) * ld + col0 + n0 + c4 * 4) * (scale ? scale[k0 + kk] : 1.0f); } }
    for (; t < total; t += gridDim.x) {
        const int k0 = (t / nN) * 64, n0 = (t % nN) * 64;
#pragma unroll
        for (int i = 0; i < 2; ++i) { const int idx = tid + 512 * i, kk = idx >> 4, c4 = idx & 15;
#pragma unroll
            for (int j = 0; j < 4; ++j) tile[kk * 65 + c4 * 4 + j] = v[i][j]; }
        const int tn = t + gridDim.x;
        if (tn < total) { const int k1 = (tn / nN) * 64, n1 = (tn % nN) * 64;
#pragma unroll
            for (int i = 0; i < 2; ++i) { const int idx = tid + 512 * i, kk = idx >> 4, c4 = idx & 15; v[i] = *(const f32x4*)(src + (size_t)(k1 + kk) * ld + col0 + n1 + c4 * 4) * (scale ? scale[k1 + kk] : 1.0f); } }
        __syncthreads();
        { const int n = tid >> 3, kc = (tid & 7) * 8; f32x4 a, b;
#pragma unroll
            for (int j = 0; j < 4; ++j) { a[j] = tile[(kc + j) * 65 + n]; b[j] = tile[(kc + 4 + j) * 65 + n]; }
            const int drow = (up < 0) ? (n0 + n) : (256 * (n0 >> 7) + (n0 & 127) + up * 128 + n);
            *(u32x4*)(dst + (size_t)drow * Kdim + k0 + kc) = pack8u(a, b); }
        __syncthreads();
    }
}

__global__ void __launch_bounds__(512, 2) fwd_kernel(Params p) {
    extern __shared__ __attribute__((aligned(16))) unsigned char lds[];
    __builtin_assume(__builtin_amdgcn_workitem_id_y() == 0); __builtin_assume(__builtin_amdgcn_workitem_id_z() == 0);
    cg::grid_group grid = cg::this_grid();
    const int wid = __builtin_amdgcn_readfirstlane(threadIdx.x >> 6), G = gridDim.x, bx = blockIdx.x;
    unsigned char* ws = p.ws;
    bf16_t* W1T = (bf16_t*)(ws + WS_W1T); bf16_t* WAT = (bf16_t*)(ws + WS_WAT); bf16_t* WFT = (bf16_t*)(ws + WS_WFT); bf16_t* WOT = (bf16_t*)(ws + WS_WOT);
    bf16_t* W5T = (bf16_t*)(ws + WS_W5T); bf16_t* WDT = (bf16_t*)(ws + WS_WDT);
    bf16_t* XB = (bf16_t*)(ws + WS_RA); bf16_t* OA = (bf16_t*)(ws + WS_RA); bf16_t* OF = (bf16_t*)(ws + WS_RA + (size_t)M * 1024 * 2); bf16_t* H1B = (bf16_t*)(ws + WS_RA);
    bf16_t* QKV = (bf16_t*)(ws + WS_RB); float* TMP = (float*)(ws + WS_RB); bf16_t* MERGED = (bf16_t*)(ws + WS_RB + (size_t)M * DM * 4); bf16_t* ACT = (bf16_t*)(ws + WS_RB);
    bf16_t* GATES = (bf16_t*)(ws + WS_RG);
    float* RSTD1 = (float*)(ws + WS_RSTD1); float* SSQ2 = (float*)(ws + WS_SSQ2); float* SSQ3 = (float*)(ws + WS_SSQ3);
    float* LOGF = (float*)(ws + WS_LOGF); float* CUM = (float*)(ws + WS_CUM); float* KSQ = (float*)(ws + WS_KSQ); float* SSQA = (float*)(ws + WS_SSQA);
    const int lo = p.ph_lo, hi_ = p.ph_hi;
#define IN(k) (lo <= (k) && (k) < hi_)
#define SEAM(k) do { if (IN(k) && IN((k) + 1)) grid.sync(); } while (0)

    for (int rep_ = 0; rep_ < (REP_PHASE == 0 ? 2 : 1); ++rep_) if (IN(0)) {
        if (rep_) grid.sync();
        const int lane = fresh_lane(), tid = wid * 64 + lane;
        float* tile = (float*)lds;
        const float* w_in = p.in[3];
        transpose_job(w_in, NINC, 0, 96, DM, W1T, -1, p.in[2], tile, tid);
        transpose_job(w_in, NINC, 6152, 64, DM, W1T + (size_t)6144 * DM, -1, p.in[2], tile, tid);
        transpose_job(p.in[10], DM, 0, 32, 1024, WAT, -1, nullptr, tile, tid);
        transpose_job(p.in[11], DM, 0, 32, 1024, WFT, -1, nullptr, tile, tid);
        transpose_job(p.in[12], DM, 0, 32, DM, WOT, -1, nullptr, tile, tid);
        transpose_job(p.in[14], DFF, 0, 88, DM, W5T, 0, p.in[13], tile, tid);
        transpose_job(p.in[15], DFF, 0, 88, DM, W5T, 1, p.in[13], tile, tid);
        transpose_job(p.in[16], DM, 0, 32, DFF, WDT, -1, nullptr, tile, tid);
        float* WF = (float*)lds;
        for (int k = tid; k < DM; k += 512) { const float g = p.in[2][k]; const f32x4 a = *(const f32x4*)(w_in + (size_t)k * NINC + 6144), b = *(const f32x4*)(w_in + (size_t)k * NINC + 6148);
#pragma unroll
            for (int j = 0; j < 4; ++j) { WF[j * DM + k] = a[j] * g; WF[(4 + j) * DM + k] = b[j] * g; } }
        __syncthreads();
        const float* x = p.in[0]; const float* meta = p.in[1]; const float* b_f = p.in[9];
        for (int job = bx * 8 + wid; job < M + NMETA; job += G * 8) {
            const bool ismeta = job >= M; const int row = ismeta ? job + VPAD : job;
            const float* src = ismeta ? meta + (size_t)(job - M) * DM : x + (size_t)job * DM;
            f32x4 v[8]; float ss = 0.f; float zf[8];
#pragma unroll
            for (int j = 0; j < 8; ++j) zf[j] = 0.f;
#pragma unroll
            for (int i = 0; i < 8; ++i) { v[i] = *(const f32x4*)(src + i * 256 + lane * 4);
                ss += (v[i][0] * v[i][0] + v[i][1] * v[i][1]) + (v[i][2] * v[i][2] + v[i][3] * v[i][3]); }
#pragma unroll
            for (int i = 0; i < 8; ++i) {
                u32x2 w; w.x = pg8::cvt_pk_bf16(v[i][0], v[i][1]); w.y = pg8::cvt_pk_bf16(v[i][2], v[i][3]);
                *(u32x2*)(XB + (size_t)row * DM + i * 256 + lane * 4) = w;
#pragma unroll
                for (int j = 0; j < 8; ++j) { const f32x4 wv = *(const f32x4*)(WF + j * DM + i * 256 + lane * 4); zf[j] += (v[i][0] * wv[0] + v[i][1] * wv[1]) + (v[i][2] * wv[2] + v[i][3] * wv[3]); } }
            ss = wave_sum(ss);
#pragma unroll
            for (int j = 0; j < 8; ++j) zf[j] = wave_sum(zf[j]);
            const float rs = __builtin_amdgcn_rsqf(ss * (1.0f / 2048.0f) + 1e-6f);
            if (lane == 0) RSTD1[row] = rs;
            if (lane < 8 && !ismeta) { SSQ2[(size_t)lane * M + row] = 0.f; SSQ3[(size_t)lane * M + row] = 0.f; }
            if (lane < 8) { float zz = zf[0];
#pragma unroll
                for (int j = 1; j < 8; ++j) zz = (lane == j) ? zf[j] : zz;
                const float y = zz * rs + b_f[lane];
                const float lf = fminf(y, 0.f) - log1pf(__expf(-fabsf(y)));
                if (!ismeta) { const int b = job >> 13, t = job & (SEQ - 1); LOGF[(size_t)(b * 8 + lane) * LB + 64 + t] = lf; }
                else { const int vp = VPAD + (job - M);
#pragma unroll
                    for (int b = 0; b < NBATCH; ++b) LOGF[(size_t)(b * 8 + lane) * LB + vp] = lf; } }
        }
        for (int i = bx * 512 + tid; i < 16 * MQ; i += G * 512) KSQ[i] = 0.f;
        if (bx == 0 && tid == 0) *(unsigned*)(ws + WS_QCTR) = 0u;
        if (bx == 0) for (int i = tid; i < 32 * VPAD; i += 512) LOGF[(size_t)(i / VPAD) * LB + (i % VPAD)] = 0.f;
        __syncthreads();
    }
    SEAM(0);

    for (int rep_ = 0; rep_ < (REP_PHASE == 1 ? 2 : 1); ++rep_) if (IN(1)) {
        if (rep_) grid.sync();
        const int lane = fresh_lane(), tid = wid * 64 + lane;
        if (bx < 32) {
            const float* srcp = LOGF + (size_t)bx * LB; float* dstp = CUM + (size_t)bx * LB; float* red = (float*)lds;
            const int i0 = tid * 17; float vals[17]; float s = 0.f;
#pragma unroll
            for (int i = 0; i < 17; ++i) { const int k = i0 + i; vals[i] = k < LB ? srcp[k] : 0.f; s += vals[i]; vals[i] = s; }
            float incl = s;
#pragma unroll
            for (int o = 1; o < 64; o <<= 1) { const float t = __shfl_up(incl, o); if (lane >= o) incl += t; }
            if (lane == 63) red[wid] = incl;
            __syncthreads();
            float base = incl - s;
            for (int w = 0; w < wid; ++w) base += red[w];
#pragma unroll
            for (int i = 0; i < 17; ++i) { const int k = i0 + i; if (k < LB) dstp[k] = (base + vals[i]) * 11.313708498984761f; }
            __syncthreads();
        }
        {
            bf16_t* xm = (bf16_t*)lds;
            for (int i = tid; i < 16 * 256; i += 512) *(u32x4*)(xm + (size_t)i * 8) = *(const u32x4*)(XB + (size_t)(M + VPAD) * DM + (size_t)i * 8);
            { const int i = bx * 512 + tid; if (i < 32 * VPAD * 16) { const int sl = i / (VPAD * 16), r = (i / 16) % VPAD, ch = i % 16; const int hd = sl < 16 ? 8 + sl : 16 + sl;
                *(u32x4*)(QKV + ((size_t)hd * MQ + M + r) * 128 + ch * 8) = (u32x4){0u, 0u, 0u, 0u}; } }
            __syncthreads();
            for (int c0 = bx * 16; c0 < 4096; c0 += G * 16) {
#pragma unroll 1
                for (int cc = 0; cc < 2; ++cc) { const int c = c0 + wid * 2 + cc, sl = c >> 7, hd = sl < 16 ? 8 + sl : 16 + sl, n = hd * 128 + (c & 127);
                    f32x4 wa[8];
#pragma unroll
                    for (int q = 0; q < 4; ++q) unpack8(*(const u32x4*)(W1T + (size_t)n * DM + lane * 32 + q * 8), wa[2 * q], wa[2 * q + 1]);
                    float mine = 0.f;
#pragma unroll 1
                    for (int j = 0; j < 16; ++j) { float a = 0.f;
#pragma unroll
                        for (int q = 0; q < 4; ++q) { f32x4 x0, x1; unpack8(*(const u32x4*)(xm + (size_t)j * DM + lane * 32 + q * 8), x0, x1);
                            a += (x0[0] * wa[2 * q][0] + x0[1] * wa[2 * q][1]) + (x0[2] * wa[2 * q][2] + x0[3] * wa[2 * q][3]) + (x1[0] * wa[2 * q + 1][0] + x1[1] * wa[2 * q + 1][1]) + (x1[2] * wa[2 * q + 1][2] + x1[3] * wa[2 * q + 1][3]); }
                        a = wave_sum(a); mine = (lane == j) ? a : mine; }
                    if (lane < 16) { const float v = mine * RSTD1[M + VPAD + lane]; QKV[((size_t)hd * MQ + M + VPAD + lane) * 128 + (c & 127)] = (bf16_t)(pg8::cvt_pk_bf16(v, v) & 0xffffu); } }
            }
            __syncthreads();
        }
        pg8::Gemm g{XB, W1T, M, N1, DM}; pg8::StaticOrder S; S.init(M, N1, G, bx);
        Epi1 E{QKV, GATES, RSTD1, KSQ};
        pg8::gemm_phase<Epi1, pg8::StaticOrder>((PG8_LAS unsigned char*)lds, g, S, E, wid * 64 + fresh_lane());
    }
    SEAM(1);

    for (int rep_ = 0; rep_ < (REP_PHASE == 2 ? 2 : 1); ++rep_) if (IN(2)) {
        if (rep_) grid.sync();
        const int lane = fresh_lane(), tid = wid * 64 + lane;
        float lam;
        { const float* q1 = p.in[4]; const float* k1 = p.in[5]; const float* q2 = p.in[6]; const float* k2 = p.in[7];
          float s1 = q1[lane] * k1[lane] + q1[lane + 64] * k1[lane + 64], s2 = q2[lane] * k2[lane] + q2[lane + 64] * k2[lane + 64];
          s1 = wave_sum(s1); s2 = wave_sum(s2); lam = __expf(s1) - __expf(s2) + 0.2f; lam = __uint_as_float(__builtin_amdgcn_readfirstlane(__float_as_uint(lam))); }
        float* scrT = (float*)(ws + WS_SCR + (size_t)bx * 262144);
        float* tabw = (float*)(lds + att::LDS_TAB);
        constexpr int NITEM = 2048, NDIFF = 1024;
        unsigned* qctr = (unsigned*)(ws + WS_QCTR);
        float* red = (float*)(lds + att::LDS_TAB + 8256 * 4);
        auto grab = [&]() -> int { if (wid == 0 && fresh_lane() == 0) red[16] = __uint_as_float(atomicAdd(qctr, 1u)); __syncthreads();
                                   const int v = __builtin_amdgcn_readfirstlane((int)__float_as_uint(red[16])); __syncthreads(); return v; };
        auto desc = [&](int item, int ps) -> att::Blk {
            att::Blk r;
            if (item >= NDIFF) { const int j = item - NDIFF, h = j >> 7, b = (j >> 5) & 3, qb = 31 - (j & 31);
                const size_t rb = (size_t)b * SEQ + 256 * qb; r.P0 = 64 + 256 * qb; r.mode = 0; r.s2 = 0.f;
                r.Q = QKV + ((size_t)(24 + h) * MQ + rb) * 128; r.K = QKV + ((size_t)(32 + h) * MQ + (size_t)b * SEQ) * 128 - 64 * 128; r.V = QKV + ((size_t)(40 + h) * MQ + (size_t)b * SEQ) * 128 - 64 * 128;
                r.K0 = QKV + ((size_t)(32 + h) * MQ + M) * 128; r.V0 = QKV + ((size_t)(40 + h) * MQ + M) * 128;
                r.O = OF + rb * 1024 + h * 128; }
            else { const int h = 3 - (item >> 8), b = (item >> 6) & 3, qb = 31 - ((item >> 1) & 31), e = item & 1, c = ps;
                const size_t rb = (size_t)b * SEQ + 256 * qb; r.P0 = 64 + 256 * qb; r.mode = 1 + c;
                r.s2 = 2.0f * 11.313708498984761f * (h == 0 ? 0.25f : h == 1 ? 0.0625f : h == 2 ? 0.015625f : 0.00390625f);
                r.Q = QKV + ((size_t)(2 * h + c) * MQ + rb) * 128; r.K = QKV + ((size_t)(8 + 2 * h + c) * MQ + (size_t)b * SEQ) * 128 - 64 * 128; r.V = QKV + ((size_t)(16 + 2 * h + e) * MQ + (size_t)b * SEQ) * 128 - 64 * 128;
                r.K0 = QKV + ((size_t)(8 + 2 * h + c) * MQ + M) * 128; r.V0 = QKV + ((size_t)(16 + 2 * h + e) * MQ + M) * 128;
                r.O = OA + rb * 1024 + h * 256 + e * 128; }
            return r; };
        int item = grab();
        if (item < NITEM) {
            att::Seam S;
            { const att::Blk first = desc(item, 0); att::attn_prime(first, (char*)lds, S, wid * 64 + fresh_lane()); }
            while (item < NITEM) {
              const int item_next = grab();
              const int np = item < NDIFF ? 2 : 1;
              for (int ps = 0; ps < np; ++ps) {
                const att::Blk cur = desc(item, ps);
                const bf16_t* nxtQ = (ps + 1 < np) ? desc(item, ps + 1).Q : (item_next < NITEM ? desc(item_next, 0).Q : cur.Q);
                const int tt = wid * 64 + fresh_lane(), ln_ = tt & 63;
                float km = 0.f;
                { const int nk = cur.P0 + 256;
                  if (item >= NDIFF) { const int j = item - NDIFF, h = j >> 7, b = (j >> 5) & 3; const float* cm = CUM + (size_t)(b * 8 + h) * LB; const float cref = cm[cur.P0];
                      const float* kq = KSQ + (size_t)(8 + h) * MQ;
                      for (int k = tt; k < nk; k += 512) { tabw[k] = cref - cm[k]; km = fmaxf(km, k < 64 ? metak2(cur.K0, k) : kq[b * SEQ + k - 64]); } }
                  else { const int h = 3 - (item >> 8), b = (item >> 6) & 3, c = ps; const float sl = 0.5f * cur.s2; const float* kq = KSQ + (size_t)(2 * h + c) * MQ;
                      for (int k = tt; k < nk; k += 512) { tabw[k] = sl * (float)(k - cur.P0); km = fmaxf(km, k < 64 ? metak2(cur.K0, k) : kq[b * SEQ + k - 64]); } } }
                float qs = 0.f;
#pragma unroll
                for (int d0 = 0; d0 < 8; ++d0) { f32x4 a, b2; unpack8(*reinterpret_cast<const u32x4*>(&S.qr[d0]), a, b2); qs += (a[0] * a[0] + a[1] * a[1]) + (a[2] * a[2] + a[3] * a[3]) + (b2[0] * b2[0] + b2[1] * b2[1]) + (b2[2] * b2[2] + b2[3] * b2[3]); }
                qs += __shfl_xor(qs, 32);
#pragma unroll
                for (int o = 32; o >= 1; o >>= 1) { qs = fmaxf(qs, __shfl_xor(qs, o)); km = fmaxf(km, __shfl_xor(km, o)); }
                if (ln_ == 0) { red[wid] = qs; red[8 + wid] = km; }
                __syncthreads();
                int j_lo;
                { float q2 = red[0], k2 = red[8];
#pragma unroll
                  for (int w = 1; w < 8; ++w) { q2 = fmaxf(q2, red[w]); k2 = fmaxf(k2, red[8 + w]); }
                  const float Bnd = sqrtf(q2 * k2) * 1.05f + 1.0f; const float thr = -(1176.3f + 226.3f + Bnd);
                  int lo_ = 0, hi_2 = (cur.P0 + 255) / 64;
                  while (lo_ < hi_2) { const int mid = (lo_ + hi_2) >> 1; if (tabw[64 * mid + 63] < thr) lo_ = mid + 1; else hi_2 = mid; }
                  j_lo = __builtin_amdgcn_readfirstlane(lo_); }
                att::attn_block(cur, nxtQ, (char*)lds, S, lam, scrT, OA, SSQA, wid * 64 + fresh_lane(), j_lo);
              }
              item = item_next;
            }
        }
        asm volatile("s_waitcnt vmcnt(0)" ::: "memory");
        __syncthreads();
        grid.sync();
        { const int ln2 = fresh_lane(), h = ln2 >> 4; const float* g_subln = p.in[8];
          f32x4 gq[4];
#pragma unroll
          for (int q = 0; q < 4; ++q) gq[q] = *(const f32x4*)(g_subln + (ln2 & 15) * 16 + q * 4) * 0.8f;
          for (int row = bx * 8 + wid; row < M; row += G * 8) {
              const float rn = __builtin_amdgcn_rsqf((SSQA[(size_t)row * 8 + 2 * h] + SSQA[(size_t)row * 8 + 2 * h + 1]) * (1.0f / 256.0f) + 1e-5f);
              bf16_t* d = OA + (size_t)row * 1024 + ln2 * 16;
              f32x4 a0, a1, a2, a3; unpack8(*(const u32x4*)d, a0, a1); unpack8(*(const u32x4*)(d + 8), a2, a3);
              *(u32x4*)d = pack8u(a0 * rn * gq[0], a1 * rn * gq[1]); *(u32x4*)(d + 8) = pack8u(a2 * rn * gq[2], a3 * rn * gq[3]); } }
    }
    SEAM(2);

    for (int rep_ = 0; rep_ < (REP_PHASE == 3 ? 2 : 1); ++rep_) if (IN(3)) {
        if (rep_) grid.sync();
        { pg8::Gemm g{OA, WAT, M, DM, 1024}; pg8::StaticOrder S; S.init(M, DM, G, bx); Epi3a E{TMP, GATES};
          pg8::gemm_phase<Epi3a, pg8::StaticOrder>((PG8_LAS unsigned char*)lds, g, S, E, wid * 64 + fresh_lane()); }
        { pg8::Gemm g{OF, WFT, M, DM, 1024}; pg8::StaticOrder S; S.init(M, DM, G, bx); Epi3b E{TMP, GATES, MERGED};
          pg8::gemm_phase<Epi3b, pg8::StaticOrder>((PG8_LAS unsigned char*)lds, g, S, E, wid * 64 + fresh_lane()); }
    }
    SEAM(3);

    if (IN(4)) {
        pg8::Gemm g{MERGED, WOT, M, DM, DM}; pg8::StaticOrder S; S.init(M, DM, G, bx); Epi4 E{p.in[0], p.out, H1B, SSQ2};
        pg8::gemm_phase<Epi4, pg8::StaticOrder>((PG8_LAS unsigned char*)lds, g, S, E, wid * 64 + fresh_lane());
    }
    SEAM(4);

    for (int rep_ = 0; rep_ < (REP_PHASE == 5 ? 2 : 1); ++rep_) if (IN(5)) {
        if (rep_) grid.sync();
        pg8::Gemm g{H1B, W5T, M, N5, DM}; pg8::StaticOrder S; S.init(M, N5, G, bx); Epi5 E{SSQ2, ACT};
        pg8::gemm_phase<Epi5, pg8::StaticOrder>((PG8_LAS unsigned char*)lds, g, S, E, wid * 64 + fresh_lane());
    }
    SEAM(5);

    if (IN(6)) {
        pg8::Gemm g{ACT, WDT, M, DM, DFF}; pg8::StaticOrder S; S.init(M, DM, G, bx); Epi6 E{p.out, SSQ3};
        pg8::gemm_phase<Epi6, pg8::StaticOrder>((PG8_LAS unsigned char*)lds, g, S, E, wid * 64 + fresh_lane());
    }
    SEAM(6);

    if (IN(7)) {
        const int lane = fresh_lane();
        const float* gfin = p.in[17];
        f32x4 gv[8];
#pragma unroll
        for (int i = 0; i < 8; ++i) gv[i] = *(const f32x4*)(gfin + i * 256 + lane * 4);
        for (int orow = bx * 8 + wid; orow < NBATCH * SEQ; orow += G * 8) {
            const int row = orow;
            float sq = 0.f;
#pragma unroll
            for (int t = 0; t < 8; ++t) sq += SSQ3[(size_t)t * M + row];
            const float rs = __builtin_amdgcn_rsqf(sq * (1.0f / 2048.0f) + 1e-6f);
            float* d = p.out + (size_t)orow * DM + lane * 4;
#pragma unroll
            for (int i = 0; i < 8; ++i) { const f32x4 v = *(const f32x4*)(d + i * 256); *(f32x4*)(d + i * 256) = v * rs * gv[i]; }
        }
    }
#undef IN
#undef SEAM
}

extern "C" void kernel_launch(void* const* d_in, const int* in_sizes, int n_in, void* d_out, int out_size, void* d_ws, size_t ws_size, hipStream_t stream) {
    static int grid = 0;
    if (grid == 0) {
        if (n_in != 18 || ws_size < WS_END) { fprintf(stderr, "kernel_launch: need 18 inputs and >= %zu bytes of workspace (got %d, %zu)\n", (size_t)WS_END, n_in, ws_size); grid = -1; return; }
        int dev = 0, cus = 0, per_cu = 0;
        (void)hipGetDevice(&dev);
        if (hipDeviceGetAttribute(&cus, hipDeviceAttributeMultiprocessorCount, dev) != hipSuccess || cus <= 0) cus = 256;
        if (hipFuncSetAttribute((const void*)fwd_kernel, hipFuncAttributeMaxDynamicSharedMemorySize, LDS_BYTES) != hipSuccess) { fprintf(stderr, "kernel_launch: hipFuncSetAttribute failed\n"); }
        if (hipOccupancyMaxActiveBlocksPerMultiprocessor(&per_cu, (const void*)fwd_kernel, 512, LDS_BYTES) != hipSuccess || per_cu < 1) { fprintf(stderr, "kernel_launch: occupancy query says %d\n", per_cu); per_cu = 1; }
        (void)hipGetLastError();
        grid = cus * 1;
        if (grid > 256) grid = 256;
    }
    if (grid < 0) return;
    Params p{};
    for (int i = 0; i < 18; ++i) p.in[i] = (const float*)d_in[i];
    p.out = (float*)d_out; p.ws = (unsigned char*)d_ws;
#if ONE_LAUNCH
    p.ph_lo = 0; p.ph_hi = 8;
    void* args[] = {&p};
    hipError_t e = hipLaunchCooperativeKernel((const void*)fwd_kernel, dim3(grid), dim3(512), args, LDS_BYTES, stream);
    if (e != hipSuccess) fprintf(stderr, "cooperative launch failed: %s (grid %d)\n", hipGetErrorString(e), grid);
#else
    for (int ph = 0; ph < 8; ++ph) { p.ph_lo = ph; p.ph_hi = ph + 1; hipLaunchKernelGGL(fwd_kernel, dim3(grid), dim3(512), LDS_BYTES, stream, p); }
#endif
}
```

```cpp
#include <hip/hip_runtime.h>
#include <hip/hip_cooperative_groups.h>
#include <cstdio>
#include <cstdint>
namespace cg = cooperative_groups;

#ifndef REP_PHASE
#define REP_PHASE -1
#endif
#ifndef ONE_LAUNCH
#define ONE_LAUNCH 1
#endif

typedef unsigned short bf16_t;
typedef short bf16x8 __attribute__((ext_vector_type(8)));
typedef short s16x4 __attribute__((ext_vector_type(4)));
typedef float f32x4 __attribute__((ext_vector_type(4)));
typedef float f32x16 __attribute__((ext_vector_type(16)));
typedef unsigned u32x4 __attribute__((ext_vector_type(4)));
typedef unsigned u32x2 __attribute__((ext_vector_type(2)));

constexpr int DM = 2048, NBATCH = 4, SEQ = 8192, NMETA = 16;
constexpr int VPAD = 48;
constexpr int LB = 8256;
constexpr int M = NBATCH * SEQ;
constexpr int MQ = M + 64;
constexpr int NINC = 10248;
constexpr int N1 = 10240;
constexpr int DFF = 5632, N5 = 2 * DFF;
constexpr int NHD = 48;

constexpr size_t SZ_W1T = (size_t)N1 * DM * 2, SZ_WAT = (size_t)DM * 1024 * 2, SZ_WOT = (size_t)DM * DM * 2, SZ_W5T = (size_t)N5 * DM * 2, SZ_WDT = (size_t)DM * DFF * 2;
constexpr size_t WS_W1T = 0, WS_WAT = WS_W1T + SZ_W1T, WS_WFT = WS_WAT + SZ_WAT, WS_WOT = WS_WFT + SZ_WAT, WS_W5T = WS_WOT + SZ_WOT, WS_WDT = WS_W5T + SZ_W5T;
constexpr size_t WS_RA = WS_WDT + SZ_WDT;
constexpr size_t SZ_RA = (size_t)MQ * DM * 2;
constexpr size_t WS_RB = WS_RA + SZ_RA;
constexpr size_t SZ_RB = (size_t)NHD * MQ * 128 * 2;
constexpr size_t WS_RG = WS_RB + SZ_RB;
constexpr size_t SZ_RG = (size_t)M * 4096 * 2;
constexpr size_t WS_RSTD1 = WS_RG + SZ_RG, WS_SSQ2 = WS_RSTD1 + (size_t)MQ * 4, WS_SSQ3 = WS_SSQ2 + (size_t)M * 8 * 4;
constexpr size_t WS_LOGF = WS_SSQ3 + (size_t)M * 8 * 4, WS_CUM = WS_LOGF + (size_t)32 * LB * 4;
constexpr size_t WS_SCR = WS_CUM + (size_t)32 * LB * 4;
constexpr size_t WS_KSQ = WS_SCR + (size_t)256 * 262144;
constexpr size_t WS_QCTR = WS_KSQ + (size_t)16 * MQ * 4;
constexpr size_t WS_SSQA = WS_QCTR + 256;
constexpr size_t WS_CNT6 = WS_SSQA + (size_t)M * 8 * 4;
constexpr size_t WS_SLOT6 = WS_CNT6 + (size_t)256 * 256;
constexpr size_t WS_BAR = WS_SLOT6 + (size_t)32 * M * 4;
constexpr size_t WS_END = WS_BAR + 256;
constexpr int LDS_BYTES = 131072;

namespace pg8 {
#define PG8_LAS __attribute__((address_space(3)))
constexpr int BM = 256, BK = 64, HALF = 128, HTB = HALF * BK * 2, STAGE_BYTES = 8 * HTB, NXCD = 8, WGM = 8;
__host__ __device__ __forceinline__ int lds_byte(int r, int c) { const int st = (r >> 4) * 2 + (c >> 5), rr = r & 15, cc = c & 31, ob = rr * 64 + cc * 2; return st * 1024 + (ob ^ (((ob >> 9) & 1) << 5)); }
__host__ __device__ __forceinline__ void stage_rc(int b, int& R, int& C) { const int st = b / 1024, sb = b % 1024, swz = sb ^ (((sb >> 9) & 1) << 5); R = (st >> 1) * 16 + swz / 64; C = (st & 1) * 32 + (swz % 64) / 2; }
__host__ __device__ __forceinline__ int perm32(int rho) { const int n = rho >> 4, i = rho & 15; return 8 * (i >> 2) + 4 * n + (i & 3); }
struct Unit { int pm, pn; };
struct Gemm { const bf16_t* A; const bf16_t* Bt; int M, N, K; };
struct StaticOrder {
    int nM, nN, nwg, G, c;
    __host__ __device__ void init(int M_, int N_, int G_, int c_) { nM = M_ / BM; nN = N_ / BM; nwg = nM * nN; G = G_; c = c_; }
    __host__ __device__ bool next(int i, Unit& u) const {
        const long L = (long)i * G + c; if (L >= nwg) return false;
        int wgid = (int)L; { const int q = nwg / NXCD, r = nwg % NXCD, xcd = wgid % NXCD, off = wgid / NXCD; wgid = (xcd < r ? xcd * (q + 1) : r * (q + 1) + (xcd - r) * q) + off; }
        const int nig = WGM * nN, gid = wgid / nig, fm = gid * WGM, gsz = (nM - fm) < WGM ? (nM - fm) : WGM;
        u.pm = fm + ((wgid % nig) % gsz); u.pn = (wgid % nig) / gsz; return true;
    }
    __device__ __forceinline__ void a_ready(const Unit&) const {}
    __device__ __forceinline__ void done(const Unit&) const {}
};
__device__ __forceinline__ unsigned cvt_pk_bf16(float lo, float hi) { unsigned r; asm volatile("v_cvt_pk_bf16_f32 %0, %1, %2" : "=v"(r) : "v"(lo), "v"(hi)); return r; }

template <class Epi, class Sched>
__device__ __forceinline__ void gemm_phase(PG8_LAS unsigned char* lds, const Gemm g, const Sched& S, const Epi& E, const int tid) {
    const int wid = __builtin_amdgcn_readfirstlane(tid >> 6), lane = tid & 63, wr = wid >> 2, wc = wid & 3, fr = lane & 15, fq = lane >> 4;
    const int K = g.K, nt = K / BK;
    unsigned voffA[2], voffB[2];
#pragma unroll
    for (int i = 0; i < 2; ++i) { int R, C; stage_rc(tid * 16 + i * 8192, R, C); const int Rb = Epi::PERM ? ((R & ~31) + perm32(R & 31)) : R;
        voffA[i] = (unsigned)(R * K + C) * 2u; voffB[i] = (unsigned)(Rb * K + C) * 2u; }
    const size_t kstep = (size_t)(BK * 2);
    const size_t hstep = (size_t)HALF * K * 2;
    const size_t tstep = 2 * hstep;
    const unsigned ldsw = (unsigned)wid * 1024u;
    const int aoff = lds_byte(wr * 64 + fr, fq * 8), boff = lds_byte(wc * 32 + fr, fq * 8);
#define PG8_SA(b, h) (((b) * 2 + (h)) * HTB)
#define PG8_SB(b, h) ((4 + (b) * 2 + (h)) * HTB)
#define PG8_STAGE(bufoff, gbase, voff) do { _Pragma("unroll") for (int _i = 0; _i < 2; ++_i) \
        __builtin_amdgcn_global_load_lds((const unsigned*)((const char*)(gbase) + (voff)[_i]), (PG8_LAS unsigned*)(lds + (bufoff) + ldsw + _i * 8192), 16, 0, 0); } while (0)
#define PG8_LDA(dst, b, h) do { _Pragma("unroll") for (int m = 0; m < 4; ++m) _Pragma("unroll") for (int k = 0; k < 2; ++k) dst[m][k] = *(const PG8_LAS bf16x8*)(lds + PG8_SA(b, h) + aoff + m * 2048 + k * 1024); } while (0)
#define PG8_LDB(dst, b, h) do { _Pragma("unroll") for (int n = 0; n < 2; ++n) _Pragma("unroll") for (int k = 0; k < 2; ++k) dst[n][k] = *(const PG8_LAS bf16x8*)(lds + PG8_SB(b, h) + boff + n * 2048 + k * 1024); } while (0)
#define PG8_MMA(ai, bj, At, Bt) do { __builtin_amdgcn_s_setprio(1); _Pragma("unroll") for (int m = 0; m < 4; ++m) _Pragma("unroll") for (int n = 0; n < 2; ++n) _Pragma("unroll") for (int k = 0; k < 2; ++k) \
        acc[ai][bj][m][n] = __builtin_amdgcn_mfma_f32_16x16x32_bf16(Bt[n][k], At[m][k], acc[ai][bj][m][n], 0, 0, 0); __builtin_amdgcn_s_setprio(0); } while (0)
#define PG8_WAIT_V(n) asm volatile("s_waitcnt vmcnt(" #n ")" ::: "memory")
#define PG8_WAIT_L(n) asm volatile("s_waitcnt lgkmcnt(" #n ")" ::: "memory")
#define PG8_BAR __builtin_amdgcn_s_barrier()
#define PG8_SCHED __builtin_amdgcn_sched_barrier(0)
    Unit cur, nxt; int ui = 0;
    if (!S.next(0, cur)) return;
    f32x4 acc[2][2][4][2];
#pragma unroll
    for (int a = 0; a < 2; ++a)
#pragma unroll
        for (int b = 0; b < 2; ++b)
#pragma unroll
            for (int m = 0; m < 4; ++m)
#pragma unroll
                for (int n = 0; n < 2; ++n) acc[a][b][m][n] = (f32x4){0.f, 0.f, 0.f, 0.f};
    bf16x8 At[4][2], B0[2][2], B1[2][2];
    const char* cA = (const char*)g.A + (size_t)cur.pm * tstep; const char* cB = (const char*)g.Bt + (size_t)cur.pn * tstep;
    S.a_ready(cur);
    PG8_STAGE(PG8_SB(0, 0), cB, voffB); PG8_STAGE(PG8_SA(0, 0), cA, voffA); PG8_STAGE(PG8_SB(0, 1), cB + hstep, voffB); PG8_STAGE(PG8_SA(0, 1), cA + hstep, voffA);
    if (wr == 1) PG8_BAR;
    PG8_WAIT_V(4); PG8_BAR;
    PG8_STAGE(PG8_SB(1, 0), cB + kstep, voffB); PG8_STAGE(PG8_SA(1, 0), cA + kstep, voffA); PG8_STAGE(PG8_SB(1, 1), cB + hstep + kstep, voffB);
    PG8_WAIT_V(6); PG8_BAR;
    for (;;) {
        const bool has_next = S.next(ui + 1, nxt);
        const char* nA = has_next ? (const char*)g.A + (size_t)nxt.pm * tstep : cA; const char* nB = has_next ? (const char*)g.Bt + (size_t)nxt.pn * tstep : cB;
        for (int t = 0; t < nt; t += 2) {
            const bool last = (t == nt - 2);
            const char* a1 = cA + (size_t)(t + 1) * kstep;
            const char* a2 = last ? nA : cA + (size_t)(t + 2) * kstep; const char* b2 = last ? nB : cB + (size_t)(t + 2) * kstep;
            const char* a3 = a2 + kstep; const char* b3 = b2 + kstep;
            if (last && has_next) S.a_ready(nxt);
            PG8_LDB(B0, 0, 0); PG8_SCHED; PG8_LDA(At, 0, 0); PG8_STAGE(PG8_SA(1, 1), a1 + hstep, voffA);
            PG8_WAIT_L(8); PG8_BAR; PG8_WAIT_L(0); PG8_MMA(0, 0, At, B0); PG8_BAR; PG8_SCHED;
            PG8_LDB(B1, 0, 1); PG8_STAGE(PG8_SB(0, 0), b2, voffB);
            PG8_BAR; PG8_WAIT_L(0); PG8_MMA(0, 1, At, B1); PG8_BAR;
            PG8_LDA(At, 0, 1); PG8_STAGE(PG8_SA(0, 0), a2, voffA);
            PG8_BAR; PG8_WAIT_L(0); PG8_MMA(1, 0, At, B0); PG8_BAR; PG8_SCHED;
            PG8_STAGE(PG8_SB(0, 1), b2 + hstep, voffB);
            PG8_WAIT_V(6); PG8_BAR; PG8_MMA(1, 1, At, B1); PG8_BAR;
            PG8_LDB(B0, 1, 0); PG8_SCHED; PG8_LDA(At, 1, 0); PG8_STAGE(PG8_SA(0, 1), a2 + hstep, voffA);
            PG8_WAIT_L(8); PG8_BAR; PG8_WAIT_L(0); PG8_MMA(0, 0, At, B0); PG8_BAR; PG8_SCHED;
            PG8_LDB(B1, 1, 1); PG8_STAGE(PG8_SB(1, 0), b3, voffB);
            PG8_BAR; PG8_WAIT_L(0); PG8_MMA(0, 1, At, B1); PG8_BAR;
            PG8_LDA(At, 1, 1); PG8_STAGE(PG8_SA(1, 0), a3, voffA);
            PG8_BAR; PG8_WAIT_L(0); PG8_MMA(1, 0, At, B0); PG8_BAR; PG8_SCHED;
            PG8_STAGE(PG8_SB(1, 1), b3 + hstep, voffB);
            PG8_WAIT_V(6); PG8_BAR; PG8_MMA(1, 1, At, B1); PG8_BAR;
        }
        E(acc, cur, wr, wc, fr, fq); S.done(cur);
        if (!has_next) break;
#pragma unroll
        for (int a = 0; a < 2; ++a)
#pragma unroll
            for (int b = 0; b < 2; ++b)
#pragma unroll
                for (int m = 0; m < 4; ++m)
#pragma unroll
                    for (int n = 0; n < 2; ++n) acc[a][b][m][n] = (f32x4){0.f, 0.f, 0.f, 0.f};
        cur = nxt; cA = nA; cB = nB; ++ui;
    }
    PG8_WAIT_V(0);
    if (wr == 0) PG8_BAR;
    PG8_BAR;
#undef PG8_SA
#undef PG8_SB
#undef PG8_STAGE
#undef PG8_LDA
#undef PG8_LDB
#undef PG8_MMA
#undef PG8_WAIT_V
#undef PG8_WAIT_L
#undef PG8_BAR
#undef PG8_SCHED
}
}

__device__ __forceinline__ int fresh_lane() { int l; asm volatile("v_mbcnt_lo_u32_b32 %0, -1, 0\n\tv_mbcnt_hi_u32_b32 %0, -1, %0" : "=v"(l)); return l; }
__device__ __forceinline__ float bf2f(unsigned short b) { return __uint_as_float(((unsigned)b) << 16); }
__device__ __forceinline__ float sigmoidf_(float x) { return __builtin_amdgcn_rcpf(1.0f + __builtin_amdgcn_exp2f(-1.4426950408889634f * x)); }
__device__ __forceinline__ u32x4 pack8u(f32x4 a, f32x4 b) { u32x4 w = {pg8::cvt_pk_bf16(a[0], a[1]), pg8::cvt_pk_bf16(a[2], a[3]), pg8::cvt_pk_bf16(b[0], b[1]), pg8::cvt_pk_bf16(b[2], b[3])}; return w; }
__device__ __forceinline__ void unpack8(u32x4 w, f32x4& a, f32x4& b) {
    a = (f32x4){__uint_as_float(w.x << 16), __uint_as_float(w.x & 0xffff0000u), __uint_as_float(w.y << 16), __uint_as_float(w.y & 0xffff0000u)};
    b = (f32x4){__uint_as_float(w.z << 16), __uint_as_float(w.z & 0xffff0000u), __uint_as_float(w.w << 16), __uint_as_float(w.w & 0xffff0000u)};
}
__device__ __forceinline__ float shx(float v, int o, int ln) { return __uint_as_float((unsigned)__builtin_amdgcn_ds_bpermute((ln ^ o) << 2, (int)__float_as_uint(v))); }
__device__ __forceinline__ float wave_sum(float v) {
#pragma unroll
    for (int o = 32; o >= 1; o >>= 1) v += __shfl_xor(v, o);
    return v;
}

typedef f32x4 Acc[2][2][4][2];
struct Epi1 { static constexpr bool PERM = true;
    bf16_t* QKV; bf16_t* GATES; const float* rstd; float* KSQ;
    __device__ __forceinline__ void operator()(const Acc& acc, const pg8::Unit& u, int wr, int wc, int fr, int fq) const {
        const int row0 = u.pm * 256 + wr * 64 + fr;
        if (u.pn < 24) {
            const bool iskh = (u.pn >= 4 && u.pn < 8) || (u.pn >= 16 && u.pn < 20);
            const int ks0 = u.pn < 8 ? 2 * u.pn - 8 : 2 * u.pn - 32 + 8;
#pragma unroll
            for (int ai = 0; ai < 2; ++ai)
#pragma unroll
                for (int m = 0; m < 4; ++m) { const int row = row0 + ai * 128 + m * 16; const float rs = rstd[row];
#pragma unroll
                    for (int bj = 0; bj < 2; ++bj) { bf16_t* dst = QKV + ((size_t)(2 * u.pn + bj) * MQ + row) * 128 + wc * 32 + 8 * fq;
                        const f32x4 v0 = acc[ai][bj][m][0] * rs, v1 = acc[ai][bj][m][1] * rs;
                        *(u32x4*)dst = pack8u(v0, v1);
                        if (iskh) { float ss = (v0[0] * v0[0] + v0[1] * v0[1]) + (v0[2] * v0[2] + v0[3] * v0[3]) + (v1[0] * v1[0] + v1[1] * v1[1]) + (v1[2] * v1[2] + v1[3] * v1[3]);
                            ss += __shfl_xor(ss, 16); ss += __shfl_xor(ss, 32);
                            if (fq == 0) atomicAdd(KSQ + (size_t)(ks0 + bj) * MQ + row, ss); } } }
        } else {
            const int colb = (u.pn - 24) * 256 + wc * 32 + 8 * fq;
#pragma unroll
            for (int ai = 0; ai < 2; ++ai)
#pragma unroll
                for (int m = 0; m < 4; ++m) { const int row = row0 + ai * 128 + m * 16; const float rs = rstd[row];
#pragma unroll
                    for (int bj = 0; bj < 2; ++bj) { f32x4 v0 = acc[ai][bj][m][0] * rs, v1 = acc[ai][bj][m][1] * rs;
#pragma unroll
                        for (int j = 0; j < 4; ++j) { v0[j] = sigmoidf_(v0[j]); v1[j] = sigmoidf_(v1[j]); }
                        *(u32x4*)(GATES + (size_t)row * 4096 + colb + bj * 128) = pack8u(v0, v1); } }
        }
    }
};
struct Epi3a { static constexpr bool PERM = true;
    float* TMP; const bf16_t* GATES;
    __device__ __forceinline__ void operator()(const Acc& acc, const pg8::Unit& u, int wr, int wc, int fr, int fq) const {
        const int row0 = u.pm * 256 + wr * 64 + fr, col0 = u.pn * 256 + wc * 32 + 8 * fq;
#pragma unroll
        for (int ai = 0; ai < 2; ++ai)
#pragma unroll
            for (int m = 0; m < 4; ++m) { const int row = row0 + ai * 128 + m * 16;
#pragma unroll
                for (int bj = 0; bj < 2; ++bj) { const int col = col0 + bj * 128; f32x4 g0, g1; unpack8(*(const u32x4*)(GATES + (size_t)row * 4096 + col), g0, g1);
                    float* d = TMP + (size_t)row * DM + col; *(f32x4*)d = acc[ai][bj][m][0] * g0; *(f32x4*)(d + 4) = acc[ai][bj][m][1] * g1; } }
    }
};
struct Epi3b { static constexpr bool PERM = true;
    const float* TMP; const bf16_t* GATES; bf16_t* MERGED;
    __device__ __forceinline__ void operator()(const Acc& acc, const pg8::Unit& u, int wr, int wc, int fr, int fq) const {
        const int row0 = u.pm * 256 + wr * 64 + fr, col0 = u.pn * 256 + wc * 32 + 8 * fq;
#pragma unroll
        for (int ai = 0; ai < 2; ++ai)
#pragma unroll
            for (int m = 0; m < 4; ++m) { const int row = row0 + ai * 128 + m * 16;
#pragma unroll
                for (int bj = 0; bj < 2; ++bj) { const int col = col0 + bj * 128; f32x4 g0, g1; unpack8(*(const u32x4*)(GATES + (size_t)row * 4096 + 2048 + col), g0, g1);
                    const float* s = TMP + (size_t)row * DM + col; const f32x4 t0 = *(const f32x4*)s, t1 = *(const f32x4*)(s + 4);
                    *(u32x4*)(MERGED + (size_t)row * DM + col) = pack8u(t0 + acc[ai][bj][m][0] * g0, t1 + acc[ai][bj][m][1] * g1); } }
    }
};
struct Epi4 { static constexpr bool PERM = true;
    const float* x; float* out; bf16_t* H1B; float* ssq;
    __device__ __forceinline__ void operator()(const Acc& acc, const pg8::Unit& u, int wr, int wc, int fr, int fq) const {
        const int row0 = u.pm * 256 + wr * 64 + fr, col0 = u.pn * 256 + wc * 32 + 8 * fq;
#pragma unroll
        for (int ai = 0; ai < 2; ++ai)
#pragma unroll
            for (int m = 0; m < 4; ++m) { const int row = row0 + ai * 128 + m * 16; const size_t orow = (size_t)row; float ss = 0.f;
#pragma unroll
                    for (int bj = 0; bj < 2; ++bj) { const int col = col0 + bj * 128; const float* xs = x + orow * DM + col;
                        const f32x4 h0 = *(const f32x4*)xs + acc[ai][bj][m][0], h1 = *(const f32x4*)(xs + 4) + acc[ai][bj][m][1];
                        float* d = out + orow * DM + col; *(f32x4*)d = h0; *(f32x4*)(d + 4) = h1;
                        *(u32x4*)(H1B + (size_t)row * DM + col) = pack8u(h0, h1);
                        ss += (h0[0] * h0[0] + h0[1] * h0[1]) + (h0[2] * h0[2] + h0[3] * h0[3]) + (h1[0] * h1[0] + h1[1] * h1[1]) + (h1[2] * h1[2] + h1[3] * h1[3]); }
                    ss += __shfl_xor(ss, 16); ss += __shfl_xor(ss, 32);
                    if (fq == 0) atomicAdd(ssq + (size_t)u.pn * M + row, ss); }
    }
};
struct Epi5 { static constexpr bool PERM = true;
    const float* ssq; bf16_t* ACT;
    __device__ __forceinline__ void operator()(const Acc& acc, const pg8::Unit& u, int wr, int wc, int fr, int fq) const {
        const int row0 = u.pm * 256 + wr * 64 + fr, col0 = u.pn * 128 + wc * 32 + 8 * fq;
#pragma unroll
        for (int ai = 0; ai < 2; ++ai)
#pragma unroll
            for (int m = 0; m < 4; ++m) { const int row = row0 + ai * 128 + m * 16; float sq = 0.f;
#pragma unroll
                for (int t = 0; t < 8; ++t) sq += ssq[(size_t)t * M + row];
                const float rs = __builtin_amdgcn_rsqf(sq * (1.0f / 2048.0f) + 1e-6f);
                f32x4 o[2];
#pragma unroll
                for (int n = 0; n < 2; ++n) { const f32x4 g = acc[ai][0][m][n] * rs, up = acc[ai][1][m][n] * rs;
#pragma unroll
                    for (int j = 0; j < 4; ++j) o[n][j] = g[j] * sigmoidf_(g[j]) * up[j]; }
                *(u32x4*)(ACT + (size_t)row * DFF + col0) = pack8u(o[0], o[1]); }
    }
};
struct Epi6 { static constexpr bool PERM = true;
    float* out; float* ssq;
    __device__ __forceinline__ void operator()(const Acc& acc, const pg8::Unit& u, int wr, int wc, int fr, int fq) const {
        const int row0 = u.pm * 256 + wr * 64 + fr, col0 = u.pn * 256 + wc * 32 + 8 * fq;
#pragma unroll
        for (int ai = 0; ai < 2; ++ai)
#pragma unroll
            for (int m = 0; m < 4; ++m) { const int row = row0 + ai * 128 + m * 16; const size_t orow = (size_t)row; float ss = 0.f;
#pragma unroll
                    for (int bj = 0; bj < 2; ++bj) { const int col = col0 + bj * 128; float* d = out + orow * DM + col;
                        const f32x4 h0 = *(const f32x4*)d + acc[ai][bj][m][0], h1 = *(const f32x4*)(d + 4) + acc[ai][bj][m][1];
                        *(f32x4*)d = h0; *(f32x4*)(d + 4) = h1;
                        ss += (h0[0] * h0[0] + h0[1] * h0[1]) + (h0[2] * h0[2] + h0[3] * h0[3]) + (h1[0] * h1[0] + h1[1] * h1[1]) + (h1[2] * h1[2] + h1[3] * h1[3]); }
                    ss += __shfl_xor(ss, 16); ss += __shfl_xor(ss, 32);
                    if (fq == 0) atomicAdd(ssq + (size_t)u.pn * M + row, ss); }
    }
};

struct Epi6F { static constexpr bool PERM = true;
    float* out; float* slots; unsigned* cnt; const float* gfin;
    __device__ __forceinline__ void operator()(const Acc& acc_, const pg8::Unit& u, int wr, int wc, int fr, int fq) const {
        Acc& acc = const_cast<Acc&>(acc_);
        const int row0 = u.pm * 256 + wr * 64 + fr, col0 = u.pn * 256 + wc * 32 + 8 * fq;
        float* myslot = slots + (size_t)(u.pn * 4 + wc) * M;
#pragma unroll
        for (int ai = 0; ai < 2; ++ai)
#pragma unroll
            for (int m = 0; m < 4; ++m) { const int row = row0 + ai * 128 + m * 16; float ss = 0.f;
#pragma unroll
                for (int bj = 0; bj < 2; ++bj) { const float* d = out + (size_t)row * DM + col0 + bj * 128;
                    const f32x4 h0 = *(const f32x4*)d + acc[ai][bj][m][0], h1 = *(const f32x4*)(d + 4) + acc[ai][bj][m][1];
                    acc[ai][bj][m][0] = h0; acc[ai][bj][m][1] = h1;
                    ss += (h0[0] * h0[0] + h0[1] * h0[1]) + (h0[2] * h0[2] + h0[3] * h0[3]) + (h1[0] * h1[0] + h1[1] * h1[1]) + (h1[2] * h1[2] + h1[3] * h1[3]); }
                ss += __shfl_xor(ss, 16); ss += __shfl_xor(ss, 32);
                if (fq == 0) __hip_atomic_store(myslot + row, ss, __ATOMIC_RELAXED, __HIP_MEMORY_SCOPE_AGENT); }
        asm volatile("s_waitcnt vmcnt(0)" ::: "memory");
        unsigned* c = cnt + 64 * (2 * u.pm + wr);
        if ((fr | fq) == 0) __hip_atomic_fetch_add(c, 1u, __ATOMIC_RELAXED, __HIP_MEMORY_SCOPE_AGENT);
        { const unsigned long long t0 = __builtin_amdgcn_s_memrealtime();
          while ((unsigned)__builtin_amdgcn_readfirstlane(__hip_atomic_load(c, __ATOMIC_RELAXED, __HIP_MEMORY_SCOPE_AGENT)) < 32u) {
              if (__builtin_amdgcn_s_memrealtime() - t0 > 2000000ull) break;
              __builtin_amdgcn_s_sleep(2); } }
        __builtin_amdgcn_fence(__ATOMIC_ACQUIRE, "agent");
#pragma unroll
        for (int ai = 0; ai < 2; ++ai)
#pragma unroll
            for (int m = 0; m < 4; ++m) { const int row = row0 + ai * 128 + m * 16; float sq = 0.f;
#pragma unroll
                for (int t = 0; t < 8; ++t) sq += __hip_atomic_load(slots + (size_t)(fq * 8 + t) * M + row, __ATOMIC_RELAXED, __HIP_MEMORY_SCOPE_AGENT);
                sq += __shfl_xor(sq, 16); sq += __shfl_xor(sq, 32);
                const float rs = __builtin_amdgcn_rsqf(sq * (1.0f / 2048.0f) + 1e-6f);
#pragma unroll
                for (int bj = 0; bj < 2; ++bj) { float* d = out + (size_t)row * DM + col0 + bj * 128; const float* gp = gfin + col0 + bj * 128;
                    *(f32x4*)d = acc[ai][bj][m][0] * rs * *(const f32x4*)gp; *(f32x4*)(d + 4) = acc[ai][bj][m][1] * rs * *(const f32x4*)(gp + 4); } }
    }
};
struct PanelOrder { int c;
    __device__ __forceinline__ bool next(int i, pg8::Unit& u) const { if (i >= 4) return false; const int x = c & 7, j = c >> 3; u.pm = 32 * i + 4 * x + (j >> 3); u.pn = j & 7; return true; }
    __device__ __forceinline__ void a_ready(const pg8::Unit&) const {}
    __device__ __forceinline__ void done(const pg8::Unit&) const {}
};

namespace att {
constexpr int D = 128, NW = 8, QBLK = 32, KVBLK = 64, QB = 256;
constexpr int SHM_V = KVBLK * D * 2, SHM_K = KVBLK * D * 2;
constexpr int LDS_WS = 3 * SHM_V + 2 * SHM_K;
constexpr int LDS_TAB = LDS_WS + NW * 64 * 4;
constexpr float SCALE = 0.08838834764831845f;
constexpr float THR = 8.f;
#define KSWZ(row, colB) ((row) * 256 + ((colB) ^ (((row) & 7) << 4)))
#define SBAR() __builtin_amdgcn_sched_barrier(0)
__device__ __forceinline__ int v_st(int k, int c) { const int kk = (k & ~0xC) | ((k & 4) << 1) | ((k & 8) >> 1); return ((kk >> 3) * 4 + (c >> 5)) * 512 + ((kk & 7) * 32 + (c & 31)) * 2; }
__device__ __forceinline__ int v_rd_base(int lane) { return ((lane & 3) << 3) | (((lane >> 2) & 3) << 6) | (((lane >> 4) & 1) << 5) | (((lane >> 5) & 1) << 8); }
constexpr int v_rd_off(int d0, int ks, int half) { return d0 * 512 + ks * 4096 + half * 2048; }
__device__ __forceinline__ int crow(int r, int hi) { return (r & 3) + 8 * (r >> 2) + 4 * hi; }
__device__ __forceinline__ unsigned cvtpk(float lo, float hi) { unsigned r; asm volatile("v_cvt_pk_bf16_f32 %0, %1, %2" : "=v"(r) : "v"(lo), "v"(hi)); return r; }
__device__ __forceinline__ bf16x8 load8(const bf16_t* p) { return *reinterpret_cast<const bf16x8*>(p); }
__device__ __forceinline__ void mask_tile(f32x16& p0, f32x16& p1, int dqe, int dqt, unsigned W, float s2) {
    const float NEG = -__builtin_inff();
#pragma unroll
    for (int r = 0; r < 16; ++r) {
        const int c = (r & 3) + 8 * (r >> 2);
        const int a0 = c - dqt, a1 = c + 32 - dqt;
        p0[r] -= s2 * (float)(a0 > 0 ? a0 : 0);
        p1[r] -= s2 * (float)(a1 > 0 ? a1 : 0);
        if ((unsigned)(dqe - c) >= W) p0[r] = NEG;
        if ((unsigned)(dqe - c - 32) >= W) p1[r] = NEG;
    }
}
__device__ __forceinline__ void partialSM(f32x16& p0, f32x16& p1, float& m_reg, float& mn, float& alpha, bool& skip) {
    float pmax = p0[0]; for (int r = 1; r < 16; ++r) pmax = fmaxf(pmax, p0[r]); for (int r = 0; r < 16; ++r) pmax = fmaxf(pmax, p1[r]);
    { auto rr = __builtin_amdgcn_permlane32_swap(__float_as_uint(pmax), __float_as_uint(pmax), false, false);
      pmax = fmaxf(__uint_as_float(rr[0]), __uint_as_float(rr[1])); }
    constexpr float C2 = 1.4426950408889634f * SCALE;
    skip = __all((pmax - m_reg) * C2 < -150.f);
    if (skip) { mn = m_reg; alpha = 1.f; return; }
    if (__builtin_expect(__all((pmax - m_reg) * SCALE <= THR), 1)) { mn = m_reg; alpha = 1.f; }
    else { mn = fmaxf(m_reg, pmax); alpha = __builtin_amdgcn_exp2f((m_reg - mn) * C2); m_reg = mn; }
    const float mnL = -mn * C2;
    for (int r = 0; r < 16; ++r) p0[r] = fmaf(p0[r], C2, mnL); for (int r = 0; r < 16; ++r) p1[r] = fmaf(p1[r], C2, mnL);
    for (int r = 0; r < 16; ++r) p0[r] = __builtin_amdgcn_exp2f(p0[r]);
}
__device__ __forceinline__ void finishSM(f32x16& p0, f32x16& p1, float alpha, float& l_reg, bf16x8& pa0, bf16x8& pa1, bf16x8& pa2, bf16x8& pa3) {
    for (int r = 0; r < 16; ++r) p1[r] = __builtin_amdgcn_exp2f(p1[r]);
    float ps = 0; for (int r = 0; r < 16; ++r) ps += p0[r]; for (int r = 0; r < 16; ++r) ps += p1[r];
    { auto rr = __builtin_amdgcn_permlane32_swap(__float_as_uint(ps), __float_as_uint(ps), false, false);
      ps = __uint_as_float(rr[0]) + __uint_as_float(rr[1]); }
    l_reg = l_reg * alpha + ps;
#define PK4(P, B_, OUT) do { unsigned a0 = cvtpk(P[B_+0], P[B_+1]), a1 = cvtpk(P[B_+2], P[B_+3]);                          \
        unsigned b0 = cvtpk(P[B_+4], P[B_+5]), b1 = cvtpk(P[B_+6], P[B_+7]);                                             \
        auto r0 = __builtin_amdgcn_permlane32_swap(a0, b0, false, false); auto r1 = __builtin_amdgcn_permlane32_swap(a1, b1, false, false); \
        u32x4 w = {r0[0], r1[0], r0[1], r1[1]}; OUT = *reinterpret_cast<bf16x8*>(&w); } while (0)
    PK4(p0, 0, pa0); PK4(p0, 8, pa1); PK4(p1, 0, pa2); PK4(p1, 8, pa3);
#undef PK4
}
template <int KB>
__device__ __forceinline__ void qkt(f32x16& p0, f32x16& p1, const char* K_lds, int r32, int hi, const bf16x8* qr) {
    p0 = f32x16{}; p1 = f32x16{};
    const char* kb[4];
#pragma unroll
    for (int dd = 0; dd < 4; ++dd) kb[dd] = K_lds + KB * SHM_K + KSWZ(r32, (dd * 16 + hi * 8) * 2);
#pragma unroll
    for (int d0 = 0; d0 < 8; ++d0) { const char* a = kb[d0 & 3] + (d0 >> 2) * 128;
        bf16x8 b0 = *reinterpret_cast<const bf16x8*>(a);
        bf16x8 b1 = *reinterpret_cast<const bf16x8*>(a + 32 * 256);
        p0 = __builtin_amdgcn_mfma_f32_32x32x16_bf16(b0, qr[d0], p0, 0, 0, 0);
        p1 = __builtin_amdgcn_mfma_f32_32x32x16_bf16(b1, qr[d0], p1, 0, 0, 0); }
}
__device__ __forceinline__ void pv_tile(f32x16* o, int vb0, bf16x8 pa0, bf16x8 pa1, bf16x8 pa2, bf16x8 pa3) {
#define TRRD(dst, off) asm volatile("ds_read_b64_tr_b16 %0, %1 offset:%2" : "=&v"(dst) : "v"(vb0), "i"(off) : "memory")
#define PV_D0(d0) do { s16x4 l0, l1, l2, l3, h0, h1, h2, h3; constexpr int b_ = v_rd_off(d0, 0, 0); \
        TRRD(l0, b_); TRRD(h0, b_ + 2048); TRRD(l1, b_ + 4096); TRRD(h1, b_ + 6144); TRRD(l2, b_ + 8192); TRRD(h2, b_ + 10240); TRRD(l3, b_ + 12288); TRRD(h3, b_ + 14336); \
        asm volatile("s_waitcnt lgkmcnt(0)" ::: "memory"); SBAR();   \
        o[d0] = __builtin_amdgcn_mfma_f32_32x32x16_bf16(pa0, (bf16x8){l0[0], l0[1], l0[2], l0[3], h0[0], h0[1], h0[2], h0[3]}, o[d0], 0, 0, 0);   \
        o[d0] = __builtin_amdgcn_mfma_f32_32x32x16_bf16(pa1, (bf16x8){l1[0], l1[1], l1[2], l1[3], h1[0], h1[1], h1[2], h1[3]}, o[d0], 0, 0, 0);   \
        o[d0] = __builtin_amdgcn_mfma_f32_32x32x16_bf16(pa2, (bf16x8){l2[0], l2[1], l2[2], l2[3], h2[0], h2[1], h2[2], h2[3]}, o[d0], 0, 0, 0);   \
        o[d0] = __builtin_amdgcn_mfma_f32_32x32x16_bf16(pa3, (bf16x8){l3[0], l3[1], l3[2], l3[3], h3[0], h3[1], h3[2], h3[3]}, o[d0], 0, 0, 0); } while (0)
    PV_D0(0); PV_D0(1); PV_D0(2); PV_D0(3);
#undef PV_D0
#undef TRRD
}
struct Blk { const bf16_t* Q; const bf16_t* K; const bf16_t* V; const bf16_t* K0; const bf16_t* V0; bf16_t* O; int P0; int mode; float s2; };
struct Seam { bf16x8 qr[8]; bf16x8 st_v0, st_v1, st_k0, st_k1; };
#define ROW(p, k0, rr) ((p) + (size_t)((k0) + (rr)) * D + sc)
#define VMW() asm volatile("s_waitcnt vmcnt(0)" ::: "memory")
#define VMWN(n) asm volatile("s_waitcnt vmcnt(%0)" :: "i"(n) : "memory")
#define SLOAD_H(Kp, Vp, k0) do { S.st_v0 = load8(ROW(Vp, k0, sr)); S.st_v1 = load8(ROW(Vp, k0, 32 + sr));              \
                         S.st_k0 = load8(ROW(Kp, k0, sr)); S.st_k1 = load8(ROW(Kp, k0, 32 + sr)); } while (0)
#define SWRITE_HK(bf) do { *(bf16x8*)(K_lds + (bf) * SHM_K + kws) = S.st_k0; *(bf16x8*)(K_lds + (bf) * SHM_K + kws + 32 * 256) = S.st_k1; } while (0)
#define SWRITE_HV(bf) do { *(bf16x8*)(V_lds + (bf) * SHM_V + vst0) = S.st_v0; *(bf16x8*)(V_lds + (bf) * SHM_V + vst1) = S.st_v1; } while (0)
#define SWRITE_H(bf) do { SWRITE_HV(bf); SWRITE_HK(bf); } while (0)
__device__ __forceinline__ void attn_prime(const Blk& cur, char* lds, Seam& S, const int tid) {
    const int wid = __builtin_amdgcn_readfirstlane(tid >> 6), lane = tid & 63, r32 = lane & 31, hi = lane >> 5;
    for (int d0 = 0; d0 < 8; ++d0) S.qr[d0] = load8(cur.Q + (size_t)(wid * QBLK + r32) * D + d0 * 16 + hi * 8);
}
__device__ __forceinline__ void attn_block(const Blk& cur, const bf16_t* nxtQ, char* lds, Seam& S, float lam, float* scrT, const bf16_t* OAb, float* SSQAb, const int tid, const int j_lo) {
    const int wid = __builtin_amdgcn_readfirstlane(tid >> 6), lane = tid & 63, r32 = lane & 31, hi = lane >> 5;
    const int NT = (cur.P0 + QB - 1) / KVBLK + 1 - j_lo;
    const int qlo = cur.P0 + wid * QBLK;
    const int qt4 = qlo + r32 - 4 * hi;
    const bool isdiff = cur.mode != 0;
    char* V_lds = lds; char* K_lds = lds + 3 * SHM_V;
    float* ws = (float*)(lds + LDS_WS) + wid * 64; float* li_l = ws, * al_l = ws + 32;
    float m_reg = ((const float*)(lds + LDS_TAB))[qlo + r32] - 226.27417f, l_reg = 0; f32x16 o[4] = {};
    const int sr = tid >> 4, sc = (tid & 15) * 8, vst0 = v_st(sr, sc), vst1 = v_st(32 + sr, sc), kws = KSWZ(sr, sc * 2);
    const int vb0 = (int)(uintptr_t)V_lds + v_rd_base(lane);
    const bf16_t* Kh = cur.K; const bf16_t* Vh = cur.V;
#define RESC(a) do { if (__any((a) < 1.f)) { if (hi == 0) al_l[r32] = (a); asm volatile("s_waitcnt lgkmcnt(0)" ::: "memory");              \
                     for (int d_ = 0; d_ < 4; ++d_) for (int r = 0; r < 16; ++r) o[d_][r] *= al_l[crow(r, hi)]; } } while (0)
#define KBASE(t) ((j_lo + (t)) * KVBLK)
#define BIAS(P0_, P1_, t) do { int h_ = hi; asm volatile("" : "+v"(h_)); const float* tb_ = (const float*)(lds + LDS_TAB) + (4 * h_ + KBASE(t));         \
        _Pragma("unroll") for (int i_ = 0; i_ < 4; ++i_) { const f32x4 b0_ = *(const f32x4*)(tb_ + 8 * i_), b1_ = *(const f32x4*)(tb_ + 32 + 8 * i_); \
            _Pragma("unroll") for (int j_ = 0; j_ < 4; ++j_) { P0_[4 * i_ + j_] += b0_[j_]; P1_[4 * i_ + j_] += b1_[j_]; } } } while (0)
#define MASKT(P0_, P1_, t) do { const int kb_ = KBASE(t); BIAS(P0_, P1_, t); if (kb_ + KVBLK - 1 > qlo || kb_ == 0) { int q_ = qt4; asm volatile("" : "+v"(q_)); const int qt_ = q_ + 4 * hi, qe_ = isdiff ? (qt_ | 63) : qt_;      \
            mask_tile(P0_, P1_, qe_ - kb_ - 4 * hi, q_ - kb_, (unsigned)(qe_ - 47), cur.s2); } } while (0)
#define SEAM_K0() do { VMWN(8); SWRITE_HK(0); SBAR(); } while (0)
    f32x16 pA0, pA1, pB0, pB1; float mnA, mnB, alA, alB; bf16x8 pa0, pa1, pa2, pa3; bool skA, skB;
    { const bf16_t* kp = j_lo == 0 ? cur.K0 : Kh + (size_t)j_lo * KVBLK * D; const bf16_t* vp = j_lo == 0 ? cur.V0 : Vh + (size_t)j_lo * KVBLK * D;
      SLOAD_H(kp, vp, 0); VMW(); SWRITE_H(0); SBAR(); }
    if (NT > 1) { SLOAD_H(Kh, Vh, KBASE(1)); }
    __syncthreads();
    SBAR(); qkt<0>(pA0, pA1, K_lds, r32, hi, S.qr);
    MASKT(pA0, pA1, 0); partialSM(pA0, pA1, m_reg, mnA, alA, skA);
    if (NT > 1) { VMW(); SWRITE_H(1); }
    __syncthreads();
#define HALF_STEP(PX0, PX1, mnX, alX, skX, PY0, PY1, alY, skY, t, KB, VB, SB_) do {                                                      \
        SBAR(); qkt<KB>(PX0, PX1, K_lds, r32, hi, S.qr);                                             \
        if (!(skY)) finishSM(PY0, PY1, alY, l_reg, pa0, pa1, pa2, pa3); SBAR();                                               \
        if ((t) + 1 < NT) { SLOAD_H(Kh, Vh, KBASE((t) + 1)); SBAR(); }                                               \
        if (!(skY)) pv_tile(o, vb0 + vprev * SHM_V, pa0, pa1, pa2, pa3); MASKT(PX0, PX1, (t)); partialSM(PX0, PX1, m_reg, mnX, alX, skX);                        \
        if ((t) + 1 < NT) { VMW(); SWRITE_HK(SB_); SWRITE_HV(vprev == 0 ? 2 : vprev - 1); }     \
        RESC(alX); __syncthreads(); vprev = vprev == 2 ? 0 : vprev + 1; } while (0)
    int vprev = 0;
    for (int t = 1; t + 1 < NT; t += 2) {
        HALF_STEP(pB0, pB1, mnB, alB, skB, pA0, pA1, alA, skA, t, 1, 0, 0);
        HALF_STEP(pA0, pA1, mnA, alA, skA, pB0, pB1, alB, skB, t + 1, 0, 1, 1);
    }
    const bool even = (NT & 1) == 0;
    if (even) { SBAR(); qkt<1>(pB0, pB1, K_lds, r32, hi, S.qr); SBAR(); }
    { int t2 = tid; asm volatile("" : "+v"(t2));
      const int l2 = t2 & 63;
      const unsigned qoff = (unsigned)((wid * QBLK + (l2 & 31)) * D + (l2 >> 5) * 8);
#pragma unroll
      for (int d0 = 0; d0 < 8; ++d0) S.qr[d0] = load8(nxtQ + qoff + d0 * 16); }
    SBAR();
    if (!skA) finishSM(pA0, pA1, alA, l_reg, pa0, pa1, pa2, pa3); SBAR();
    if (!skA) pv_tile(o, vb0 + ((even ? NT - 2 : NT - 1) % 3) * SHM_V, pa0, pa1, pa2, pa3);
    if (even) { MASKT(pB0, pB1, NT - 1); partialSM(pB0, pB1, m_reg, mnB, alB, skB); __syncthreads(); RESC(alB);
        if (!skB) { finishSM(pB0, pB1, alB, l_reg, pa0, pa1, pa2, pa3); SBAR(); pv_tile(o, vb0 + ((NT - 1) % 3) * SHM_V, pa0, pa1, pa2, pa3); } }
    SBAR();
    int ln = lane; asm volatile("" : "+v"(ln));
    const int r32e = ln & 31;
    if (hi == 0) li_l[r32] = l_reg; asm volatile("s_waitcnt lgkmcnt(0)" ::: "memory");
    float rli[16];
#pragma unroll
    for (int r = 0; r < 16; ++r) rli[r] = __builtin_amdgcn_rcpf(li_l[crow(r, hi)]);
    const int mode = cur.mode;
    if (mode == 0) {
        bf16_t* Ow = cur.O + (size_t)(wid * QBLK) * 1024;
#pragma unroll
        for (int r = 0; r < 16; ++r) { const int orow = crow(r, hi);
#pragma unroll
            for (int d0 = 0; d0 < 4; ++d0) { const float v = o[d0][r] * rli[r]; const float vn = shx(v, 1, ln);
                if ((r32e & 1) == 0) *(unsigned*)(Ow + (orow * 1024 + d0 * 32 + r32e)) = cvtpk(v, vn); } }
    } else if (mode == 1) {
        float* T = scrT + (wid * 4096 + ln);
#pragma unroll
        for (int r = 0; r < 16; ++r)
#pragma unroll
            for (int d0 = 0; d0 < 4; ++d0) T[(r * 4 + d0) * 64] = o[d0][r] * rli[r];
    } else {
        const float* T = scrT + (wid * 4096 + ln);
        bf16_t* Ow = cur.O + (size_t)(wid * QBLK) * 1024; const size_t oo = (size_t)(cur.O - OAb); float* SSw = SSQAb + (oo >> 10) * 8 + ((oo >> 7) & 7) + (wid * QBLK) * 8;
#pragma unroll
        for (int r = 0; r < 16; ++r) { const int orow = crow(r, hi); float ss = 0.f;
#pragma unroll
            for (int d0 = 0; d0 < 4; ++d0) { const float v = __hip_atomic_load(T + (r * 4 + d0) * 64, __ATOMIC_RELAXED, __HIP_MEMORY_SCOPE_AGENT) - lam * (o[d0][r] * rli[r]); ss += v * v;
                const float vn = shx(v, 1, ln);
                if ((r32e & 1) == 0) *(unsigned*)(Ow + (orow * 1024 + d0 * 32 + r32e)) = cvtpk(v, vn); }
            ss += shx(ss, 1, ln); ss += shx(ss, 2, ln); ss += shx(ss, 4, ln); ss += shx(ss, 8, ln); ss += shx(ss, 16, ln);
            if (r32e == 0) SSw[orow * 8] = ss; }
    }
    __syncthreads();
#undef RESC
#undef KBASE
#undef BIAS
#undef MASKT
#undef SEAM_K0
#undef HALF_STEP
}
#undef ROW
#undef VMW
#undef VMWN
#undef SLOAD_H
#undef SWRITE_HK
#undef SWRITE_HV
#undef SWRITE_H
}

__device__ __forceinline__ float metak2(const bf16_t* K0, int k) {
    if (k < VPAD) return 0.f;
    float a = 0.f;
    for (int q = 0; q < 16; ++q) { f32x4 x0, x1; unpack8(*(const u32x4*)(K0 + (size_t)k * 128 + q * 8), x0, x1); a += (x0[0] * x0[0] + x0[1] * x0[1]) + (x0[2] * x0[2] + x0[3] * x0[3]) + (x1[0] * x1[0] + x1[1] * x1[1]) + (x1[2] * x1[2] + x1[3] * x1[3]); }
    return a;
}
__device__ __forceinline__ void grid_bar(unsigned* ctr, unsigned target, int wid) {
    __syncthreads();
    if (wid == 0) {
        if (fresh_lane() == 0) {
            __builtin_amdgcn_fence(__ATOMIC_RELEASE, "agent");
            unsigned seen = atomicAdd(ctr, 1u) + 1u;
            while (seen < target) { __builtin_amdgcn_s_sleep(1); seen = __hip_atomic_load(ctr, __ATOMIC_RELAXED, __HIP_MEMORY_SCOPE_AGENT); }
            __builtin_amdgcn_fence(__ATOMIC_ACQUIRE, "agent");
        }
    }
    __syncthreads();
}
struct Params { const float* in[18]; float* out; unsigned char* ws; int ph_lo, ph_hi; };

__device__ __forceinline__ void transpose_job(const float* __restrict__ src, int ld, int col0, int nN, int Kdim, bf16_t* __restrict__ dst, int up, const float* __restrict__ scale, float* tile, const int tid) {
    const int nK = Kdim / 64, total = nK * nN;
    f32x4 v[2];
    int t = blockIdx.x;
    if (t < total) { const int k0 = (t / nN) * 64, n0 = (t % nN) * 64;
#pragma unroll
        for (int i = 0; i < 2; ++i) { const int idx = tid + 512 * i, kk = idx >> 4, c4 = idx & 15; v[i] = *(const f32x4*)(src + (size_t)(k0 + kk) * ld + col0 + n0 + c4 * 4) * (scale ? scale[k0 + kk] : 1.0f); } }
    for (; t < total; t += gridDim.x) {
        const int k0 = (t / nN) * 64, n0 = (t % nN) * 64;
#pragma unroll
        for (int i = 0; i < 2; ++i) { const int idx = tid + 512 * i, kk = idx >> 4, c4 = idx & 15;
#pragma unroll
            for (int j = 0; j < 4; ++j) tile[kk * 65 + c4 * 4 + j] = v[i][j]; }
        const int tn = t + gridDim.x;
        if (tn < total) { const int k1 = (tn / nN) * 64, n1 = (tn % nN) * 64;
#pragma unroll
            for (int i = 0; i < 2; ++i) { const int idx = tid + 512 * i, kk = idx >> 4, c4 = idx & 15; v[i] = *(const f32x4*)(src + (size_t)(k1 + kk) * ld + col0 + n1 + c4 * 4) * (scale ? scale[k1 + kk] : 1.0f); } }
        __syncthreads();
        { const int n = tid >> 3, kc = (tid & 7) * 8; f32x4 a, b;
#pragma unroll
            for (int j = 0; j < 4; ++j) { a[j] = tile[(kc + j) * 65 + n]; b[j] = tile[(kc + 4 + j) * 65 + n]; }
            const int drow = (up < 0) ? (n0 + n) : (256 * (n0 >> 7) + (n0 & 127) + up * 128 + n);
            *(u32x4*)(dst + (size_t)drow * Kdim + k0 + kc) = pack8u(a, b); }
        __syncthreads();
    }
}

__global__ void __launch_bounds__(512, 2) fwd_kernel(Params p) {
    extern __shared__ __attribute__((aligned(16))) unsigned char lds[];
    __builtin_assume(__builtin_amdgcn_workitem_id_y() == 0); __builtin_assume(__builtin_amdgcn_workitem_id_z() == 0);
    cg::grid_group grid = cg::this_grid();
    const int wid = __builtin_amdgcn_readfirstlane(threadIdx.x >> 6), G = gridDim.x, bx = blockIdx.x;
    unsigned char* ws = p.ws;
    bf16_t* W1T = (bf16_t*)(ws + WS_W1T); bf16_t* WAT = (bf16_t*)(ws + WS_WAT); bf16_t* WFT = (bf16_t*)(ws + WS_WFT); bf16_t* WOT = (bf16_t*)(ws + WS_WOT);
    bf16_t* W5T = (bf16_t*)(ws + WS_W5T); bf16_t* WDT = (bf16_t*)(ws + WS_WDT);
    bf16_t* XB = (bf16_t*)(ws + WS_RA); bf16_t* OA = (bf16_t*)(ws + WS_RA); bf16_t* OF = (bf16_t*)(ws + WS_RA + (size_t)M * 1024 * 2); bf16_t* H1B = (bf16_t*)(ws + WS_RA);
    bf16_t* QKV = (bf16_t*)(ws + WS_RB); float* TMP = (float*)(ws + WS_RB); bf16_t* MERGED = (bf16_t*)(ws + WS_RB + (size_t)M * DM * 4); bf16_t* ACT = (bf16_t*)(ws + WS_RB);
    bf16_t* GATES = (bf16_t*)(ws + WS_RG);
    float* RSTD1 = (float*)(ws + WS_RSTD1); float* SSQ2 = (float*)(ws + WS_SSQ2); float* SSQ3 = (float*)(ws + WS_SSQ3);
    float* LOGF = (float*)(ws + WS_LOGF); float* CUM = (float*)(ws + WS_CUM); float* KSQ = (float*)(ws + WS_KSQ); float* SSQA = (float*)(ws + WS_SSQA);
    const int lo = p.ph_lo, hi_ = p.ph_hi;
#define IN(k) (lo <= (k) && (k) < hi_)
    unsigned* gbar = (unsigned*)(ws + WS_BAR); unsigned gbar_n = 0u;
#define GBAR() do { gbar_n += (unsigned)G; grid_bar(gbar, gbar_n, wid); } while (0)
#define SEAM(k) do { if (IN(k) && IN((k) + 1)) { if ((k) == 0) grid.sync(); else GBAR(); } } while (0)

    for (int rep_ = 0; rep_ < (REP_PHASE == 0 ? 2 : 1); ++rep_) if (IN(0)) {
        if (rep_) grid.sync();
        const int lane = fresh_lane(), tid = wid * 64 + lane;
        float* tile = (float*)lds;
        const float* w_in = p.in[3];
        transpose_job(w_in, NINC, 0, 96, DM, W1T, -1, p.in[2], tile, tid);
        transpose_job(w_in, NINC, 6152, 64, DM, W1T + (size_t)6144 * DM, -1, p.in[2], tile, tid);
        transpose_job(p.in[10], DM, 0, 32, 1024, WAT, -1, nullptr, tile, tid);
        transpose_job(p.in[11], DM, 0, 32, 1024, WFT, -1, nullptr, tile, tid);
        transpose_job(p.in[12], DM, 0, 32, DM, WOT, -1, nullptr, tile, tid);
        transpose_job(p.in[14], DFF, 0, 88, DM, W5T, 0, p.in[13], tile, tid);
        transpose_job(p.in[15], DFF, 0, 88, DM, W5T, 1, p.in[13], tile, tid);
        transpose_job(p.in[16], DM, 0, 32, DFF, WDT, -1, nullptr, tile, tid);
        float* WF = (float*)lds;
        for (int k = tid; k < DM; k += 512) { const float g = p.in[2][k]; const f32x4 a = *(const f32x4*)(w_in + (size_t)k * NINC + 6144), b = *(const f32x4*)(w_in + (size_t)k * NINC + 6148);
#pragma unroll
            for (int j = 0; j < 4; ++j) { WF[j * DM + k] = a[j] * g; WF[(4 + j) * DM + k] = b[j] * g; } }
        __syncthreads();
        const float* x = p.in[0]; const float* meta = p.in[1]; const float* b_f = p.in[9];
        for (int job = bx * 8 + wid; job < M + NMETA; job += G * 8) {
            const bool ismeta = job >= M; const int row = ismeta ? job + VPAD : job;
            const float* src = ismeta ? meta + (size_t)(job - M) * DM : x + (size_t)job * DM;
            f32x4 v[8]; float ss = 0.f; float zf[8];
#pragma unroll
            for (int j = 0; j < 8; ++j) zf[j] = 0.f;
#pragma unroll
            for (int i = 0; i < 8; ++i) { v[i] = *(const f32x4*)(src + i * 256 + lane * 4);
                ss += (v[i][0] * v[i][0] + v[i][1] * v[i][1]) + (v[i][2] * v[i][2] + v[i][3] * v[i][3]); }
#pragma unroll
            for (int i = 0; i < 8; ++i) {
                u32x2 w; w.x = pg8::cvt_pk_bf16(v[i][0], v[i][1]); w.y = pg8::cvt_pk_bf16(v[i][2], v[i][3]);
                *(u32x2*)(XB + (size_t)row * DM + i * 256 + lane * 4) = w;
#pragma unroll
                for (int j = 0; j < 8; ++j) { const f32x4 wv = *(const f32x4*)(WF + j * DM + i * 256 + lane * 4); zf[j] += (v[i][0] * wv[0] + v[i][1] * wv[1]) + (v[i][2] * wv[2] + v[i][3] * wv[3]); } }
            ss = wave_sum(ss);
#pragma unroll
            for (int j = 0; j < 8; ++j) zf[j] = wave_sum(zf[j]);
            const float rs = __builtin_amdgcn_rsqf(ss * (1.0f / 2048.0f) + 1e-6f);
            if (lane == 0) RSTD1[row] = rs;
            if (lane < 8 && !ismeta) { SSQ2[(size_t)lane * M + row] = 0.f; SSQ3[(size_t)lane * M + row] = 0.f; }
            if (lane < 8) { float zz = zf[0];
#pragma unroll
                for (int j = 1; j < 8; ++j) zz = (lane == j) ? zf[j] : zz;
                const float y = zz * rs + b_f[lane];
                const float lf = fminf(y, 0.f) - log1pf(__expf(-fabsf(y)));
                if (!ismeta) { const int b = job >> 13, t = job & (SEQ - 1); LOGF[(size_t)(b * 8 + lane) * LB + 64 + t] = lf; }
                else { const int vp = VPAD + (job - M);
#pragma unroll
                    for (int b = 0; b < NBATCH; ++b) LOGF[(size_t)(b * 8 + lane) * LB + vp] = lf; } }
        }
        for (int i = bx * 512 + tid; i < 16 * MQ; i += G * 512) KSQ[i] = 0.f;
        if (bx == 0 && tid == 0) *(unsigned*)(ws + WS_QCTR) = 0u;
        if (bx == 1 && tid < 256) ((unsigned*)(ws + WS_CNT6))[64 * tid] = 0u;
        if (bx == 0) for (int i = tid; i < 32 * VPAD; i += 512) LOGF[(size_t)(i / VPAD) * LB + (i % VPAD)] = 0.f;
        __syncthreads();
    }
    SEAM(0);

    for (int rep_ = 0; rep_ < (REP_PHASE == 1 ? 2 : 1); ++rep_) if (IN(1)) {
        if (rep_) grid.sync();
        const int lane = fresh_lane(), tid = wid * 64 + lane;
        if (bx < 32) {
            const float* srcp = LOGF + (size_t)bx * LB; float* dstp = CUM + (size_t)bx * LB; float* red = (float*)lds;
            const int i0 = tid * 17; float vals[17]; float s = 0.f;
#pragma unroll
            for (int i = 0; i < 17; ++i) { const int k = i0 + i; vals[i] = k < LB ? srcp[k] : 0.f; s += vals[i]; vals[i] = s; }
            float incl = s;
#pragma unroll
            for (int o = 1; o < 64; o <<= 1) { const float t = __shfl_up(incl, o); if (lane >= o) incl += t; }
            if (lane == 63) red[wid] = incl;
            __syncthreads();
            float base = incl - s;
            for (int w = 0; w < wid; ++w) base += red[w];
#pragma unroll
            for (int i = 0; i < 17; ++i) { const int k = i0 + i; if (k < LB) dstp[k] = (base + vals[i]) * 11.313708498984761f; }
            __syncthreads();
        }
        {
            bf16_t* xm = (bf16_t*)lds;
            for (int i = tid; i < 16 * 256; i += 512) *(u32x4*)(xm + (size_t)i * 8) = *(const u32x4*)(XB + (size_t)(M + VPAD) * DM + (size_t)i * 8);
            { const int i = bx * 512 + tid; if (i < 32 * VPAD * 16) { const int sl = i / (VPAD * 16), r = (i / 16) % VPAD, ch = i % 16; const int hd = sl < 16 ? 8 + sl : 16 + sl;
                *(u32x4*)(QKV + ((size_t)hd * MQ + M + r) * 128 + ch * 8) = (u32x4){0u, 0u, 0u, 0u}; } }
            __syncthreads();
            for (int c0 = bx * 16; c0 < 4096; c0 += G * 16) {
#pragma unroll 1
                for (int cc = 0; cc < 2; ++cc) { const int c = c0 + wid * 2 + cc, sl = c >> 7, hd = sl < 16 ? 8 + sl : 16 + sl, n = hd * 128 + (c & 127);
                    f32x4 wa[8];
#pragma unroll
                    for (int q = 0; q < 4; ++q) unpack8(*(const u32x4*)(W1T + (size_t)n * DM + lane * 32 + q * 8), wa[2 * q], wa[2 * q + 1]);
                    float mine = 0.f;
#pragma unroll 1
                    for (int j = 0; j < 16; ++j) { float a = 0.f;
#pragma unroll
                        for (int q = 0; q < 4; ++q) { f32x4 x0, x1; unpack8(*(const u32x4*)(xm + (size_t)j * DM + lane * 32 + q * 8), x0, x1);
                            a += (x0[0] * wa[2 * q][0] + x0[1] * wa[2 * q][1]) + (x0[2] * wa[2 * q][2] + x0[3] * wa[2 * q][3]) + (x1[0] * wa[2 * q + 1][0] + x1[1] * wa[2 * q + 1][1]) + (x1[2] * wa[2 * q + 1][2] + x1[3] * wa[2 * q + 1][3]); }
                        a = wave_sum(a); mine = (lane == j) ? a : mine; }
                    if (lane < 16) { const float v = mine * RSTD1[M + VPAD + lane]; QKV[((size_t)hd * MQ + M + VPAD + lane) * 128 + (c & 127)] = (bf16_t)(pg8::cvt_pk_bf16(v, v) & 0xffffu); } }
            }
            __syncthreads();
        }
        pg8::Gemm g{XB, W1T, M, N1, DM}; pg8::StaticOrder S; S.init(M, N1, G, bx);
        Epi1 E{QKV, GATES, RSTD1, KSQ};
        pg8::gemm_phase<Epi1, pg8::StaticOrder>((PG8_LAS unsigned char*)lds, g, S, E, wid * 64 + fresh_lane());
    }
    SEAM(1);

    for (int rep_ = 0; rep_ < (REP_PHASE == 2 ? 2 : 1); ++rep_) if (IN(2)) {
        if (rep_) grid.sync();
        const int lane = fresh_lane(), tid = wid * 64 + lane;
        float lam;
        { const float* q1 = p.in[4]; const float* k1 = p.in[5]; const float* q2 = p.in[6]; const float* k2 = p.in[7];
          float s1 = q1[lane] * k1[lane] + q1[lane + 64] * k1[lane + 64], s2 = q2[lane] * k2[lane] + q2[lane + 64] * k2[lane + 64];
          s1 = wave_sum(s1); s2 = wave_sum(s2); lam = __expf(s1) - __expf(s2) + 0.2f; lam = __uint_as_float(__builtin_amdgcn_readfirstlane(__float_as_uint(lam))); }
        float* scrT = (float*)(ws + WS_SCR + (size_t)bx * 262144);
        float* tabw = (float*)(lds + att::LDS_TAB);
        constexpr int NITEM = 2048, NDIFF = 1024;
        unsigned* qctr = (unsigned*)(ws + WS_QCTR);
        float* red = (float*)(lds + att::LDS_TAB + 8256 * 4);
        auto grab = [&]() -> int { if (wid == 0 && fresh_lane() == 0) red[16] = __uint_as_float(atomicAdd(qctr, 1u)); __syncthreads();
                                   const int v = __builtin_amdgcn_readfirstlane((int)__float_as_uint(red[16])); __syncthreads(); return v; };
        auto desc = [&](int item, int ps) -> att::Blk {
            att::Blk r;
            if (item >= NDIFF) { const int j = item - NDIFF, h = j >> 7, b = (j >> 5) & 3, qb = 31 - (j & 31);
                const size_t rb = (size_t)b * SEQ + 256 * qb; r.P0 = 64 + 256 * qb; r.mode = 0; r.s2 = 0.f;
                r.Q = QKV + ((size_t)(24 + h) * MQ + rb) * 128; r.K = QKV + ((size_t)(32 + h) * MQ + (size_t)b * SEQ) * 128 - 64 * 128; r.V = QKV + ((size_t)(40 + h) * MQ + (size_t)b * SEQ) * 128 - 64 * 128;
                r.K0 = QKV + ((size_t)(32 + h) * MQ + M) * 128; r.V0 = QKV + ((size_t)(40 + h) * MQ + M) * 128;
                r.O = OF + rb * 1024 + h * 128; }
            else { const int h = 3 - (item >> 8), b = (item >> 6) & 3, qb = 31 - ((item >> 1) & 31), e = item & 1, c = ps;
                const size_t rb = (size_t)b * SEQ + 256 * qb; r.P0 = 64 + 256 * qb; r.mode = 1 + c;
                r.s2 = 2.0f * 11.313708498984761f * (h == 0 ? 0.25f : h == 1 ? 0.0625f : h == 2 ? 0.015625f : 0.00390625f);
                r.Q = QKV + ((size_t)(2 * h + c) * MQ + rb) * 128; r.K = QKV + ((size_t)(8 + 2 * h + c) * MQ + (size_t)b * SEQ) * 128 - 64 * 128; r.V = QKV + ((size_t)(16 + 2 * h + e) * MQ + (size_t)b * SEQ) * 128 - 64 * 128;
                r.K0 = QKV + ((size_t)(8 + 2 * h + c) * MQ + M) * 128; r.V0 = QKV + ((size_t)(16 + 2 * h + e) * MQ + M) * 128;
                r.O = OA + rb * 1024 + h * 256 + e * 128; }
            return r; };
        int item = grab();
        if (item < NITEM) {
            att::Seam S;
            { const att::Blk first = desc(item, 0); att::attn_prime(first, (char*)lds, S, wid * 64 + fresh_lane()); }
            while (item < NITEM) {
              const int item_next = grab();
              const int np = item < NDIFF ? 2 : 1;
              for (int ps = 0; ps < np; ++ps) {
                const att::Blk cur = desc(item, ps);
                const bf16_t* nxtQ = (ps + 1 < np) ? desc(item, ps + 1).Q : (item_next < NITEM ? desc(item_next, 0).Q : cur.Q);
                const int tt = wid * 64 + fresh_lane(), ln_ = tt & 63;
                float km = 0.f;
                { const int nk = cur.P0 + 256;
                  if (item >= NDIFF) { const int j = item - NDIFF, h = j >> 7, b = (j >> 5) & 3; const float* cm = CUM + (size_t)(b * 8 + h) * LB; const float cref = cm[cur.P0];
                      const float* kq = KSQ + (size_t)(8 + h) * MQ;
                      for (int k = tt; k < nk; k += 512) { tabw[k] = cref - cm[k]; km = fmaxf(km, k < 64 ? metak2(cur.K0, k) : kq[b * SEQ + k - 64]); } }
                  else { const int h = 3 - (item >> 8), b = (item >> 6) & 3, c = ps; const float sl = 0.5f * cur.s2; const float* kq = KSQ + (size_t)(2 * h + c) * MQ;
                      for (int k = tt; k < nk; k += 512) { tabw[k] = sl * (float)(k - cur.P0); km = fmaxf(km, k < 64 ? metak2(cur.K0, k) : kq[b * SEQ + k - 64]); } } }
                float qs = 0.f;
#pragma unroll
                for (int d0 = 0; d0 < 8; ++d0) { f32x4 a, b2; unpack8(*reinterpret_cast<const u32x4*>(&S.qr[d0]), a, b2); qs += (a[0] * a[0] + a[1] * a[1]) + (a[2] * a[2] + a[3] * a[3]) + (b2[0] * b2[0] + b2[1] * b2[1]) + (b2[2] * b2[2] + b2[3] * b2[3]); }
                qs += shx(qs, 32, ln_);
#pragma unroll
                for (int o = 32; o >= 1; o >>= 1) { qs = fmaxf(qs, shx(qs, o, ln_)); km = fmaxf(km, shx(km, o, ln_)); }
                if (ln_ == 0) { red[wid] = qs; red[8 + wid] = km; }
                __syncthreads();
                int j_lo;
                { float q2 = red[0], k2 = red[8];
#pragma unroll
                  for (int w = 1; w < 8; ++w) { q2 = fmaxf(q2, red[w]); k2 = fmaxf(k2, red[8 + w]); }
                  const float Bnd = sqrtf(q2 * k2) * 1.05f + 1.0f; const float thr = -(1176.3f + 226.3f + Bnd);
                  int lo_ = 0, hi_2 = (cur.P0 + 255) / 64;
                  while (lo_ < hi_2) { const int mid = (lo_ + hi_2) >> 1; if (tabw[64 * mid + 63] < thr) lo_ = mid + 1; else hi_2 = mid; }
                  j_lo = __builtin_amdgcn_readfirstlane(lo_); }
                att::attn_block(cur, nxtQ, (char*)lds, S, lam, scrT, OA, SSQA, wid * 64 + fresh_lane(), j_lo);
              }
              item = item_next;
            }
        }
        asm volatile("s_waitcnt vmcnt(0)" ::: "memory");
        __syncthreads();
        GBAR();
        { const int ln2 = fresh_lane(), h = ln2 >> 4; const float* g_subln = p.in[8];
          f32x4 gq[4];
#pragma unroll
          for (int q = 0; q < 4; ++q) gq[q] = *(const f32x4*)(g_subln + (ln2 & 15) * 16 + q * 4) * 0.8f;
          for (int row = bx * 8 + wid; row < M; row += G * 8) {
              const float rn = __builtin_amdgcn_rsqf((SSQA[(size_t)row * 8 + 2 * h] + SSQA[(size_t)row * 8 + 2 * h + 1]) * (1.0f / 256.0f) + 1e-5f);
              bf16_t* d = OA + (size_t)row * 1024 + ln2 * 16;
              f32x4 a0, a1, a2, a3; unpack8(*(const u32x4*)d, a0, a1); unpack8(*(const u32x4*)(d + 8), a2, a3);
              *(u32x4*)d = pack8u(a0 * rn * gq[0], a1 * rn * gq[1]); *(u32x4*)(d + 8) = pack8u(a2 * rn * gq[2], a3 * rn * gq[3]); } }
    }
    SEAM(2);

    for (int rep_ = 0; rep_ < (REP_PHASE == 3 ? 2 : 1); ++rep_) if (IN(3)) {
        if (rep_) grid.sync();
        if (G == 256) { pg8::Gemm g{OA, WAT, M, DM, 1024}; PanelOrder S{bx}; Epi3a E{TMP, GATES};
          pg8::gemm_phase<Epi3a, PanelOrder>((PG8_LAS unsigned char*)lds, g, S, E, wid * 64 + fresh_lane()); }
        else { pg8::Gemm g{OA, WAT, M, DM, 1024}; pg8::StaticOrder S; S.init(M, DM, G, bx); Epi3a E{TMP, GATES};
          pg8::gemm_phase<Epi3a, pg8::StaticOrder>((PG8_LAS unsigned char*)lds, g, S, E, wid * 64 + fresh_lane()); }
        if (G == 256) { pg8::Gemm g{OF, WFT, M, DM, 1024}; PanelOrder S{bx}; Epi3b E{TMP, GATES, MERGED};
          pg8::gemm_phase<Epi3b, PanelOrder>((PG8_LAS unsigned char*)lds, g, S, E, wid * 64 + fresh_lane()); }
        else { pg8::Gemm g{OF, WFT, M, DM, 1024}; pg8::StaticOrder S; S.init(M, DM, G, bx); Epi3b E{TMP, GATES, MERGED};
          pg8::gemm_phase<Epi3b, pg8::StaticOrder>((PG8_LAS unsigned char*)lds, g, S, E, wid * 64 + fresh_lane()); }
    }
    SEAM(3);

    if (IN(4)) {
        pg8::Gemm g{MERGED, WOT, M, DM, DM}; Epi4 E{p.in[0], p.out, H1B, SSQ2};
        if (G == 256) { PanelOrder S{bx}; pg8::gemm_phase<Epi4, PanelOrder>((PG8_LAS unsigned char*)lds, g, S, E, wid * 64 + fresh_lane()); }
        else { pg8::StaticOrder S; S.init(M, DM, G, bx); pg8::gemm_phase<Epi4, pg8::StaticOrder>((PG8_LAS unsigned char*)lds, g, S, E, wid * 64 + fresh_lane()); }
    }
    SEAM(4);

    for (int rep_ = 0; rep_ < (REP_PHASE == 5 ? 2 : 1); ++rep_) if (IN(5)) {
        if (rep_) grid.sync();
        pg8::Gemm g{H1B, W5T, M, N5, DM}; pg8::StaticOrder S; S.init(M, N5, G, bx); Epi5 E{SSQ2, ACT};
        pg8::gemm_phase<Epi5, pg8::StaticOrder>((PG8_LAS unsigned char*)lds, g, S, E, wid * 64 + fresh_lane());
    }
    SEAM(5);

    if (IN(6)) {
        pg8::Gemm g{ACT, WDT, M, DM, DFF};
        if (G == 256) { PanelOrder S{bx}; Epi6 E{p.out, SSQ3};
            pg8::gemm_phase<Epi6, PanelOrder>((PG8_LAS unsigned char*)lds, g, S, E, wid * 64 + fresh_lane()); }
        else { pg8::StaticOrder S; S.init(M, DM, G, bx); Epi6 E{p.out, SSQ3};
            pg8::gemm_phase<Epi6, pg8::StaticOrder>((PG8_LAS unsigned char*)lds, g, S, E, wid * 64 + fresh_lane()); }
    }
    SEAM(6);

    if (IN(7)) {
        const int lane = fresh_lane();
        const float* gfin = p.in[17];
        f32x4 gv[8];
#pragma unroll
        for (int i = 0; i < 8; ++i) gv[i] = *(const f32x4*)(gfin + i * 256 + lane * 4);
        for (int orow = bx * 8 + wid; orow < NBATCH * SEQ; orow += G * 8) {
            const int row = orow;
            float sq = 0.f;
#pragma unroll
            for (int t = 0; t < 8; ++t) sq += SSQ3[(size_t)t * M + row];
            const float rs = __builtin_amdgcn_rsqf(sq * (1.0f / 2048.0f) + 1e-6f);
            float* d = p.out + (size_t)orow * DM + lane * 4;
#pragma unroll
            for (int i = 0; i < 8; ++i) { const f32x4 v = *(const f32x4*)(d + i * 256); *(f32x4*)(d + i * 256) = v * rs * gv[i]; }
        }
    }
#undef IN
#undef SEAM
}

extern "C" void kernel_launch(void* const* d_in, const int* in_sizes, int n_in, void* d_out, int out_size, void* d_ws, size_t ws_size, hipStream_t stream) {
    static int grid = 0;
    if (grid == 0) {
        if (n_in != 18 || ws_size < WS_END) { fprintf(stderr, "kernel_launch: need 18 inputs and >= %zu bytes of workspace (got %d, %zu)\n", (size_t)WS_END, n_in, ws_size); grid = -1; return; }
        int dev = 0, cus = 0, per_cu = 0;
        (void)hipGetDevice(&dev);
        if (hipDeviceGetAttribute(&cus, hipDeviceAttributeMultiprocessorCount, dev) != hipSuccess || cus <= 0) cus = 256;
        if (hipFuncSetAttribute((const void*)fwd_kernel, hipFuncAttributeMaxDynamicSharedMemorySize, LDS_BYTES) != hipSuccess) { fprintf(stderr, "kernel_launch: hipFuncSetAttribute failed\n"); }
        if (hipOccupancyMaxActiveBlocksPerMultiprocessor(&per_cu, (const void*)fwd_kernel, 512, LDS_BYTES) != hipSuccess || per_cu < 1) { fprintf(stderr, "kernel_launch: occupancy query says %d\n", per_cu); per_cu = 1; }
        (void)hipGetLastError();
        grid = cus * 1;
        if (grid > 256) grid = 256;
    }
    if (grid < 0) return;
    Params p{};
    for (int i = 0; i < 18; ++i) p.in[i] = (const float*)d_in[i];
    p.out = (float*)d_out; p.ws = (unsigned char*)d_ws;
#if ONE_LAUNCH
    p.ph_lo = 0; p.ph_hi = 8;
    void* args[] = {&p};
    (void)hipMemsetAsync((char*)d_ws + WS_BAR, 0, 256, stream);
    hipError_t e = hipLaunchCooperativeKernel((const void*)fwd_kernel, dim3(grid), dim3(512), args, LDS_BYTES, stream);
    if (e != hipSuccess) fprintf(stderr, "cooperative launch failed: %s (grid %d)\n", hipGetErrorString(e), grid);
#else
    for (int ph = 0; ph < 8; ++ph) { p.ph_lo = ph; p.ph_hi = ph + 1; hipLaunchKernelGGL(fwd_kernel, dim3(grid), dim3(512), LDS_BYTES, stream, p); }
#endif
}
```

```cpp
#include <hip/hip_runtime.h>
#include <hip/hip_cooperative_groups.h>
#include <cstdio>
#include <cstdint>
namespace cg = cooperative_groups;

#ifndef REP_PHASE
#define REP_PHASE -1
#endif
#ifndef ONE_LAUNCH
#define ONE_LAUNCH 1
#endif

typedef unsigned short bf16_t;
typedef short bf16x8 __attribute__((ext_vector_type(8)));
typedef short s16x4 __attribute__((ext_vector_type(4)));
typedef float f32x4 __attribute__((ext_vector_type(4)));
typedef float f32x16 __attribute__((ext_vector_type(16)));
typedef unsigned u32x4 __attribute__((ext_vector_type(4)));
typedef unsigned u32x2 __attribute__((ext_vector_type(2)));

constexpr int DM = 2048, NBATCH = 4, SEQ = 8192, NMETA = 16;
constexpr int VPAD = 48;
constexpr int LB = 8256;
constexpr int M = NBATCH * SEQ;
constexpr int MQ = M + 64;
constexpr int NINC = 10248;
constexpr int N1 = 10240;
constexpr int DFF = 5632, N5 = 2 * DFF;
constexpr int NHD = 48;

constexpr size_t SZ_W1T = (size_t)N1 * DM * 2, SZ_WAT = (size_t)DM * 1024 * 2, SZ_WOT = (size_t)DM * DM * 2, SZ_W5T = (size_t)N5 * DM * 2, SZ_WDT = (size_t)DM * DFF * 2;
constexpr size_t WS_W1T = 0, WS_WAT = WS_W1T + SZ_W1T, WS_WFT = WS_WAT + SZ_WAT, WS_WOT = WS_WFT + SZ_WAT, WS_W5T = WS_WOT + SZ_WOT, WS_WDT = WS_W5T + SZ_W5T;
constexpr size_t WS_RA = WS_WDT + SZ_WDT;
constexpr size_t SZ_RA = (size_t)MQ * DM * 2;
constexpr size_t WS_RB = WS_RA + SZ_RA;
constexpr size_t SZ_RB = (size_t)NHD * MQ * 128 * 2;
constexpr size_t WS_RG = WS_RB + SZ_RB;
constexpr size_t SZ_RG = (size_t)M * 4096 * 2;
constexpr size_t WS_RSTD1 = WS_RG + SZ_RG, WS_SSQ2 = WS_RSTD1 + (size_t)MQ * 4, WS_SSQ3 = WS_SSQ2 + (size_t)M * 8 * 4;
constexpr size_t WS_LOGF = WS_SSQ3 + (size_t)M * 8 * 4, WS_CUM = WS_LOGF + (size_t)32 * LB * 4;
constexpr size_t WS_SCR = WS_CUM + (size_t)32 * LB * 4;
constexpr size_t WS_KSQ = WS_SCR + (size_t)256 * 262144;
constexpr size_t WS_QCTR = WS_KSQ + (size_t)16 * MQ * 4;
constexpr size_t WS_SSQA = WS_QCTR + 256;
constexpr size_t WS_CNT6 = WS_SSQA + (size_t)M * 8 * 4;
constexpr size_t WS_SLOT6 = WS_CNT6 + (size_t)256 * 256;
constexpr size_t WS_END = WS_SLOT6 + (size_t)32 * M * 4;
constexpr int LDS_BYTES = 131072;

namespace pg8 {
#define PG8_LAS __attribute__((address_space(3)))
constexpr int BM = 256, BK = 64, HALF = 128, HTB = HALF * BK * 2, STAGE_BYTES = 8 * HTB, NXCD = 8, WGM = 8;
__host__ __device__ __forceinline__ int lds_byte(int r, int c) { const int st = (r >> 4) * 2 + (c >> 5), rr = r & 15, cc = c & 31, ob = rr * 64 + cc * 2; return st * 1024 + (ob ^ (((ob >> 9) & 1) << 5)); }
__host__ __device__ __forceinline__ void stage_rc(int b, int& R, int& C) { const int st = b / 1024, sb = b % 1024, swz = sb ^ (((sb >> 9) & 1) << 5); R = (st >> 1) * 16 + swz / 64; C = (st & 1) * 32 + (swz % 64) / 2; }
__host__ __device__ __forceinline__ int perm32(int rho) { const int n = rho >> 4, i = rho & 15; return 8 * (i >> 2) + 4 * n + (i & 3); }
struct Unit { int pm, pn; };
struct Gemm { const bf16_t* A; const bf16_t* Bt; int M, N, K; };
struct StaticOrder {
    int nM, nN, nwg, G, c;
    __host__ __device__ void init(int M_, int N_, int G_, int c_) { nM = M_ / BM; nN = N_ / BM; nwg = nM * nN; G = G_; c = c_; }
    __host__ __device__ bool next(int i, Unit& u) const {
        const long L = (long)i * G + c; if (L >= nwg) return false;
        int wgid = (int)L; { const int q = nwg / NXCD, r = nwg % NXCD, xcd = wgid % NXCD, off = wgid / NXCD; wgid = (xcd < r ? xcd * (q + 1) : r * (q + 1) + (xcd - r) * q) + off; }
        const int nig = WGM * nN, gid = wgid / nig, fm = gid * WGM, gsz = (nM - fm) < WGM ? (nM - fm) : WGM;
        u.pm = fm + ((wgid % nig) % gsz); u.pn = (wgid % nig) / gsz; return true;
    }
    __device__ __forceinline__ void a_ready(const Unit&) const {}
    __device__ __forceinline__ void done(const Unit&) const {}
};
__device__ __forceinline__ unsigned cvt_pk_bf16(float lo, float hi) { unsigned r; asm volatile("v_cvt_pk_bf16_f32 %0, %1, %2" : "=v"(r) : "v"(lo), "v"(hi)); return r; }

template <class Epi, class Sched>
__device__ __forceinline__ void gemm_phase(PG8_LAS unsigned char* lds, const Gemm g, const Sched& S, const Epi& E, const int tid) {
    const int wid = __builtin_amdgcn_readfirstlane(tid >> 6), lane = tid & 63, wr = wid >> 2, wc = wid & 3, fr = lane & 15, fq = lane >> 4;
    const int K = g.K, nt = K / BK;
    unsigned voffA[2], voffB[2];
#pragma unroll
    for (int i = 0; i < 2; ++i) { int R, C; stage_rc(tid * 16 + i * 8192, R, C); const int Rb = Epi::PERM ? ((R & ~31) + perm32(R & 31)) : R;
        voffA[i] = (unsigned)(R * K + C) * 2u; voffB[i] = (unsigned)(Rb * K + C) * 2u; }
    const size_t kstep = (size_t)(BK * 2);
    const size_t hstep = (size_t)HALF * K * 2;
    const size_t tstep = 2 * hstep;
    const unsigned ldsw = (unsigned)wid * 1024u;
    const int aoff = lds_byte(wr * 64 + fr, fq * 8), boff = lds_byte(wc * 32 + fr, fq * 8);
#define PG8_SA(b, h) (((b) * 2 + (h)) * HTB)
#define PG8_SB(b, h) ((4 + (b) * 2 + (h)) * HTB)
#define PG8_STAGE(bufoff, gbase, voff) do { _Pragma("unroll") for (int _i = 0; _i < 2; ++_i) \
        __builtin_amdgcn_global_load_lds((const unsigned*)((const char*)(gbase) + (voff)[_i]), (PG8_LAS unsigned*)(lds + (bufoff) + ldsw + _i * 8192), 16, 0, 0); } while (0)
#define PG8_LDA(dst, b, h) do { _Pragma("unroll") for (int m = 0; m < 4; ++m) _Pragma("unroll") for (int k = 0; k < 2; ++k) dst[m][k] = *(const PG8_LAS bf16x8*)(lds + PG8_SA(b, h) + aoff + m * 2048 + k * 1024); } while (0)
#define PG8_LDB(dst, b, h) do { _Pragma("unroll") for (int n = 0; n < 2; ++n) _Pragma("unroll") for (int k = 0; k < 2; ++k) dst[n][k] = *(const PG8_LAS bf16x8*)(lds + PG8_SB(b, h) + boff + n * 2048 + k * 1024); } while (0)
#define PG8_MMA(ai, bj, At, Bt) do { __builtin_amdgcn_s_setprio(1); _Pragma("unroll") for (int m = 0; m < 4; ++m) _Pragma("unroll") for (int n = 0; n < 2; ++n) _Pragma("unroll") for (int k = 0; k < 2; ++k) \
        acc[ai][bj][m][n] = __builtin_amdgcn_mfma_f32_16x16x32_bf16(Bt[n][k], At[m][k], acc[ai][bj][m][n], 0, 0, 0); __builtin_amdgcn_s_setprio(0); } while (0)
#define PG8_WAIT_V(n) asm volatile("s_waitcnt vmcnt(" #n ")" ::: "memory")
#define PG8_WAIT_L(n) asm volatile("s_waitcnt lgkmcnt(" #n ")" ::: "memory")
#define PG8_BAR __builtin_amdgcn_s_barrier()
#define PG8_SCHED __builtin_amdgcn_sched_barrier(0)
    Unit cur, nxt; int ui = 0;
    if (!S.next(0, cur)) return;
    f32x4 acc[2][2][4][2];
#pragma unroll
    for (int a = 0; a < 2; ++a)
#pragma unroll
        for (int b = 0; b < 2; ++b)
#pragma unroll
            for (int m = 0; m < 4; ++m)
#pragma unroll
                for (int n = 0; n < 2; ++n) acc[a][b][m][n] = (f32x4){0.f, 0.f, 0.f, 0.f};
    bf16x8 At[4][2], B0[2][2], B1[2][2];
    const char* cA = (const char*)g.A + (size_t)cur.pm * tstep; const char* cB = (const char*)g.Bt + (size_t)cur.pn * tstep;
    S.a_ready(cur);
    PG8_STAGE(PG8_SB(0, 0), cB, voffB); PG8_STAGE(PG8_SA(0, 0), cA, voffA); PG8_STAGE(PG8_SB(0, 1), cB + hstep, voffB); PG8_STAGE(PG8_SA(0, 1), cA + hstep, voffA);
    if (wr == 1) PG8_BAR;
    PG8_WAIT_V(4); PG8_BAR;
    PG8_STAGE(PG8_SB(1, 0), cB + kstep, voffB); PG8_STAGE(PG8_SA(1, 0), cA + kstep, voffA); PG8_STAGE(PG8_SB(1, 1), cB + hstep + kstep, voffB);
    PG8_WAIT_V(6); PG8_BAR;
    for (;;) {
        const bool has_next = S.next(ui + 1, nxt);
        const char* nA = has_next ? (const char*)g.A + (size_t)nxt.pm * tstep : cA; const char* nB = has_next ? (const char*)g.Bt + (size_t)nxt.pn * tstep : cB;
        for (int t = 0; t < nt; t += 2) {
            const bool last = (t == nt - 2);
            const char* a1 = cA + (size_t)(t + 1) * kstep;
            const char* a2 = last ? nA : cA + (size_t)(t + 2) * kstep; const char* b2 = last ? nB : cB + (size_t)(t + 2) * kstep;
            const char* a3 = a2 + kstep; const char* b3 = b2 + kstep;
            if (last && has_next) S.a_ready(nxt);
            PG8_LDB(B0, 0, 0); PG8_SCHED; PG8_LDA(At, 0, 0); PG8_STAGE(PG8_SA(1, 1), a1 + hstep, voffA);
            PG8_WAIT_L(8); PG8_BAR; PG8_WAIT_L(0); PG8_MMA(0, 0, At, B0); PG8_BAR; PG8_SCHED;
            PG8_LDB(B1, 0, 1); PG8_STAGE(PG8_SB(0, 0), b2, voffB);
            PG8_BAR; PG8_WAIT_L(0); PG8_MMA(0, 1, At, B1); PG8_BAR;
            PG8_LDA(At, 0, 1); PG8_STAGE(PG8_SA(0, 0), a2, voffA);
            PG8_BAR; PG8_WAIT_L(0); PG8_MMA(1, 0, At, B0); PG8_BAR; PG8_SCHED;
            PG8_STAGE(PG8_SB(0, 1), b2 + hstep, voffB);
            PG8_WAIT_V(6); PG8_BAR; PG8_MMA(1, 1, At, B1); PG8_BAR;
            PG8_LDB(B0, 1, 0); PG8_SCHED; PG8_LDA(At, 1, 0); PG8_STAGE(PG8_SA(0, 1), a2 + hstep, voffA);
            PG8_WAIT_L(8); PG8_BAR; PG8_WAIT_L(0); PG8_MMA(0, 0, At, B0); PG8_BAR; PG8_SCHED;
            PG8_LDB(B1, 1, 1); PG8_STAGE(PG8_SB(1, 0), b3, voffB);
            PG8_BAR; PG8_WAIT_L(0); PG8_MMA(0, 1, At, B1); PG8_BAR;
            PG8_LDA(At, 1, 1); PG8_STAGE(PG8_SA(1, 0), a3, voffA);
            PG8_BAR; PG8_WAIT_L(0); PG8_MMA(1, 0, At, B0); PG8_BAR; PG8_SCHED;
            PG8_STAGE(PG8_SB(1, 1), b3 + hstep, voffB);
            PG8_WAIT_V(6); PG8_BAR; PG8_MMA(1, 1, At, B1); PG8_BAR;
        }
        E(acc, cur, wr, wc, fr, fq); S.done(cur);
        if (!has_next) break;
#pragma unroll
        for (int a = 0; a < 2; ++a)
#pragma unroll
            for (int b = 0; b < 2; ++b)
#pragma unroll
                for (int m = 0; m < 4; ++m)
#pragma unroll
                    for (int n = 0; n < 2; ++n) acc[a][b][m][n] = (f32x4){0.f, 0.f, 0.f, 0.f};
        cur = nxt; cA = nA; cB = nB; ++ui;
    }
    PG8_WAIT_V(0);
    if (wr == 0) PG8_BAR;
    PG8_BAR;
#undef PG8_SA
#undef PG8_SB
#undef PG8_STAGE
#undef PG8_LDA
#undef PG8_LDB
#undef PG8_MMA
#undef PG8_WAIT_V
#undef PG8_WAIT_L
#undef PG8_BAR
#undef PG8_SCHED
}
}

__device__ __forceinline__ int fresh_lane() { int l; asm volatile("v_mbcnt_lo_u32_b32 %0, -1, 0\n\tv_mbcnt_hi_u32_b32 %0, -1, %0" : "=v"(l)); return l; }
__device__ __forceinline__ float bf2f(unsigned short b) { return __uint_as_float(((unsigned)b) << 16); }
__device__ __forceinline__ float sigmoidf_(float x) { return __builtin_amdgcn_rcpf(1.0f + __builtin_amdgcn_exp2f(-1.4426950408889634f * x)); }
__device__ __forceinline__ u32x4 pack8u(f32x4 a, f32x4 b) { u32x4 w = {pg8::cvt_pk_bf16(a[0], a[1]), pg8::cvt_pk_bf16(a[2], a[3]), pg8::cvt_pk_bf16(b[0], b[1]), pg8::cvt_pk_bf16(b[2], b[3])}; return w; }
__device__ __forceinline__ void unpack8(u32x4 w, f32x4& a, f32x4& b) {
    a = (f32x4){__uint_as_float(w.x << 16), __uint_as_float(w.x & 0xffff0000u), __uint_as_float(w.y << 16), __uint_as_float(w.y & 0xffff0000u)};
    b = (f32x4){__uint_as_float(w.z << 16), __uint_as_float(w.z & 0xffff0000u), __uint_as_float(w.w << 16), __uint_as_float(w.w & 0xffff0000u)};
}
__device__ __forceinline__ float shx(float v, int o, int ln) { return __uint_as_float((unsigned)__builtin_amdgcn_ds_bpermute((ln ^ o) << 2, (int)__float_as_uint(v))); }
__device__ __forceinline__ float wave_sum(float v) {
#pragma unroll
    for (int o = 32; o >= 1; o >>= 1) v += __shfl_xor(v, o);
    return v;
}

typedef f32x4 Acc[2][2][4][2];
struct Epi1 { static constexpr bool PERM = true;
    bf16_t* QKV; bf16_t* GATES; const float* rstd; float* KSQ;
    __device__ __forceinline__ void operator()(const Acc& acc, const pg8::Unit& u, int wr, int wc, int fr, int fq) const {
        const int row0 = u.pm * 256 + wr * 64 + fr;
        if (u.pn < 24) {
            const bool iskh = (u.pn >= 4 && u.pn < 8) || (u.pn >= 16 && u.pn < 20);
            const int ks0 = u.pn < 8 ? 2 * u.pn - 8 : 2 * u.pn - 32 + 8;
#pragma unroll
            for (int ai = 0; ai < 2; ++ai)
#pragma unroll
                for (int m = 0; m < 4; ++m) { const int row = row0 + ai * 128 + m * 16; const float rs = rstd[row];
#pragma unroll
                    for (int bj = 0; bj < 2; ++bj) { bf16_t* dst = QKV + ((size_t)(2 * u.pn + bj) * MQ + row) * 128 + wc * 32 + 8 * fq;
                        const f32x4 v0 = acc[ai][bj][m][0] * rs, v1 = acc[ai][bj][m][1] * rs;
                        *(u32x4*)dst = pack8u(v0, v1);
                        if (iskh) { float ss = (v0[0] * v0[0] + v0[1] * v0[1]) + (v0[2] * v0[2] + v0[3] * v0[3]) + (v1[0] * v1[0] + v1[1] * v1[1]) + (v1[2] * v1[2] + v1[3] * v1[3]);
                            ss += __shfl_xor(ss, 16); ss += __shfl_xor(ss, 32);
                            if (fq == 0) atomicAdd(KSQ + (size_t)(ks0 + bj) * MQ + row, ss); } } }
        } else {
            const int colb = (u.pn - 24) * 256 + wc * 32 + 8 * fq;
#pragma unroll
            for (int ai = 0; ai < 2; ++ai)
#pragma unroll
                for (int m = 0; m < 4; ++m) { const int row = row0 + ai * 128 + m * 16; const float rs = rstd[row];
#pragma unroll
                    for (int bj = 0; bj < 2; ++bj) { f32x4 v0 = acc[ai][bj][m][0] * rs, v1 = acc[ai][bj][m][1] * rs;
#pragma unroll
                        for (int j = 0; j < 4; ++j) { v0[j] = sigmoidf_(v0[j]); v1[j] = sigmoidf_(v1[j]); }
                        *(u32x4*)(GATES + (size_t)row * 4096 + colb + bj * 128) = pack8u(v0, v1); } }
        }
    }
};
struct Epi3a { static constexpr bool PERM = true;
    float* TMP; const bf16_t* GATES;
    __device__ __forceinline__ void operator()(const Acc& acc, const pg8::Unit& u, int wr, int wc, int fr, int fq) const {
        const int row0 = u.pm * 256 + wr * 64 + fr, col0 = u.pn * 256 + wc * 32 + 8 * fq;
#pragma unroll
        for (int ai = 0; ai < 2; ++ai)
#pragma unroll
            for (int m = 0; m < 4; ++m) { const int row = row0 + ai * 128 + m * 16;
#pragma unroll
                for (int bj = 0; bj < 2; ++bj) { const int col = col0 + bj * 128; f32x4 g0, g1; unpack8(*(const u32x4*)(GATES + (size_t)row * 4096 + col), g0, g1);
                    float* d = TMP + (size_t)row * DM + col; *(f32x4*)d = acc[ai][bj][m][0] * g0; *(f32x4*)(d + 4) = acc[ai][bj][m][1] * g1; } }
    }
};
struct Epi3b { static constexpr bool PERM = true;
    const float* TMP; const bf16_t* GATES; bf16_t* MERGED;
    __device__ __forceinline__ void operator()(const Acc& acc, const pg8::Unit& u, int wr, int wc, int fr, int fq) const {
        const int row0 = u.pm * 256 + wr * 64 + fr, col0 = u.pn * 256 + wc * 32 + 8 * fq;
#pragma unroll
        for (int ai = 0; ai < 2; ++ai)
#pragma unroll
            for (int m = 0; m < 4; ++m) { const int row = row0 + ai * 128 + m * 16;
#pragma unroll
                for (int bj = 0; bj < 2; ++bj) { const int col = col0 + bj * 128; f32x4 g0, g1; unpack8(*(const u32x4*)(GATES + (size_t)row * 4096 + 2048 + col), g0, g1);
                    const float* s = TMP + (size_t)row * DM + col; const f32x4 t0 = *(const f32x4*)s, t1 = *(const f32x4*)(s + 4);
                    *(u32x4*)(MERGED + (size_t)row * DM + col) = pack8u(t0 + acc[ai][bj][m][0] * g0, t1 + acc[ai][bj][m][1] * g1); } }
    }
};
struct Epi4 { static constexpr bool PERM = true;
    const float* x; float* out; bf16_t* H1B; float* ssq;
    __device__ __forceinline__ void operator()(const Acc& acc, const pg8::Unit& u, int wr, int wc, int fr, int fq) const {
        const int row0 = u.pm * 256 + wr * 64 + fr, col0 = u.pn * 256 + wc * 32 + 8 * fq;
#pragma unroll
        for (int ai = 0; ai < 2; ++ai)
#pragma unroll
            for (int m = 0; m < 4; ++m) { const int row = row0 + ai * 128 + m * 16; const size_t orow = (size_t)row; float ss = 0.f;
#pragma unroll
                    for (int bj = 0; bj < 2; ++bj) { const int col = col0 + bj * 128; const float* xs = x + orow * DM + col;
                        const f32x4 h0 = *(const f32x4*)xs + acc[ai][bj][m][0], h1 = *(const f32x4*)(xs + 4) + acc[ai][bj][m][1];
                        float* d = out + orow * DM + col; *(f32x4*)d = h0; *(f32x4*)(d + 4) = h1;
                        *(u32x4*)(H1B + (size_t)row * DM + col) = pack8u(h0, h1);
                        ss += (h0[0] * h0[0] + h0[1] * h0[1]) + (h0[2] * h0[2] + h0[3] * h0[3]) + (h1[0] * h1[0] + h1[1] * h1[1]) + (h1[2] * h1[2] + h1[3] * h1[3]); }
                    ss += __shfl_xor(ss, 16); ss += __shfl_xor(ss, 32);
                    if (fq == 0) atomicAdd(ssq + (size_t)u.pn * M + row, ss); }
    }
};
struct Epi5 { static constexpr bool PERM = true;
    const float* ssq; bf16_t* ACT;
    __device__ __forceinline__ void operator()(const Acc& acc, const pg8::Unit& u, int wr, int wc, int fr, int fq) const {
        const int row0 = u.pm * 256 + wr * 64 + fr, col0 = u.pn * 128 + wc * 32 + 8 * fq;
#pragma unroll
        for (int ai = 0; ai < 2; ++ai)
#pragma unroll
            for (int m = 0; m < 4; ++m) { const int row = row0 + ai * 128 + m * 16; float sq = 0.f;
#pragma unroll
                for (int t = 0; t < 8; ++t) sq += ssq[(size_t)t * M + row];
                const float rs = __builtin_amdgcn_rsqf(sq * (1.0f / 2048.0f) + 1e-6f);
                f32x4 o[2];
#pragma unroll
                for (int n = 0; n < 2; ++n) { const f32x4 g = acc[ai][0][m][n] * rs, up = acc[ai][1][m][n] * rs;
#pragma unroll
                    for (int j = 0; j < 4; ++j) o[n][j] = g[j] * sigmoidf_(g[j]) * up[j]; }
                *(u32x4*)(ACT + (size_t)row * DFF + col0) = pack8u(o[0], o[1]); }
    }
};
struct Epi6 { static constexpr bool PERM = true;
    float* out; float* ssq;
    __device__ __forceinline__ void operator()(const Acc& acc, const pg8::Unit& u, int wr, int wc, int fr, int fq) const {
        const int row0 = u.pm * 256 + wr * 64 + fr, col0 = u.pn * 256 + wc * 32 + 8 * fq;
#pragma unroll
        for (int ai = 0; ai < 2; ++ai)
#pragma unroll
            for (int m = 0; m < 4; ++m) { const int row = row0 + ai * 128 + m * 16; const size_t orow = (size_t)row; float ss = 0.f;
#pragma unroll
                    for (int bj = 0; bj < 2; ++bj) { const int col = col0 + bj * 128; float* d = out + orow * DM + col;
                        const f32x4 h0 = *(const f32x4*)d + acc[ai][bj][m][0], h1 = *(const f32x4*)(d + 4) + acc[ai][bj][m][1];
                        *(f32x4*)d = h0; *(f32x4*)(d + 4) = h1;
                        ss += (h0[0] * h0[0] + h0[1] * h0[1]) + (h0[2] * h0[2] + h0[3] * h0[3]) + (h1[0] * h1[0] + h1[1] * h1[1]) + (h1[2] * h1[2] + h1[3] * h1[3]); }
                    ss += __shfl_xor(ss, 16); ss += __shfl_xor(ss, 32);
                    if (fq == 0) atomicAdd(ssq + (size_t)u.pn * M + row, ss); }
    }
};

struct Epi6F { static constexpr bool PERM = true;
    float* out; float* slots; unsigned* cnt; const float* gfin;
    __device__ __forceinline__ void operator()(const Acc& acc_, const pg8::Unit& u, int wr, int wc, int fr, int fq) const {
        Acc& acc = const_cast<Acc&>(acc_);
        const int row0 = u.pm * 256 + wr * 64 + fr, col0 = u.pn * 256 + wc * 32 + 8 * fq;
        float* myslot = slots + (size_t)(u.pn * 4 + wc) * M;
#pragma unroll
        for (int ai = 0; ai < 2; ++ai)
#pragma unroll
            for (int m = 0; m < 4; ++m) { const int row = row0 + ai * 128 + m * 16; float ss = 0.f;
#pragma unroll
                for (int bj = 0; bj < 2; ++bj) { const float* d = out + (size_t)row * DM + col0 + bj * 128;
                    const f32x4 h0 = *(const f32x4*)d + acc[ai][bj][m][0], h1 = *(const f32x4*)(d + 4) + acc[ai][bj][m][1];
                    acc[ai][bj][m][0] = h0; acc[ai][bj][m][1] = h1;
                    ss += (h0[0] * h0[0] + h0[1] * h0[1]) + (h0[2] * h0[2] + h0[3] * h0[3]) + (h1[0] * h1[0] + h1[1] * h1[1]) + (h1[2] * h1[2] + h1[3] * h1[3]); }
                ss += __shfl_xor(ss, 16); ss += __shfl_xor(ss, 32);
                if (fq == 0) __hip_atomic_store(myslot + row, ss, __ATOMIC_RELAXED, __HIP_MEMORY_SCOPE_AGENT); }
        asm volatile("s_waitcnt vmcnt(0)" ::: "memory");
        unsigned* c = cnt + 64 * (2 * u.pm + wr);
        if ((fr | fq) == 0) __hip_atomic_fetch_add(c, 1u, __ATOMIC_RELAXED, __HIP_MEMORY_SCOPE_AGENT);
        { const unsigned long long t0 = __builtin_amdgcn_s_memrealtime();
          while ((unsigned)__builtin_amdgcn_readfirstlane(__hip_atomic_load(c, __ATOMIC_RELAXED, __HIP_MEMORY_SCOPE_AGENT)) < 32u) {
              if (__builtin_amdgcn_s_memrealtime() - t0 > 2000000ull) break;
              __builtin_amdgcn_s_sleep(2); } }
        __builtin_amdgcn_fence(__ATOMIC_ACQUIRE, "agent");
#pragma unroll
        for (int ai = 0; ai < 2; ++ai)
#pragma unroll
            for (int m = 0; m < 4; ++m) { const int row = row0 + ai * 128 + m * 16; float sq = 0.f;
#pragma unroll
                for (int t = 0; t < 8; ++t) sq += __hip_atomic_load(slots + (size_t)(fq * 8 + t) * M + row, __ATOMIC_RELAXED, __HIP_MEMORY_SCOPE_AGENT);
                sq += __shfl_xor(sq, 16); sq += __shfl_xor(sq, 32);
                const float rs = __builtin_amdgcn_rsqf(sq * (1.0f / 2048.0f) + 1e-6f);
#pragma unroll
                for (int bj = 0; bj < 2; ++bj) { float* d = out + (size_t)row * DM + col0 + bj * 128; const float* gp = gfin + col0 + bj * 128;
                    *(f32x4*)d = acc[ai][bj][m][0] * rs * *(const f32x4*)gp; *(f32x4*)(d + 4) = acc[ai][bj][m][1] * rs * *(const f32x4*)(gp + 4); } }
    }
};
struct PanelOrder { int c;
    __device__ __forceinline__ bool next(int i, pg8::Unit& u) const { if (i >= 4) return false; const int x = c & 7, j = c >> 3; u.pm = 32 * i + 4 * x + (j >> 3); u.pn = j & 7; return true; }
    __device__ __forceinline__ void a_ready(const pg8::Unit&) const {}
    __device__ __forceinline__ void done(const pg8::Unit&) const {}
};

namespace att {
constexpr int D = 128, NW = 8, QBLK = 32, KVBLK = 64, QB = 256;
constexpr int SHM_V = KVBLK * D * 2, SHM_K = KVBLK * D * 2;
constexpr int LDS_WS = 3 * SHM_V + 2 * SHM_K;
constexpr int LDS_TAB = LDS_WS + NW * 64 * 4;
constexpr float SCALE = 0.08838834764831845f;
constexpr float THR = 8.f;
#define KSWZ(row, colB) ((row) * 256 + ((colB) ^ (((row) & 7) << 4)))
#define SBAR() __builtin_amdgcn_sched_barrier(0)
__device__ __forceinline__ int v_st(int k, int c) { const int kk = (k & ~0xC) | ((k & 4) << 1) | ((k & 8) >> 1); return ((kk >> 3) * 4 + (c >> 5)) * 512 + ((kk & 7) * 32 + (c & 31)) * 2; }
__device__ __forceinline__ int v_rd_base(int lane) { return ((lane & 3) << 3) | (((lane >> 2) & 3) << 6) | (((lane >> 4) & 1) << 5) | (((lane >> 5) & 1) << 8); }
constexpr int v_rd_off(int d0, int ks, int half) { return d0 * 512 + ks * 4096 + half * 2048; }
__device__ __forceinline__ int crow(int r, int hi) { return (r & 3) + 8 * (r >> 2) + 4 * hi; }
__device__ __forceinline__ unsigned cvtpk(float lo, float hi) { unsigned r; asm volatile("v_cvt_pk_bf16_f32 %0, %1, %2" : "=v"(r) : "v"(lo), "v"(hi)); return r; }
__device__ __forceinline__ bf16x8 load8(const bf16_t* p) { return *reinterpret_cast<const bf16x8*>(p); }
__device__ __forceinline__ void mask_tile(f32x16& p0, f32x16& p1, int dqe, int dqt, unsigned W, float s2) {
    const float NEG = -__builtin_inff();
#pragma unroll
    for (int r = 0; r < 16; ++r) {
        const int c = (r & 3) + 8 * (r >> 2);
        const int a0 = c - dqt, a1 = c + 32 - dqt;
        p0[r] -= s2 * (float)(a0 > 0 ? a0 : 0);
        p1[r] -= s2 * (float)(a1 > 0 ? a1 : 0);
        if ((unsigned)(dqe - c) >= W) p0[r] = NEG;
        if ((unsigned)(dqe - c - 32) >= W) p1[r] = NEG;
    }
}
__device__ __forceinline__ void partialSM(f32x16& p0, f32x16& p1, float& m_reg, float& mn, float& alpha, bool& skip) {
    float pmax = p0[0]; for (int r = 1; r < 16; ++r) pmax = fmaxf(pmax, p0[r]); for (int r = 0; r < 16; ++r) pmax = fmaxf(pmax, p1[r]);
    { auto rr = __builtin_amdgcn_permlane32_swap(__float_as_uint(pmax), __float_as_uint(pmax), false, false);
      pmax = fmaxf(__uint_as_float(rr[0]), __uint_as_float(rr[1])); }
    constexpr float C2 = 1.4426950408889634f * SCALE;
    skip = __all((pmax - m_reg) * C2 < -150.f);
    if (skip) { mn = m_reg; alpha = 1.f; return; }
    if (__builtin_expect(__all((pmax - m_reg) * SCALE <= THR), 1)) { mn = m_reg; alpha = 1.f; }
    else { mn = fmaxf(m_reg, pmax); alpha = __builtin_amdgcn_exp2f((m_reg - mn) * C2); m_reg = mn; }
    const float mnL = -mn * C2;
    for (int r = 0; r < 16; ++r) p0[r] = fmaf(p0[r], C2, mnL); for (int r = 0; r < 16; ++r) p1[r] = fmaf(p1[r], C2, mnL);
    for (int r = 0; r < 16; ++r) p0[r] = __builtin_amdgcn_exp2f(p0[r]);
}
__device__ __forceinline__ void finishSM(f32x16& p0, f32x16& p1, float alpha, float& l_reg, bf16x8& pa0, bf16x8& pa1, bf16x8& pa2, bf16x8& pa3) {
    for (int r = 0; r < 16; ++r) p1[r] = __builtin_amdgcn_exp2f(p1[r]);
    float ps = 0; for (int r = 0; r < 16; ++r) ps += p0[r]; for (int r = 0; r < 16; ++r) ps += p1[r];
    { auto rr = __builtin_amdgcn_permlane32_swap(__float_as_uint(ps), __float_as_uint(ps), false, false);
      ps = __uint_as_float(rr[0]) + __uint_as_float(rr[1]); }
    l_reg = l_reg * alpha + ps;
#define PK4(P, B_, OUT) do { unsigned a0 = cvtpk(P[B_+0], P[B_+1]), a1 = cvtpk(P[B_+2], P[B_+3]);                          \
        unsigned b0 = cvtpk(P[B_+4], P[B_+5]), b1 = cvtpk(P[B_+6], P[B_+7]);                                             \
        auto r0 = __builtin_amdgcn_permlane32_swap(a0, b0, false, false); auto r1 = __builtin_amdgcn_permlane32_swap(a1, b1, false, false); \
        u32x4 w = {r0[0], r1[0], r0[1], r1[1]}; OUT = *reinterpret_cast<bf16x8*>(&w); } while (0)
    PK4(p0, 0, pa0); PK4(p0, 8, pa1); PK4(p1, 0, pa2); PK4(p1, 8, pa3);
#undef PK4
}
template <int KB>
__device__ __forceinline__ void qkt(f32x16& p0, f32x16& p1, const char* K_lds, int r32, int hi, const bf16x8* qr) {
    p0 = f32x16{}; p1 = f32x16{};
    const char* kb[4];
#pragma unroll
    for (int dd = 0; dd < 4; ++dd) kb[dd] = K_lds + KB * SHM_K + KSWZ(r32, (dd * 16 + hi * 8) * 2);
#pragma unroll
    for (int d0 = 0; d0 < 8; ++d0) { const char* a = kb[d0 & 3] + (d0 >> 2) * 128;
        bf16x8 b0 = *reinterpret_cast<const bf16x8*>(a);
        bf16x8 b1 = *reinterpret_cast<const bf16x8*>(a + 32 * 256);
        p0 = __builtin_amdgcn_mfma_f32_32x32x16_bf16(b0, qr[d0], p0, 0, 0, 0);
        p1 = __builtin_amdgcn_mfma_f32_32x32x16_bf16(b1, qr[d0], p1, 0, 0, 0); }
}
__device__ __forceinline__ void pv_tile(f32x16* o, int vb0, bf16x8 pa0, bf16x8 pa1, bf16x8 pa2, bf16x8 pa3) {
#define TRRD(dst, off) asm volatile("ds_read_b64_tr_b16 %0, %1 offset:%2" : "=&v"(dst) : "v"(vb0), "i"(off) : "memory")
#define PV_D0(d0) do { s16x4 l0, l1, l2, l3, h0, h1, h2, h3; constexpr int b_ = v_rd_off(d0, 0, 0); \
        TRRD(l0, b_); TRRD(h0, b_ + 2048); TRRD(l1, b_ + 4096); TRRD(h1, b_ + 6144); TRRD(l2, b_ + 8192); TRRD(h2, b_ + 10240); TRRD(l3, b_ + 12288); TRRD(h3, b_ + 14336); \
        asm volatile("s_waitcnt lgkmcnt(0)" ::: "memory"); SBAR();   \
        o[d0] = __builtin_amdgcn_mfma_f32_32x32x16_bf16(pa0, (bf16x8){l0[0], l0[1], l0[2], l0[3], h0[0], h0[1], h0[2], h0[3]}, o[d0], 0, 0, 0);   \
        o[d0] = __builtin_amdgcn_mfma_f32_32x32x16_bf16(pa1, (bf16x8){l1[0], l1[1], l1[2], l1[3], h1[0], h1[1], h1[2], h1[3]}, o[d0], 0, 0, 0);   \
        o[d0] = __builtin_amdgcn_mfma_f32_32x32x16_bf16(pa2, (bf16x8){l2[0], l2[1], l2[2], l2[3], h2[0], h2[1], h2[2], h2[3]}, o[d0], 0, 0, 0);   \
        o[d0] = __builtin_amdgcn_mfma_f32_32x32x16_bf16(pa3, (bf16x8){l3[0], l3[1], l3[2], l3[3], h3[0], h3[1], h3[2], h3[3]}, o[d0], 0, 0, 0); } while (0)
    PV_D0(0); PV_D0(1); PV_D0(2); PV_D0(3);
#undef PV_D0
#undef TRRD
}
struct Blk { const bf16_t* Q; const bf16_t* K; const bf16_t* V; const bf16_t* K0; const bf16_t* V0; bf16_t* O; int P0; int mode; float s2; };
struct Seam { bf16x8 qr[8]; bf16x8 st_v0, st_v1, st_k0, st_k1; };
#define ROW(p, k0, rr) ((p) + (size_t)((k0) + (rr)) * D + sc)
#define VMW() asm volatile("s_waitcnt vmcnt(0)" ::: "memory")
#define VMWN(n) asm volatile("s_waitcnt vmcnt(%0)" :: "i"(n) : "memory")
#define SLOAD_H(Kp, Vp, k0) do { S.st_v0 = load8(ROW(Vp, k0, sr)); S.st_v1 = load8(ROW(Vp, k0, 32 + sr));              \
                         S.st_k0 = load8(ROW(Kp, k0, sr)); S.st_k1 = load8(ROW(Kp, k0, 32 + sr)); } while (0)
#define SWRITE_HK(bf) do { *(bf16x8*)(K_lds + (bf) * SHM_K + kws) = S.st_k0; *(bf16x8*)(K_lds + (bf) * SHM_K + kws + 32 * 256) = S.st_k1; } while (0)
#define SWRITE_HV(bf) do { *(bf16x8*)(V_lds + (bf) * SHM_V + vst0) = S.st_v0; *(bf16x8*)(V_lds + (bf) * SHM_V + vst1) = S.st_v1; } while (0)
#define SWRITE_H(bf) do { SWRITE_HV(bf); SWRITE_HK(bf); } while (0)
__device__ __forceinline__ void attn_prime(const Blk& cur, char* lds, Seam& S, const int tid) {
    const int wid = __builtin_amdgcn_readfirstlane(tid >> 6), lane = tid & 63, r32 = lane & 31, hi = lane >> 5;
    for (int d0 = 0; d0 < 8; ++d0) S.qr[d0] = load8(cur.Q + (size_t)(wid * QBLK + r32) * D + d0 * 16 + hi * 8);
}
__device__ __forceinline__ void attn_block(const Blk& cur, const bf16_t* nxtQ, char* lds, Seam& S, float lam, float* scrT, const bf16_t* OAb, float* SSQAb, const int tid, const int j_lo) {
    const int wid = __builtin_amdgcn_readfirstlane(tid >> 6), lane = tid & 63, r32 = lane & 31, hi = lane >> 5;
    const int NT = (cur.P0 + QB - 1) / KVBLK + 1 - j_lo;
    const int qlo = cur.P0 + wid * QBLK;
    const int qt4 = qlo + r32 - 4 * hi;
    const bool isdiff = cur.mode != 0;
    char* V_lds = lds; char* K_lds = lds + 3 * SHM_V;
    float* ws = (float*)(lds + LDS_WS) + wid * 64; float* li_l = ws, * al_l = ws + 32;
    float m_reg = ((const float*)(lds + LDS_TAB))[qlo + r32] - 45.254834f, l_reg = 0; f32x16 o[4] = {};
    const int sr = tid >> 4, sc = (tid & 15) * 8, vst0 = v_st(sr, sc), vst1 = v_st(32 + sr, sc), kws = KSWZ(sr, sc * 2);
    const int vb0 = (int)(uintptr_t)V_lds + v_rd_base(lane);
    const bf16_t* Kh = cur.K; const bf16_t* Vh = cur.V;
#define RESC(a) do { if (__any((a) < 1.f)) { if (hi == 0) al_l[r32] = (a); asm volatile("s_waitcnt lgkmcnt(0)" ::: "memory");              \
                     for (int d_ = 0; d_ < 4; ++d_) for (int r = 0; r < 16; ++r) o[d_][r] *= al_l[crow(r, hi)]; } } while (0)
#define KBASE(t) ((j_lo + (t)) * KVBLK)
#define BIAS(P0_, P1_, t) do { int h_ = hi; asm volatile("" : "+v"(h_)); const float* tb_ = (const float*)(lds + LDS_TAB) + (4 * h_ + KBASE(t));         \
        _Pragma("unroll") for (int i_ = 0; i_ < 4; ++i_) { const f32x4 b0_ = *(const f32x4*)(tb_ + 8 * i_), b1_ = *(const f32x4*)(tb_ + 32 + 8 * i_); \
            _Pragma("unroll") for (int j_ = 0; j_ < 4; ++j_) { P0_[4 * i_ + j_] += b0_[j_]; P1_[4 * i_ + j_] += b1_[j_]; } } } while (0)
#define MASKT(P0_, P1_, t) do { const int kb_ = KBASE(t); BIAS(P0_, P1_, t); if (kb_ + KVBLK - 1 > qlo || kb_ == 0) { int q_ = qt4; asm volatile("" : "+v"(q_)); const int qt_ = q_ + 4 * hi, qe_ = isdiff ? (qt_ | 63) : qt_;      \
            mask_tile(P0_, P1_, qe_ - kb_ - 4 * hi, q_ - kb_, (unsigned)(qe_ - 47), cur.s2); } } while (0)
#define SEAM_K0() do { VMWN(8); SWRITE_HK(0); SBAR(); } while (0)
    f32x16 pA0, pA1, pB0, pB1; float mnA, mnB, alA, alB; bf16x8 pa0, pa1, pa2, pa3; bool skA, skB;
    { const bf16_t* kp = j_lo == 0 ? cur.K0 : Kh + (size_t)j_lo * KVBLK * D; const bf16_t* vp = j_lo == 0 ? cur.V0 : Vh + (size_t)j_lo * KVBLK * D;
      SLOAD_H(kp, vp, 0); VMW(); SWRITE_H(0); SBAR(); }
    if (NT > 1) { SLOAD_H(Kh, Vh, KBASE(1)); }
    __syncthreads();
    SBAR(); qkt<0>(pA0, pA1, K_lds, r32, hi, S.qr);
    MASKT(pA0, pA1, 0); partialSM(pA0, pA1, m_reg, mnA, alA, skA);
    if (NT > 1) { VMW(); SWRITE_H(1); }
    __syncthreads();
#define HALF_STEP(PX0, PX1, mnX, alX, skX, PY0, PY1, alY, skY, t, KB, VB, SB_) do {                                                      \
        SBAR(); qkt<KB>(PX0, PX1, K_lds, r32, hi, S.qr);                                             \
        if (!(skY)) finishSM(PY0, PY1, alY, l_reg, pa0, pa1, pa2, pa3); SBAR();                                               \
        if ((t) + 1 < NT) { SLOAD_H(Kh, Vh, KBASE((t) + 1)); SBAR(); }                                               \
        if (!(skY)) pv_tile(o, vb0 + vprev * SHM_V, pa0, pa1, pa2, pa3); MASKT(PX0, PX1, (t)); partialSM(PX0, PX1, m_reg, mnX, alX, skX);                        \
        if ((t) + 1 < NT) { VMW(); SWRITE_HK(SB_); SWRITE_HV(vprev == 0 ? 2 : vprev - 1); }     \
        RESC(alX); __syncthreads(); vprev = vprev == 2 ? 0 : vprev + 1; } while (0)
    int vprev = 0;
    for (int t = 1; t + 1 < NT; t += 2) {
        HALF_STEP(pB0, pB1, mnB, alB, skB, pA0, pA1, alA, skA, t, 1, 0, 0);
        HALF_STEP(pA0, pA1, mnA, alA, skA, pB0, pB1, alB, skB, t + 1, 0, 1, 1);
    }
    const bool even = (NT & 1) == 0;
    if (even) { SBAR(); qkt<1>(pB0, pB1, K_lds, r32, hi, S.qr); SBAR(); }
    { int t2 = tid; asm volatile("" : "+v"(t2));
      const int l2 = t2 & 63;
      const unsigned qoff = (unsigned)((wid * QBLK + (l2 & 31)) * D + (l2 >> 5) * 8);
#pragma unroll
      for (int d0 = 0; d0 < 8; ++d0) S.qr[d0] = load8(nxtQ + qoff + d0 * 16); }
    SBAR();
    if (!skA) finishSM(pA0, pA1, alA, l_reg, pa0, pa1, pa2, pa3); SBAR();
    if (!skA) pv_tile(o, vb0 + ((even ? NT - 2 : NT - 1) % 3) * SHM_V, pa0, pa1, pa2, pa3);
    if (even) { MASKT(pB0, pB1, NT - 1); partialSM(pB0, pB1, m_reg, mnB, alB, skB); __syncthreads(); RESC(alB);
        if (!skB) { finishSM(pB0, pB1, alB, l_reg, pa0, pa1, pa2, pa3); SBAR(); pv_tile(o, vb0 + ((NT - 1) % 3) * SHM_V, pa0, pa1, pa2, pa3); } }
    SBAR();
    int ln = lane; asm volatile("" : "+v"(ln));
    const int r32e = ln & 31;
    if (hi == 0) li_l[r32] = l_reg; asm volatile("s_waitcnt lgkmcnt(0)" ::: "memory");
    float rli[16];
#pragma unroll
    for (int r = 0; r < 16; ++r) rli[r] = __builtin_amdgcn_rcpf(li_l[crow(r, hi)]);
    const int mode = cur.mode;
    if (mode == 0) {
        bf16_t* Ow = cur.O + (size_t)(wid * QBLK) * 1024;
#pragma unroll
        for (int r = 0; r < 16; ++r) { const int orow = crow(r, hi);
#pragma unroll
            for (int d0 = 0; d0 < 4; ++d0) { const float v = o[d0][r] * rli[r]; const float vn = shx(v, 1, ln);
                if ((r32e & 1) == 0) *(unsigned*)(Ow + (orow * 1024 + d0 * 32 + r32e)) = cvtpk(v, vn); } }
    } else if (mode == 1) {
        float* T = scrT + (wid * 4096 + ln);
#pragma unroll
        for (int r = 0; r < 16; ++r)
#pragma unroll
            for (int d0 = 0; d0 < 4; ++d0) T[(r * 4 + d0) * 64] = o[d0][r] * rli[r];
    } else {
        const float* T = scrT + (wid * 4096 + ln);
        bf16_t* Ow = cur.O + (size_t)(wid * QBLK) * 1024; const size_t oo = (size_t)(cur.O - OAb); float* SSw = SSQAb + (oo >> 10) * 8 + ((oo >> 7) & 7) + (wid * QBLK) * 8;
#pragma unroll
        for (int r = 0; r < 16; ++r) { const int orow = crow(r, hi); float ss = 0.f;
#pragma unroll
            for (int d0 = 0; d0 < 4; ++d0) { const float v = __hip_atomic_load(T + (r * 4 + d0) * 64, __ATOMIC_RELAXED, __HIP_MEMORY_SCOPE_AGENT) - lam * (o[d0][r] * rli[r]); ss += v * v;
                const float vn = shx(v, 1, ln);
                if ((r32e & 1) == 0) *(unsigned*)(Ow + (orow * 1024 + d0 * 32 + r32e)) = cvtpk(v, vn); }
            ss += shx(ss, 1, ln); ss += shx(ss, 2, ln); ss += shx(ss, 4, ln); ss += shx(ss, 8, ln); ss += shx(ss, 16, ln);
            if (r32e == 0) SSw[orow * 8] = ss; }
    }
    __syncthreads();
#undef RESC
#undef KBASE
#undef BIAS
#undef MASKT
#undef SEAM_K0
#undef HALF_STEP
}
#undef ROW
#undef VMW
#undef VMWN
#undef SLOAD_H
#undef SWRITE_HK
#undef SWRITE_HV
#undef SWRITE_H
}

__device__ __forceinline__ float metak2(const bf16_t* K0, int k) {
    if (k < VPAD) return 0.f;
    float a = 0.f;
    for (int q = 0; q < 16; ++q) { f32x4 x0, x1; unpack8(*(const u32x4*)(K0 + (size_t)k * 128 + q * 8), x0, x1); a += (x0[0] * x0[0] + x0[1] * x0[1]) + (x0[2] * x0[2] + x0[3] * x0[3]) + (x1[0] * x1[0] + x1[1] * x1[1]) + (x1[2] * x1[2] + x1[3] * x1[3]); }
    return a;
}
struct Params { const float* in[18]; float* out; unsigned char* ws; int ph_lo, ph_hi; };

__device__ __forceinline__ void transpose_job(const float* __restrict__ src, int ld, int col0, int nN, int Kdim, bf16_t* __restrict__ dst, int up, const float* __restrict__ scale, float* tile, const int tid) {
    const int nK = Kdim / 64, total = nK * nN;
    f32x4 v[2];
    int t = blockIdx.x;
    if (t < total) { const int k0 = (t / nN) * 64, n0 = (t % nN) * 64;
#pragma unroll
        for (int i = 0; i < 2; ++i) { const int idx = tid + 512 * i, kk = idx >> 4, c4 = idx & 15; v[i] = *(const f32x4*)(src + (size_t)(k0 + kk) * ld + col0 + n0 + c4 * 4) * (scale ? scale[k0 + kk] : 1.0f); } }
    for (; t < total; t += gridDim.x) {
        const int k0 = (t / nN) * 64, n0 = (t % nN) * 64;
#pragma unroll
        for (int i = 0; i < 2; ++i) { const int idx = tid + 512 * i, kk = idx >> 4, c4 = idx & 15;
#pragma unroll
            for (int j = 0; j < 4; ++j) tile[kk * 65 + c4 * 4 + j] = v[i][j]; }
        const int tn = t + gridDim.x;
        if (tn < total) { const int k1 = (tn / nN) * 64, n1 = (tn % nN) * 64;
#pragma unroll
            for (int i = 0; i < 2; ++i) { const int idx = tid + 512 * i, kk = idx >> 4, c4 = idx & 15; v[i] = *(const f32x4*)(src + (size_t)(k1 + kk) * ld + col0 + n1 + c4 * 4) * (scale ? scale[k1 + kk] : 1.0f); } }
        __syncthreads();
        { const int n = tid >> 3, kc = (tid & 7) * 8; f32x4 a, b;
#pragma unroll
            for (int j = 0; j < 4; ++j) { a[j] = tile[(kc + j) * 65 + n]; b[j] = tile[(kc + 4 + j) * 65 + n]; }
            const int drow = (up < 0) ? (n0 + n) : (256 * (n0 >> 7) + (n0 & 127) + up * 128 + n);
            *(u32x4*)(dst + (size_t)drow * Kdim + k0 + kc) = pack8u(a, b); }
        __syncthreads();
    }
}

__global__ void __launch_bounds__(512, 2) fwd_kernel(Params p) {
    extern __shared__ __attribute__((aligned(16))) unsigned char lds[];
    __builtin_assume(__builtin_amdgcn_workitem_id_y() == 0); __builtin_assume(__builtin_amdgcn_workitem_id_z() == 0);
    cg::grid_group grid = cg::this_grid();
    const int wid = __builtin_amdgcn_readfirstlane(threadIdx.x >> 6), G = gridDim.x, bx = blockIdx.x;
    unsigned char* ws = p.ws;
    bf16_t* W1T = (bf16_t*)(ws + WS_W1T); bf16_t* WAT = (bf16_t*)(ws + WS_WAT); bf16_t* WFT = (bf16_t*)(ws + WS_WFT); bf16_t* WOT = (bf16_t*)(ws + WS_WOT);
    bf16_t* W5T = (bf16_t*)(ws + WS_W5T); bf16_t* WDT = (bf16_t*)(ws + WS_WDT);
    bf16_t* XB = (bf16_t*)(ws + WS_RA); bf16_t* OA = (bf16_t*)(ws + WS_RA); bf16_t* OF = (bf16_t*)(ws + WS_RA + (size_t)M * 1024 * 2); bf16_t* H1B = (bf16_t*)(ws + WS_RA);
    bf16_t* QKV = (bf16_t*)(ws + WS_RB); float* TMP = (float*)(ws + WS_RB); bf16_t* MERGED = (bf16_t*)(ws + WS_RB + (size_t)M * DM * 4); bf16_t* ACT = (bf16_t*)(ws + WS_RB);
    bf16_t* GATES = (bf16_t*)(ws + WS_RG);
    float* RSTD1 = (float*)(ws + WS_RSTD1); float* SSQ2 = (float*)(ws + WS_SSQ2); float* SSQ3 = (float*)(ws + WS_SSQ3);
    float* LOGF = (float*)(ws + WS_LOGF); float* CUM = (float*)(ws + WS_CUM); float* KSQ = (float*)(ws + WS_KSQ); float* SSQA = (float*)(ws + WS_SSQA);
    const int lo = p.ph_lo, hi_ = p.ph_hi;
#define IN(k) (lo <= (k) && (k) < hi_)
#define SEAM(k) do { if (IN(k) && IN((k) + 1)) grid.sync(); } while (0)

    for (int rep_ = 0; rep_ < (REP_PHASE == 0 ? 2 : 1); ++rep_) if (IN(0)) {
        if (rep_) grid.sync();
        const int lane = fresh_lane(), tid = wid * 64 + lane;
        float* tile = (float*)lds;
        const float* w_in = p.in[3];
        transpose_job(w_in, NINC, 0, 96, DM, W1T, -1, p.in[2], tile, tid);
        transpose_job(w_in, NINC, 6152, 64, DM, W1T + (size_t)6144 * DM, -1, p.in[2], tile, tid);
        transpose_job(p.in[10], DM, 0, 32, 1024, WAT, -1, nullptr, tile, tid);
        transpose_job(p.in[11], DM, 0, 32, 1024, WFT, -1, nullptr, tile, tid);
        transpose_job(p.in[12], DM, 0, 32, DM, WOT, -1, nullptr, tile, tid);
        transpose_job(p.in[14], DFF, 0, 88, DM, W5T, 0, p.in[13], tile, tid);
        transpose_job(p.in[15], DFF, 0, 88, DM, W5T, 1, p.in[13], tile, tid);
        transpose_job(p.in[16], DM, 0, 32, DFF, WDT, -1, nullptr, tile, tid);
        float* WF = (float*)lds;
        for (int k = tid; k < DM; k += 512) { const float g = p.in[2][k]; const f32x4 a = *(const f32x4*)(w_in + (size_t)k * NINC + 6144), b = *(const f32x4*)(w_in + (size_t)k * NINC + 6148);
#pragma unroll
            for (int j = 0; j < 4; ++j) { WF[j * DM + k] = a[j] * g; WF[(4 + j) * DM + k] = b[j] * g; } }
        __syncthreads();
        const float* x = p.in[0]; const float* meta = p.in[1]; const float* b_f = p.in[9];
        for (int job = bx * 8 + wid; job < M + NMETA; job += G * 8) {
            const bool ismeta = job >= M; const int row = ismeta ? job + VPAD : job;
            const float* src = ismeta ? meta + (size_t)(job - M) * DM : x + (size_t)job * DM;
            f32x4 v[8]; float ss = 0.f; float zf[8];
#pragma unroll
            for (int j = 0; j < 8; ++j) zf[j] = 0.f;
#pragma unroll
            for (int i = 0; i < 8; ++i) { v[i] = *(const f32x4*)(src + i * 256 + lane * 4);
                ss += (v[i][0] * v[i][0] + v[i][1] * v[i][1]) + (v[i][2] * v[i][2] + v[i][3] * v[i][3]); }
#pragma unroll
            for (int i = 0; i < 8; ++i) {
                u32x2 w; w.x = pg8::cvt_pk_bf16(v[i][0], v[i][1]); w.y = pg8::cvt_pk_bf16(v[i][2], v[i][3]);
                *(u32x2*)(XB + (size_t)row * DM + i * 256 + lane * 4) = w;
#pragma unroll
                for (int j = 0; j < 8; ++j) { const f32x4 wv = *(const f32x4*)(WF + j * DM + i * 256 + lane * 4); zf[j] += (v[i][0] * wv[0] + v[i][1] * wv[1]) + (v[i][2] * wv[2] + v[i][3] * wv[3]); } }
            ss = wave_sum(ss);
#pragma unroll
            for (int j = 0; j < 8; ++j) zf[j] = wave_sum(zf[j]);
            const float rs = __builtin_amdgcn_rsqf(ss * (1.0f / 2048.0f) + 1e-6f);
            if (lane == 0) RSTD1[row] = rs;
            if (lane < 8 && !ismeta) { SSQ2[(size_t)lane * M + row] = 0.f; SSQ3[(size_t)lane * M + row] = 0.f; }
            if (lane < 8) { float zz = zf[0];
#pragma unroll
                for (int j = 1; j < 8; ++j) zz = (lane == j) ? zf[j] : zz;
                const float y = zz * rs + b_f[lane];
                const float lf = fminf(y, 0.f) - log1pf(__expf(-fabsf(y)));
                if (!ismeta) { const int b = job >> 13, t = job & (SEQ - 1); LOGF[(size_t)(b * 8 + lane) * LB + 64 + t] = lf; }
                else { const int vp = VPAD + (job - M);
#pragma unroll
                    for (int b = 0; b < NBATCH; ++b) LOGF[(size_t)(b * 8 + lane) * LB + vp] = lf; } }
        }
        for (int i = bx * 512 + tid; i < 16 * MQ; i += G * 512) KSQ[i] = 0.f;
        if (bx == 0 && tid == 0) *(unsigned*)(ws + WS_QCTR) = 0u;
        if (bx == 1 && tid < 256) ((unsigned*)(ws + WS_CNT6))[64 * tid] = 0u;
        if (bx == 0) for (int i = tid; i < 32 * VPAD; i += 512) LOGF[(size_t)(i / VPAD) * LB + (i % VPAD)] = 0.f;
        __syncthreads();
    }
    SEAM(0);

    for (int rep_ = 0; rep_ < (REP_PHASE == 1 ? 2 : 1); ++rep_) if (IN(1)) {
        if (rep_) grid.sync();
        const int lane = fresh_lane(), tid = wid * 64 + lane;
        if (bx < 32) {
            const float* srcp = LOGF + (size_t)bx * LB; float* dstp = CUM + (size_t)bx * LB; float* red = (float*)lds;
            const int i0 = tid * 17; float vals[17]; float s = 0.f;
#pragma unroll
            for (int i = 0; i < 17; ++i) { const int k = i0 + i; vals[i] = k < LB ? srcp[k] : 0.f; s += vals[i]; vals[i] = s; }
            float incl = s;
#pragma unroll
            for (int o = 1; o < 64; o <<= 1) { const float t = __shfl_up(incl, o); if (lane >= o) incl += t; }
            if (lane == 63) red[wid] = incl;
            __syncthreads();
            float base = incl - s;
            for (int w = 0; w < wid; ++w) base += red[w];
#pragma unroll
            for (int i = 0; i < 17; ++i) { const int k = i0 + i; if (k < LB) dstp[k] = (base + vals[i]) * 11.313708498984761f; }
            __syncthreads();
        }
        {
            bf16_t* xm = (bf16_t*)lds;
            for (int i = tid; i < 16 * 256; i += 512) *(u32x4*)(xm + (size_t)i * 8) = *(const u32x4*)(XB + (size_t)(M + VPAD) * DM + (size_t)i * 8);
            { const int i = bx * 512 + tid; if (i < 32 * VPAD * 16) { const int sl = i / (VPAD * 16), r = (i / 16) % VPAD, ch = i % 16; const int hd = sl < 16 ? 8 + sl : 16 + sl;
                *(u32x4*)(QKV + ((size_t)hd * MQ + M + r) * 128 + ch * 8) = (u32x4){0u, 0u, 0u, 0u}; } }
            __syncthreads();
            for (int c0 = bx * 16; c0 < 4096; c0 += G * 16) {
#pragma unroll 1
                for (int cc = 0; cc < 2; ++cc) { const int c = c0 + wid * 2 + cc, sl = c >> 7, hd = sl < 16 ? 8 + sl : 16 + sl, n = hd * 128 + (c & 127);
                    f32x4 wa[8];
#pragma unroll
                    for (int q = 0; q < 4; ++q) unpack8(*(const u32x4*)(W1T + (size_t)n * DM + lane * 32 + q * 8), wa[2 * q], wa[2 * q + 1]);
                    float mine = 0.f;
#pragma unroll 1
                    for (int j = 0; j < 16; ++j) { float a = 0.f;
#pragma unroll
                        for (int q = 0; q < 4; ++q) { f32x4 x0, x1; unpack8(*(const u32x4*)(xm + (size_t)j * DM + lane * 32 + q * 8), x0, x1);
                            a += (x0[0] * wa[2 * q][0] + x0[1] * wa[2 * q][1]) + (x0[2] * wa[2 * q][2] + x0[3] * wa[2 * q][3]) + (x1[0] * wa[2 * q + 1][0] + x1[1] * wa[2 * q + 1][1]) + (x1[2] * wa[2 * q + 1][2] + x1[3] * wa[2 * q + 1][3]); }
                        a = wave_sum(a); mine = (lane == j) ? a : mine; }
                    if (lane < 16) { const float v = mine * RSTD1[M + VPAD + lane]; QKV[((size_t)hd * MQ + M + VPAD + lane) * 128 + (c & 127)] = (bf16_t)(pg8::cvt_pk_bf16(v, v) & 0xffffu); } }
            }
            __syncthreads();
        }
        pg8::Gemm g{XB, W1T, M, N1, DM}; pg8::StaticOrder S; S.init(M, N1, G, bx);
        Epi1 E{QKV, GATES, RSTD1, KSQ};
        pg8::gemm_phase<Epi1, pg8::StaticOrder>((PG8_LAS unsigned char*)lds, g, S, E, wid * 64 + fresh_lane());
    }
    SEAM(1);

    for (int rep_ = 0; rep_ < (REP_PHASE == 2 ? 2 : 1); ++rep_) if (IN(2)) {
        if (rep_) grid.sync();
        const int lane = fresh_lane(), tid = wid * 64 + lane;
        float lam;
        { const float* q1 = p.in[4]; const float* k1 = p.in[5]; const float* q2 = p.in[6]; const float* k2 = p.in[7];
          float s1 = q1[lane] * k1[lane] + q1[lane + 64] * k1[lane + 64], s2 = q2[lane] * k2[lane] + q2[lane + 64] * k2[lane + 64];
          s1 = wave_sum(s1); s2 = wave_sum(s2); lam = __expf(s1) - __expf(s2) + 0.2f; lam = __uint_as_float(__builtin_amdgcn_readfirstlane(__float_as_uint(lam))); }
        float* scrT = (float*)(ws + WS_SCR + (size_t)bx * 262144);
        float* tabw = (float*)(lds + att::LDS_TAB);
        constexpr int NITEM = 2048, NDIFF = 1024;
        unsigned* qctr = (unsigned*)(ws + WS_QCTR);
        float* red = (float*)(lds + att::LDS_TAB + 8256 * 4);
        auto grab = [&]() -> int { if (wid == 0 && fresh_lane() == 0) red[16] = __uint_as_float(atomicAdd(qctr, 1u)); __syncthreads();
                                   const int v = __builtin_amdgcn_readfirstlane((int)__float_as_uint(red[16])); __syncthreads(); return v; };
        auto desc = [&](int item, int ps) -> att::Blk {
            att::Blk r;
            if (item >= NDIFF) { const int j = item - NDIFF, h = j >> 7, b = (j >> 5) & 3, qb = 31 - (j & 31);
                const size_t rb = (size_t)b * SEQ + 256 * qb; r.P0 = 64 + 256 * qb; r.mode = 0; r.s2 = 0.f;
                r.Q = QKV + ((size_t)(24 + h) * MQ + rb) * 128; r.K = QKV + ((size_t)(32 + h) * MQ + (size_t)b * SEQ) * 128 - 64 * 128; r.V = QKV + ((size_t)(40 + h) * MQ + (size_t)b * SEQ) * 128 - 64 * 128;
                r.K0 = QKV + ((size_t)(32 + h) * MQ + M) * 128; r.V0 = QKV + ((size_t)(40 + h) * MQ + M) * 128;
                r.O = OF + rb * 1024 + h * 128; }
            else { const int h = 3 - (item >> 8), b = (item >> 6) & 3, qb = 31 - ((item >> 1) & 31), e = item & 1, c = ps;
                const size_t rb = (size_t)b * SEQ + 256 * qb; r.P0 = 64 + 256 * qb; r.mode = 1 + c;
                r.s2 = 2.0f * 11.313708498984761f * (h == 0 ? 0.25f : h == 1 ? 0.0625f : h == 2 ? 0.015625f : 0.00390625f);
                r.Q = QKV + ((size_t)(2 * h + c) * MQ + rb) * 128; r.K = QKV + ((size_t)(8 + 2 * h + c) * MQ + (size_t)b * SEQ) * 128 - 64 * 128; r.V = QKV + ((size_t)(16 + 2 * h + e) * MQ + (size_t)b * SEQ) * 128 - 64 * 128;
                r.K0 = QKV + ((size_t)(8 + 2 * h + c) * MQ + M) * 128; r.V0 = QKV + ((size_t)(16 + 2 * h + e) * MQ + M) * 128;
                r.O = OA + rb * 1024 + h * 256 + e * 128; }
            return r; };
        int item = grab();
        if (item < NITEM) {
            att::Seam S;
            { const att::Blk first = desc(item, 0); att::attn_prime(first, (char*)lds, S, wid * 64 + fresh_lane()); }
            while (item < NITEM) {
              const int item_next = grab();
              const int np = item < NDIFF ? 2 : 1;
              for (int ps = 0; ps < np; ++ps) {
                const att::Blk cur = desc(item, ps);
                const bf16_t* nxtQ = (ps + 1 < np) ? desc(item, ps + 1).Q : (item_next < NITEM ? desc(item_next, 0).Q : cur.Q);
                const int tt = wid * 64 + fresh_lane(), ln_ = tt & 63;
                float km = 0.f;
                { const int nk = cur.P0 + 256;
                  if (item >= NDIFF) { const int j = item - NDIFF, h = j >> 7, b = (j >> 5) & 3; const float* cm = CUM + (size_t)(b * 8 + h) * LB; const float cref = cm[cur.P0];
                      const float* kq = KSQ + (size_t)(8 + h) * MQ;
                      for (int k = tt; k < nk; k += 512) { tabw[k] = cref - cm[k]; km = fmaxf(km, k < 64 ? metak2(cur.K0, k) : kq[b * SEQ + k - 64]); } }
                  else { const int h = 3 - (item >> 8), b = (item >> 6) & 3, c = ps; const float sl = 0.5f * cur.s2; const float* kq = KSQ + (size_t)(2 * h + c) * MQ;
                      for (int k = tt; k < nk; k += 512) { tabw[k] = sl * (float)(k - cur.P0); km = fmaxf(km, k < 64 ? metak2(cur.K0, k) : kq[b * SEQ + k - 64]); } } }
                float qs = 0.f;
#pragma unroll
                for (int d0 = 0; d0 < 8; ++d0) { f32x4 a, b2; unpack8(*reinterpret_cast<const u32x4*>(&S.qr[d0]), a, b2); qs += (a[0] * a[0] + a[1] * a[1]) + (a[2] * a[2] + a[3] * a[3]) + (b2[0] * b2[0] + b2[1] * b2[1]) + (b2[2] * b2[2] + b2[3] * b2[3]); }
                qs += shx(qs, 32, ln_);
#pragma unroll
                for (int o = 32; o >= 1; o >>= 1) { qs = fmaxf(qs, shx(qs, o, ln_)); km = fmaxf(km, shx(km, o, ln_)); }
                if (ln_ == 0) { red[wid] = qs; red[8 + wid] = km; }
                __syncthreads();
                int j_lo;
                { float q2 = red[0], k2 = red[8];
#pragma unroll
                  for (int w = 1; w < 8; ++w) { q2 = fmaxf(q2, red[w]); k2 = fmaxf(k2, red[8 + w]); }
                  const float Bnd = sqrtf(q2 * k2) * 1.05f + 1.0f; const float thr = -(1176.3f + 45.3f + Bnd);
                  int lo_ = 0, hi_2 = (cur.P0 + 255) / 64;
                  while (lo_ < hi_2) { const int mid = (lo_ + hi_2) >> 1; if (tabw[64 * mid + 63] < thr) lo_ = mid + 1; else hi_2 = mid; }
                  j_lo = __builtin_amdgcn_readfirstlane(lo_); }
                att::attn_block(cur, nxtQ, (char*)lds, S, lam, scrT, OA, SSQA, wid * 64 + fresh_lane(), j_lo);
              }
              item = item_next;
            }
        }
        asm volatile("s_waitcnt vmcnt(0)" ::: "memory");
        __syncthreads();
        grid.sync();
        { const int ln2 = fresh_lane(), h = ln2 >> 4; const float* g_subln = p.in[8];
          f32x4 gq[4];
#pragma unroll
          for (int q = 0; q < 4; ++q) gq[q] = *(const f32x4*)(g_subln + (ln2 & 15) * 16 + q * 4) * 0.8f;
          for (int row = bx * 8 + wid; row < M; row += G * 8) {
              const float rn = __builtin_amdgcn_rsqf((SSQA[(size_t)row * 8 + 2 * h] + SSQA[(size_t)row * 8 + 2 * h + 1]) * (1.0f / 256.0f) + 1e-5f);
              bf16_t* d = OA + (size_t)row * 1024 + ln2 * 16;
              f32x4 a0, a1, a2, a3; unpack8(*(const u32x4*)d, a0, a1); unpack8(*(const u32x4*)(d + 8), a2, a3);
              *(u32x4*)d = pack8u(a0 * rn * gq[0], a1 * rn * gq[1]); *(u32x4*)(d + 8) = pack8u(a2 * rn * gq[2], a3 * rn * gq[3]); } }
    }
    SEAM(2);

    for (int rep_ = 0; rep_ < (REP_PHASE == 3 ? 2 : 1); ++rep_) if (IN(3)) {
        if (rep_) grid.sync();
        if (G == 256) { pg8::Gemm g{OA, WAT, M, DM, 1024}; PanelOrder S{bx}; Epi3a E{TMP, GATES};
          pg8::gemm_phase<Epi3a, PanelOrder>((PG8_LAS unsigned char*)lds, g, S, E, wid * 64 + fresh_lane()); }
        else { pg8::Gemm g{OA, WAT, M, DM, 1024}; pg8::StaticOrder S; S.init(M, DM, G, bx); Epi3a E{TMP, GATES};
          pg8::gemm_phase<Epi3a, pg8::StaticOrder>((PG8_LAS unsigned char*)lds, g, S, E, wid * 64 + fresh_lane()); }
        if (G == 256) { pg8::Gemm g{OF, WFT, M, DM, 1024}; PanelOrder S{bx}; Epi3b E{TMP, GATES, MERGED};
          pg8::gemm_phase<Epi3b, PanelOrder>((PG8_LAS unsigned char*)lds, g, S, E, wid * 64 + fresh_lane()); }
        else { pg8::Gemm g{OF, WFT, M, DM, 1024}; pg8::StaticOrder S; S.init(M, DM, G, bx); Epi3b E{TMP, GATES, MERGED};
          pg8::gemm_phase<Epi3b, pg8::StaticOrder>((PG8_LAS unsigned char*)lds, g, S, E, wid * 64 + fresh_lane()); }
    }
    SEAM(3);

    if (IN(4)) {
        pg8::Gemm g{MERGED, WOT, M, DM, DM}; Epi4 E{p.in[0], p.out, H1B, SSQ2};
        if (G == 256) { PanelOrder S{bx}; pg8::gemm_phase<Epi4, PanelOrder>((PG8_LAS unsigned char*)lds, g, S, E, wid * 64 + fresh_lane()); }
        else { pg8::StaticOrder S; S.init(M, DM, G, bx); pg8::gemm_phase<Epi4, pg8::StaticOrder>((PG8_LAS unsigned char*)lds, g, S, E, wid * 64 + fresh_lane()); }
    }
    SEAM(4);

    for (int rep_ = 0; rep_ < (REP_PHASE == 5 ? 2 : 1); ++rep_) if (IN(5)) {
        if (rep_) grid.sync();
        pg8::Gemm g{H1B, W5T, M, N5, DM}; pg8::StaticOrder S; S.init(M, N5, G, bx); Epi5 E{SSQ2, ACT};
        pg8::gemm_phase<Epi5, pg8::StaticOrder>((PG8_LAS unsigned char*)lds, g, S, E, wid * 64 + fresh_lane());
    }
    SEAM(5);

    if (IN(6)) {
        pg8::Gemm g{ACT, WDT, M, DM, DFF};
        if (G == 256) { PanelOrder S{bx}; Epi6 E{p.out, SSQ3};
            pg8::gemm_phase<Epi6, PanelOrder>((PG8_LAS unsigned char*)lds, g, S, E, wid * 64 + fresh_lane()); }
        else { pg8::StaticOrder S; S.init(M, DM, G, bx); Epi6 E{p.out, SSQ3};
            pg8::gemm_phase<Epi6, pg8::StaticOrder>((PG8_LAS unsigned char*)lds, g, S, E, wid * 64 + fresh_lane()); }
    }
    SEAM(6);

    if (IN(7)) {
        const int lane = fresh_lane();
        const float* gfin = p.in[17];
        f32x4 gv[8];
#pragma unroll
        for (int i = 0; i < 8; ++i) gv[i] = *(const f32x4*)(gfin + i * 256 + lane * 4);
        for (int orow = bx * 8 + wid; orow < NBATCH * SEQ; orow += G * 8) {
            const int row = orow;
            float sq = 0.f;
#pragma unroll
            for (int t = 0; t < 8; ++t) sq += SSQ3[(size_t)t * M + row];
            const float rs = __builtin_amdgcn_rsqf(sq * (1.0f / 2048.0f) + 1e-6f);
            float* d = p.out + (size_t)orow * DM + lane * 4;
#pragma unroll
            for (int i = 0; i < 8; ++i) { const f32x4 v = *(const f32x4*)(d + i * 256); *(f32x4*)(d + i * 256) = v * rs * gv[i]; }
        }
    }
#undef IN
#undef SEAM
}

extern "C" void kernel_launch(void* const* d_in, const int* in_sizes, int n_in, void* d_out, int out_size, void* d_ws, size_t ws_size, hipStream_t stream) {
    static int grid = 0;
    if (grid == 0) {
        if (n_in != 18 || ws_size < WS_END) { fprintf(stderr, "kernel_launch: need 18 inputs and >= %zu bytes of workspace (got %d, %zu)\n", (size_t)WS_END, n_in, ws_size); grid = -1; return; }
        int dev = 0, cus = 0, per_cu = 0;
        (void)hipGetDevice(&dev);
        if (hipDeviceGetAttribute(&cus, hipDeviceAttributeMultiprocessorCount, dev) != hipSuccess || cus <= 0) cus = 256;
        if (hipFuncSetAttribute((const void*)fwd_kernel, hipFuncAttributeMaxDynamicSharedMemorySize, LDS_BYTES) != hipSuccess) { fprintf(stderr, "kernel_launch: hipFuncSetAttribute failed\n"); }
        if (hipOccupancyMaxActiveBlocksPerMultiprocessor(&per_cu, (const void*)fwd_kernel, 512, LDS_BYTES) != hipSuccess || per_cu < 1) { fprintf(stderr, "kernel_launch: occupancy query says %d\n", per_cu); per_cu = 1; }
        (void)hipGetLastError();
        grid = cus * 1;
        if (grid > 256) grid = 256;
    }
    if (grid < 0) return;
    Params p{};
    for (int i = 0; i < 18; ++i) p.in[i] = (const float*)d_in[i];
    p.out = (float*)d_out; p.ws = (unsigned char*)d_ws;
#if ONE_LAUNCH
    p.ph_lo = 0; p.ph_hi = 8;
    void* args[] = {&p};
    hipError_t e = hipLaunchCooperativeKernel((const void*)fwd_kernel, dim3(grid), dim3(512), args, LDS_BYTES, stream);
    if (e != hipSuccess) fprintf(stderr, "cooperative launch failed: %s (grid %d)\n", hipGetErrorString(e), grid);
#else
    for (int ph = 0; ph < 8; ++ph) { p.ph_lo = ph; p.ph_hi = ph + 1; hipLaunchKernelGGL(fwd_kernel, dim3(grid), dim3(512), LDS_BYTES, stream, p); }
#endif
}
```

```cpp
#include <hip/hip_runtime.h>
#include <hip/hip_cooperative_groups.h>
#include <cstdio>
#include <cstdint>
namespace cg = cooperative_groups;

#ifndef REP_PHASE
#define REP_PHASE -1
#endif
#ifndef ONE_LAUNCH
#define ONE_LAUNCH 1
#endif

typedef unsigned short bf16_t;
typedef short bf16x8 __attribute__((ext_vector_type(8)));
typedef short s16x4 __attribute__((ext_vector_type(4)));
typedef float f32x4 __attribute__((ext_vector_type(4)));
typedef float f32x16 __attribute__((ext_vector_type(16)));
typedef unsigned u32x4 __attribute__((ext_vector_type(4)));
typedef unsigned u32x2 __attribute__((ext_vector_type(2)));

constexpr int DM = 2048, NBATCH = 4, SEQ = 8192, NMETA = 16;
constexpr int VPAD = 48;
constexpr int LB = 8256;
constexpr int M = NBATCH * SEQ;
constexpr int MQ = M + 64;
constexpr int NINC = 10248;
constexpr int N1 = 10240;
constexpr int DFF = 5632, N5 = 2 * DFF;
constexpr int NHD = 48;

constexpr size_t SZ_W1T = (size_t)N1 * DM * 2, SZ_WAT = (size_t)DM * 1024 * 2, SZ_WOT = (size_t)DM * DM * 2, SZ_W5T = (size_t)N5 * DM * 2, SZ_WDT = (size_t)DM * DFF * 2;
constexpr size_t WS_W1T = 0, WS_WAT = WS_W1T + SZ_W1T, WS_WFT = WS_WAT + SZ_WAT, WS_WOT = WS_WFT + SZ_WAT, WS_W5T = WS_WOT + SZ_WOT, WS_WDT = WS_W5T + SZ_W5T;
constexpr size_t WS_RA = WS_WDT + SZ_WDT;
constexpr size_t SZ_RA = (size_t)MQ * DM * 2;
constexpr size_t WS_RB = WS_RA + SZ_RA;
constexpr size_t SZ_RB = (size_t)NHD * MQ * 128 * 2;
constexpr size_t WS_RG = WS_RB + SZ_RB;
constexpr size_t SZ_RG = (size_t)M * 4096 * 2;
constexpr size_t WS_RSTD1 = WS_RG + SZ_RG, WS_SSQ2 = WS_RSTD1 + (size_t)MQ * 4, WS_SSQ3 = WS_SSQ2 + (size_t)M * 8 * 4;
constexpr size_t WS_LOGF = WS_SSQ3 + (size_t)M * 8 * 4, WS_CUM = WS_LOGF + (size_t)32 * LB * 4;
constexpr size_t WS_SCR = WS_CUM + (size_t)32 * LB * 4;
constexpr size_t WS_KSQ = WS_SCR + (size_t)256 * 262144;
constexpr size_t WS_QCTR = WS_KSQ + (size_t)16 * MQ * 4;
constexpr size_t WS_SSQA = WS_QCTR + 256;
constexpr size_t WS_CNT6 = WS_SSQA + (size_t)M * 8 * 4;
constexpr size_t WS_SLOT6 = WS_CNT6 + (size_t)256 * 256;
constexpr size_t WS_END = WS_SLOT6 + (size_t)32 * M * 4;
constexpr int LDS_BYTES = 131072;

namespace pg8 {
#define PG8_LAS __attribute__((address_space(3)))
constexpr int BM = 256, BK = 64, HALF = 128, HTB = HALF * BK * 2, STAGE_BYTES = 8 * HTB, NXCD = 8, WGM = 4;
__host__ __device__ __forceinline__ int lds_byte(int r, int c) { const int st = (r >> 4) * 2 + (c >> 5), rr = r & 15, cc = c & 31, ob = rr * 64 + cc * 2; return st * 1024 + (ob ^ (((ob >> 9) & 1) << 5)); }
__host__ __device__ __forceinline__ void stage_rc(int b, int& R, int& C) { const int st = b / 1024, sb = b % 1024, swz = sb ^ (((sb >> 9) & 1) << 5); R = (st >> 1) * 16 + swz / 64; C = (st & 1) * 32 + (swz % 64) / 2; }
__host__ __device__ __forceinline__ int perm32(int rho) { const int n = rho >> 4, i = rho & 15; return 8 * (i >> 2) + 4 * n + (i & 3); }
struct Unit { int pm, pn; };
struct Gemm { const bf16_t* A; const bf16_t* Bt; int M, N, K; };
struct StaticOrder {
    int nM, nN, nwg, G, c;
    __host__ __device__ void init(int M_, int N_, int G_, int c_) { nM = M_ / BM; nN = N_ / BM; nwg = nM * nN; G = G_; c = c_; }
    __host__ __device__ bool next(int i, Unit& u) const {
        const long L = (long)i * G + c; if (L >= nwg) return false;
        int wgid = (int)L; { const int q = nwg / NXCD, r = nwg % NXCD, xcd = wgid % NXCD, off = wgid / NXCD; wgid = (xcd < r ? xcd * (q + 1) : r * (q + 1) + (xcd - r) * q) + off; }
        const int nig = WGM * nN, gid = wgid / nig, fm = gid * WGM, gsz = (nM - fm) < WGM ? (nM - fm) : WGM;
        u.pm = fm + ((wgid % nig) % gsz); u.pn = (wgid % nig) / gsz; return true;
    }
    __device__ __forceinline__ void a_ready(const Unit&) const {}
    __device__ __forceinline__ void done(const Unit&) const {}
};
__device__ __forceinline__ unsigned cvt_pk_bf16(float lo, float hi) { unsigned r; asm volatile("v_cvt_pk_bf16_f32 %0, %1, %2" : "=v"(r) : "v"(lo), "v"(hi)); return r; }

template <class Epi, class Sched>
__device__ __forceinline__ void gemm_phase(PG8_LAS unsigned char* lds, const Gemm g, const Sched& S, const Epi& E, const int tid) {
    const int wid = __builtin_amdgcn_readfirstlane(tid >> 6), lane = tid & 63, wr = wid >> 2, wc = wid & 3, fr = lane & 15, fq = lane >> 4;
    const int K = g.K, nt = K / BK;
    unsigned voffA[2], voffB[2];
#pragma unroll
    for (int i = 0; i < 2; ++i) { int R, C; stage_rc(tid * 16 + i * 8192, R, C); const int Rb = Epi::PERM ? ((R & ~31) + perm32(R & 31)) : R;
        voffA[i] = (unsigned)(R * K + C) * 2u; voffB[i] = (unsigned)(Rb * K + C) * 2u; }
    const size_t kstep = (size_t)(BK * 2);
    const size_t hstep = (size_t)HALF * K * 2;
    const size_t tstep = 2 * hstep;
    const unsigned ldsw = (unsigned)wid * 1024u;
    const int aoff = lds_byte(wr * 64 + fr, fq * 8), boff = lds_byte(wc * 32 + fr, fq * 8);
#define PG8_SA(b, h) (((b) * 2 + (h)) * HTB)
#define PG8_SB(b, h) ((4 + (b) * 2 + (h)) * HTB)
#define PG8_STAGE(bufoff, gbase, voff) do { _Pragma("unroll") for (int _i = 0; _i < 2; ++_i) \
        __builtin_amdgcn_global_load_lds((const unsigned*)((const char*)(gbase) + (voff)[_i]), (PG8_LAS unsigned*)(lds + (bufoff) + ldsw + _i * 8192), 16, 0, 0); } while (0)
#define PG8_LDA(dst, b, h) do { _Pragma("unroll") for (int m = 0; m < 4; ++m) _Pragma("unroll") for (int k = 0; k < 2; ++k) dst[m][k] = *(const PG8_LAS bf16x8*)(lds + PG8_SA(b, h) + aoff + m * 2048 + k * 1024); } while (0)
#define PG8_LDB(dst, b, h) do { _Pragma("unroll") for (int n = 0; n < 2; ++n) _Pragma("unroll") for (int k = 0; k < 2; ++k) dst[n][k] = *(const PG8_LAS bf16x8*)(lds + PG8_SB(b, h) + boff + n * 2048 + k * 1024); } while (0)
#define PG8_MMA(ai, bj, At, Bt) do { __builtin_amdgcn_s_setprio(1); _Pragma("unroll") for (int m = 0; m < 4; ++m) _Pragma("unroll") for (int n = 0; n < 2; ++n) _Pragma("unroll") for (int k = 0; k < 2; ++k) \
        acc[ai][bj][m][n] = __builtin_amdgcn_mfma_f32_16x16x32_bf16(Bt[n][k], At[m][k], acc[ai][bj][m][n], 0, 0, 0); __builtin_amdgcn_s_setprio(0); } while (0)
#define PG8_WAIT_V(n) asm volatile("s_waitcnt vmcnt(" #n ")" ::: "memory")
#define PG8_WAIT_L(n) asm volatile("s_waitcnt lgkmcnt(" #n ")" ::: "memory")
#define PG8_BAR __builtin_amdgcn_s_barrier()
#define PG8_SCHED __builtin_amdgcn_sched_barrier(0)
    Unit cur, nxt; int ui = 0;
    if (!S.next(0, cur)) return;
    f32x4 acc[2][2][4][2];
#pragma unroll
    for (int a = 0; a < 2; ++a)
#pragma unroll
        for (int b = 0; b < 2; ++b)
#pragma unroll
            for (int m = 0; m < 4; ++m)
#pragma unroll
                for (int n = 0; n < 2; ++n) acc[a][b][m][n] = (f32x4){0.f, 0.f, 0.f, 0.f};
    bf16x8 At[4][2], B0[2][2], B1[2][2];
    const char* cA = (const char*)g.A + (size_t)cur.pm * tstep; const char* cB = (const char*)g.Bt + (size_t)cur.pn * tstep;
    S.a_ready(cur);
    PG8_STAGE(PG8_SB(0, 0), cB, voffB); PG8_STAGE(PG8_SA(0, 0), cA, voffA); PG8_STAGE(PG8_SB(0, 1), cB + hstep, voffB); PG8_STAGE(PG8_SA(0, 1), cA + hstep, voffA);
    if (wr == 1) PG8_BAR;
    PG8_WAIT_V(4); PG8_BAR;
    PG8_STAGE(PG8_SB(1, 0), cB + kstep, voffB); PG8_STAGE(PG8_SA(1, 0), cA + kstep, voffA); PG8_STAGE(PG8_SB(1, 1), cB + hstep + kstep, voffB);
    PG8_WAIT_V(6); PG8_BAR;
    for (;;) {
        const bool has_next = S.next(ui + 1, nxt);
        const char* nA = has_next ? (const char*)g.A + (size_t)nxt.pm * tstep : cA; const char* nB = has_next ? (const char*)g.Bt + (size_t)nxt.pn * tstep : cB;
        for (int t = 0; t < nt; t += 2) {
            const bool last = (t == nt - 2);
            const char* a1 = cA + (size_t)(t + 1) * kstep;
            const char* a2 = last ? nA : cA + (size_t)(t + 2) * kstep; const char* b2 = last ? nB : cB + (size_t)(t + 2) * kstep;
            const char* a3 = a2 + kstep; const char* b3 = b2 + kstep;
            if (last && has_next) S.a_ready(nxt);
            PG8_LDB(B0, 0, 0); PG8_SCHED; PG8_LDA(At, 0, 0); PG8_STAGE(PG8_SA(1, 1), a1 + hstep, voffA);
            PG8_WAIT_L(8); PG8_BAR; PG8_WAIT_L(0); PG8_MMA(0, 0, At, B0); PG8_BAR; PG8_SCHED;
            PG8_LDB(B1, 0, 1); PG8_STAGE(PG8_SB(0, 0), b2, voffB);
            PG8_BAR; PG8_WAIT_L(0); PG8_MMA(0, 1, At, B1); PG8_BAR;
            PG8_LDA(At, 0, 1); PG8_STAGE(PG8_SA(0, 0), a2, voffA);
            PG8_BAR; PG8_WAIT_L(0); PG8_MMA(1, 0, At, B0); PG8_BAR; PG8_SCHED;
            PG8_STAGE(PG8_SB(0, 1), b2 + hstep, voffB);
            PG8_WAIT_V(6); PG8_BAR; PG8_MMA(1, 1, At, B1); PG8_BAR;
            PG8_LDB(B0, 1, 0); PG8_SCHED; PG8_LDA(At, 1, 0); PG8_STAGE(PG8_SA(0, 1), a2 + hstep, voffA);
            PG8_WAIT_L(8); PG8_BAR; PG8_WAIT_L(0); PG8_MMA(0, 0, At, B0); PG8_BAR; PG8_SCHED;
            PG8_LDB(B1, 1, 1); PG8_STAGE(PG8_SB(1, 0), b3, voffB);
            PG8_BAR; PG8_WAIT_L(0); PG8_MMA(0, 1, At, B1); PG8_BAR;
            PG8_LDA(At, 1, 1); PG8_STAGE(PG8_SA(1, 0), a3, voffA);
            PG8_BAR; PG8_WAIT_L(0); PG8_MMA(1, 0, At, B0); PG8_BAR; PG8_SCHED;
            PG8_STAGE(PG8_SB(1, 1), b3 + hstep, voffB);
            PG8_WAIT_V(6); PG8_BAR; PG8_MMA(1, 1, At, B1); PG8_BAR;
        }
        E(acc, cur, wr, wc, fr, fq); S.done(cur);
        if (!has_next) break;
#pragma unroll
        for (int a = 0; a < 2; ++a)
#pragma unroll
            for (int b = 0; b < 2; ++b)
#pragma unroll
                for (int m = 0; m < 4; ++m)
#pragma unroll
                    for (int n = 0; n < 2; ++n) acc[a][b][m][n] = (f32x4){0.f, 0.f, 0.f, 0.f};
        cur = nxt; cA = nA; cB = nB; ++ui;
    }
    PG8_WAIT_V(0);
    if (wr == 0) PG8_BAR;
    PG8_BAR;
#undef PG8_SA
#undef PG8_SB
#undef PG8_STAGE
#undef PG8_LDA
#undef PG8_LDB
#undef PG8_MMA
#undef PG8_WAIT_V
#undef PG8_WAIT_L
#undef PG8_BAR
#undef PG8_SCHED
}
}

__device__ __forceinline__ int fresh_lane() { int l; asm volatile("v_mbcnt_lo_u32_b32 %0, -1, 0\n\tv_mbcnt_hi_u32_b32 %0, -1, %0" : "=v"(l)); return l; }
__device__ __forceinline__ float bf2f(unsigned short b) { return __uint_as_float(((unsigned)b) << 16); }
__device__ __forceinline__ float sigmoidf_(float x) { return __builtin_amdgcn_rcpf(1.0f + __builtin_amdgcn_exp2f(-1.4426950408889634f * x)); }
__device__ __forceinline__ u32x4 pack8u(f32x4 a, f32x4 b) { u32x4 w = {pg8::cvt_pk_bf16(a[0], a[1]), pg8::cvt_pk_bf16(a[2], a[3]), pg8::cvt_pk_bf16(b[0], b[1]), pg8::cvt_pk_bf16(b[2], b[3])}; return w; }
__device__ __forceinline__ void unpack8(u32x4 w, f32x4& a, f32x4& b) {
    a = (f32x4){__uint_as_float(w.x << 16), __uint_as_float(w.x & 0xffff0000u), __uint_as_float(w.y << 16), __uint_as_float(w.y & 0xffff0000u)};
    b = (f32x4){__uint_as_float(w.z << 16), __uint_as_float(w.z & 0xffff0000u), __uint_as_float(w.w << 16), __uint_as_float(w.w & 0xffff0000u)};
}
__device__ __forceinline__ float shx(float v, int o, int ln) { return __uint_as_float((unsigned)__builtin_amdgcn_ds_bpermute((ln ^ o) << 2, (int)__float_as_uint(v))); }
__device__ __forceinline__ float wave_sum(float v) {
#pragma unroll
    for (int o = 32; o >= 1; o >>= 1) v += __shfl_xor(v, o);
    return v;
}

typedef f32x4 Acc[2][2][4][2];
struct Epi1 { static constexpr bool PERM = true;
    bf16_t* QKV; bf16_t* GATES; const float* rstd; float* KSQ;
    __device__ __forceinline__ void operator()(const Acc& acc, const pg8::Unit& u, int wr, int wc, int fr, int fq) const {
        const int row0 = u.pm * 256 + wr * 64 + fr;
        if (u.pn < 24) {
            const bool iskh = (u.pn >= 4 && u.pn < 8) || (u.pn >= 16 && u.pn < 20);
            const int ks0 = u.pn < 8 ? 2 * u.pn - 8 : 2 * u.pn - 32 + 8;
#pragma unroll
            for (int ai = 0; ai < 2; ++ai)
#pragma unroll
                for (int m = 0; m < 4; ++m) { const int row = row0 + ai * 128 + m * 16; const float rs = rstd[row];
#pragma unroll
                    for (int bj = 0; bj < 2; ++bj) { bf16_t* dst = QKV + ((size_t)(2 * u.pn + bj) * MQ + row) * 128 + wc * 32 + 8 * fq;
                        const f32x4 v0 = acc[ai][bj][m][0] * rs, v1 = acc[ai][bj][m][1] * rs;
                        *(u32x4*)dst = pack8u(v0, v1);
                        if (iskh) { float ss = (v0[0] * v0[0] + v0[1] * v0[1]) + (v0[2] * v0[2] + v0[3] * v0[3]) + (v1[0] * v1[0] + v1[1] * v1[1]) + (v1[2] * v1[2] + v1[3] * v1[3]);
                            ss += __shfl_xor(ss, 16); ss += __shfl_xor(ss, 32);
                            if (fq == 0) atomicAdd(KSQ + (size_t)(ks0 + bj) * MQ + row, ss); } } }
        } else {
            const int colb = (u.pn - 24) * 256 + wc * 32 + 8 * fq;
#pragma unroll
            for (int ai = 0; ai < 2; ++ai)
#pragma unroll
                for (int m = 0; m < 4; ++m) { const int row = row0 + ai * 128 + m * 16; const float rs = rstd[row];
#pragma unroll
                    for (int bj = 0; bj < 2; ++bj) { f32x4 v0 = acc[ai][bj][m][0] * rs, v1 = acc[ai][bj][m][1] * rs;
#pragma unroll
                        for (int j = 0; j < 4; ++j) { v0[j] = sigmoidf_(v0[j]); v1[j] = sigmoidf_(v1[j]); }
                        *(u32x4*)(GATES + (size_t)row * 4096 + colb + bj * 128) = pack8u(v0, v1); } }
        }
    }
};
struct Epi3a { static constexpr bool PERM = true;
    float* TMP; const bf16_t* GATES;
    __device__ __forceinline__ void operator()(const Acc& acc, const pg8::Unit& u, int wr, int wc, int fr, int fq) const {
        const int row0 = u.pm * 256 + wr * 64 + fr, col0 = u.pn * 256 + wc * 32 + 8 * fq;
#pragma unroll
        for (int ai = 0; ai < 2; ++ai)
#pragma unroll
            for (int m = 0; m < 4; ++m) { const int row = row0 + ai * 128 + m * 16;
#pragma unroll
                for (int bj = 0; bj < 2; ++bj) { const int col = col0 + bj * 128; f32x4 g0, g1; unpack8(*(const u32x4*)(GATES + (size_t)row * 4096 + col), g0, g1);
                    float* d = TMP + (size_t)row * DM + col; *(f32x4*)d = acc[ai][bj][m][0] * g0; *(f32x4*)(d + 4) = acc[ai][bj][m][1] * g1; } }
    }
};
struct Epi3b { static constexpr bool PERM = true;
    const float* TMP; const bf16_t* GATES; bf16_t* MERGED;
    __device__ __forceinline__ void operator()(const Acc& acc, const pg8::Unit& u, int wr, int wc, int fr, int fq) const {
        const int row0 = u.pm * 256 + wr * 64 + fr, col0 = u.pn * 256 + wc * 32 + 8 * fq;
#pragma unroll
        for (int ai = 0; ai < 2; ++ai)
#pragma unroll
            for (int m = 0; m < 4; ++m) { const int row = row0 + ai * 128 + m * 16;
#pragma unroll
                for (int bj = 0; bj < 2; ++bj) { const int col = col0 + bj * 128; f32x4 g0, g1; unpack8(*(const u32x4*)(GATES + (size_t)row * 4096 + 2048 + col), g0, g1);
                    const float* s = TMP + (size_t)row * DM + col; const f32x4 t0 = *(const f32x4*)s, t1 = *(const f32x4*)(s + 4);
                    *(u32x4*)(MERGED + (size_t)row * DM + col) = pack8u(t0 + acc[ai][bj][m][0] * g0, t1 + acc[ai][bj][m][1] * g1); } }
    }
};
struct Epi4 { static constexpr bool PERM = true;
    const float* x; float* out; bf16_t* H1B; float* ssq;
    __device__ __forceinline__ void operator()(const Acc& acc, const pg8::Unit& u, int wr, int wc, int fr, int fq) const {
        const int row0 = u.pm * 256 + wr * 64 + fr, col0 = u.pn * 256 + wc * 32 + 8 * fq;
#pragma unroll
        for (int ai = 0; ai < 2; ++ai)
#pragma unroll
            for (int m = 0; m < 4; ++m) { const int row = row0 + ai * 128 + m * 16; const size_t orow = (size_t)row; float ss = 0.f;
#pragma unroll
                    for (int bj = 0; bj < 2; ++bj) { const int col = col0 + bj * 128; const float* xs = x + orow * DM + col;
                        const f32x4 h0 = *(const f32x4*)xs + acc[ai][bj][m][0], h1 = *(const f32x4*)(xs + 4) + acc[ai][bj][m][1];
                        float* d = out + orow * DM + col; *(f32x4*)d = h0; *(f32x4*)(d + 4) = h1;
                        *(u32x4*)(H1B + (size_t)row * DM + col) = pack8u(h0, h1);
                        ss += (h0[0] * h0[0] + h0[1] * h0[1]) + (h0[2] * h0[2] + h0[3] * h0[3]) + (h1[0] * h1[0] + h1[1] * h1[1]) + (h1[2] * h1[2] + h1[3] * h1[3]); }
                    ss += __shfl_xor(ss, 16); ss += __shfl_xor(ss, 32);
                    if (fq == 0) atomicAdd(ssq + (size_t)u.pn * M + row, ss); }
    }
};
struct Epi5 { static constexpr bool PERM = true;
    const float* ssq; bf16_t* ACT;
    __device__ __forceinline__ void operator()(const Acc& acc, const pg8::Unit& u, int wr, int wc, int fr, int fq) const {
        const int row0 = u.pm * 256 + wr * 64 + fr, col0 = u.pn * 128 + wc * 32 + 8 * fq;
#pragma unroll
        for (int ai = 0; ai < 2; ++ai)
#pragma unroll
            for (int m = 0; m < 4; ++m) { const int row = row0 + ai * 128 + m * 16; float sq = 0.f;
#pragma unroll
                for (int t = 0; t < 8; ++t) sq += ssq[(size_t)t * M + row];
                const float rs = __builtin_amdgcn_rsqf(sq * (1.0f / 2048.0f) + 1e-6f);
                f32x4 o[2];
#pragma unroll
                for (int n = 0; n < 2; ++n) { const f32x4 g = acc[ai][0][m][n] * rs, up = acc[ai][1][m][n] * rs;
#pragma unroll
                    for (int j = 0; j < 4; ++j) o[n][j] = g[j] * sigmoidf_(g[j]) * up[j]; }
                *(u32x4*)(ACT + (size_t)row * DFF + col0) = pack8u(o[0], o[1]); }
    }
};
struct Epi6 { static constexpr bool PERM = true;
    float* out; float* ssq;
    __device__ __forceinline__ void operator()(const Acc& acc, const pg8::Unit& u, int wr, int wc, int fr, int fq) const {
        const int row0 = u.pm * 256 + wr * 64 + fr, col0 = u.pn * 256 + wc * 32 + 8 * fq;
#pragma unroll
        for (int ai = 0; ai < 2; ++ai)
#pragma unroll
            for (int m = 0; m < 4; ++m) { const int row = row0 + ai * 128 + m * 16; const size_t orow = (size_t)row; float ss = 0.f;
#pragma unroll
                    for (int bj = 0; bj < 2; ++bj) { const int col = col0 + bj * 128; float* d = out + orow * DM + col;
                        const f32x4 h0 = *(const f32x4*)d + acc[ai][bj][m][0], h1 = *(const f32x4*)(d + 4) + acc[ai][bj][m][1];
                        *(f32x4*)d = h0; *(f32x4*)(d + 4) = h1;
                        ss += (h0[0] * h0[0] + h0[1] * h0[1]) + (h0[2] * h0[2] + h0[3] * h0[3]) + (h1[0] * h1[0] + h1[1] * h1[1]) + (h1[2] * h1[2] + h1[3] * h1[3]); }
                    ss += __shfl_xor(ss, 16); ss += __shfl_xor(ss, 32);
                    if (fq == 0) atomicAdd(ssq + (size_t)u.pn * M + row, ss); }
    }
};

struct Epi6F { static constexpr bool PERM = true;
    float* out; float* slots; unsigned* cnt; const float* gfin;
    __device__ __forceinline__ void operator()(const Acc& acc_, const pg8::Unit& u, int wr, int wc, int fr, int fq) const {
        Acc& acc = const_cast<Acc&>(acc_);
        const int row0 = u.pm * 256 + wr * 64 + fr, col0 = u.pn * 256 + wc * 32 + 8 * fq;
        float* myslot = slots + (size_t)(u.pn * 4 + wc) * M;
#pragma unroll
        for (int ai = 0; ai < 2; ++ai)
#pragma unroll
            for (int m = 0; m < 4; ++m) { const int row = row0 + ai * 128 + m * 16; float ss = 0.f;
#pragma unroll
                for (int bj = 0; bj < 2; ++bj) { const float* d = out + (size_t)row * DM + col0 + bj * 128;
                    const f32x4 h0 = *(const f32x4*)d + acc[ai][bj][m][0], h1 = *(const f32x4*)(d + 4) + acc[ai][bj][m][1];
                    acc[ai][bj][m][0] = h0; acc[ai][bj][m][1] = h1;
                    ss += (h0[0] * h0[0] + h0[1] * h0[1]) + (h0[2] * h0[2] + h0[3] * h0[3]) + (h1[0] * h1[0] + h1[1] * h1[1]) + (h1[2] * h1[2] + h1[3] * h1[3]); }
                ss += __shfl_xor(ss, 16); ss += __shfl_xor(ss, 32);
                if (fq == 0) __hip_atomic_store(myslot + row, ss, __ATOMIC_RELAXED, __HIP_MEMORY_SCOPE_AGENT); }
        asm volatile("s_waitcnt vmcnt(0)" ::: "memory");
        unsigned* c = cnt + 64 * (2 * u.pm + wr);
        if ((fr | fq) == 0) __hip_atomic_fetch_add(c, 1u, __ATOMIC_RELAXED, __HIP_MEMORY_SCOPE_AGENT);
        { const unsigned long long t0 = __builtin_amdgcn_s_memrealtime();
          while ((unsigned)__builtin_amdgcn_readfirstlane(__hip_atomic_load(c, __ATOMIC_RELAXED, __HIP_MEMORY_SCOPE_AGENT)) < 32u) {
              if (__builtin_amdgcn_s_memrealtime() - t0 > 2000000ull) break;
              __builtin_amdgcn_s_sleep(2); } }
        __builtin_amdgcn_fence(__ATOMIC_ACQUIRE, "agent");
#pragma unroll
        for (int ai = 0; ai < 2; ++ai)
#pragma unroll
            for (int m = 0; m < 4; ++m) { const int row = row0 + ai * 128 + m * 16; float sq = 0.f;
#pragma unroll
                for (int t = 0; t < 8; ++t) sq += __hip_atomic_load(slots + (size_t)(fq * 8 + t) * M + row, __ATOMIC_RELAXED, __HIP_MEMORY_SCOPE_AGENT);
                sq += __shfl_xor(sq, 16); sq += __shfl_xor(sq, 32);
                const float rs = __builtin_amdgcn_rsqf(sq * (1.0f / 2048.0f) + 1e-6f);
#pragma unroll
                for (int bj = 0; bj < 2; ++bj) { float* d = out + (size_t)row * DM + col0 + bj * 128; const float* gp = gfin + col0 + bj * 128;
                    *(f32x4*)d = acc[ai][bj][m][0] * rs * *(const f32x4*)gp; *(f32x4*)(d + 4) = acc[ai][bj][m][1] * rs * *(const f32x4*)(gp + 4); } }
    }
};
struct PanelOrder { int c;
    __device__ __forceinline__ bool next(int i, pg8::Unit& u) const { if (i >= 4) return false; const int x = c & 7, j = c >> 3; u.pm = 32 * i + 4 * x + (j >> 3); u.pn = j & 7; return true; }
    __device__ __forceinline__ void a_ready(const pg8::Unit&) const {}
    __device__ __forceinline__ void done(const pg8::Unit&) const {}
};

namespace att {
constexpr int D = 128, NW = 8, QBLK = 32, KVBLK = 64, QB = 256;
constexpr int SHM_V = KVBLK * D * 2, SHM_K = KVBLK * D * 2;
constexpr int LDS_WS = 3 * SHM_V + 2 * SHM_K;
constexpr int LDS_TAB = LDS_WS + NW * 64 * 4;
constexpr float SCALE = 0.08838834764831845f;
constexpr float THR = 8.f;
#define KSWZ(row, colB) ((row) * 256 + ((colB) ^ (((row) & 7) << 4)))
#define SBAR() __builtin_amdgcn_sched_barrier(0)
__device__ __forceinline__ int v_st(int k, int c) { const int kk = (k & ~0xC) | ((k & 4) << 1) | ((k & 8) >> 1); return ((kk >> 3) * 4 + (c >> 5)) * 512 + ((kk & 7) * 32 + (c & 31)) * 2; }
__device__ __forceinline__ int v_rd_base(int lane) { return ((lane & 3) << 3) | (((lane >> 2) & 3) << 6) | (((lane >> 4) & 1) << 5) | (((lane >> 5) & 1) << 8); }
constexpr int v_rd_off(int d0, int ks, int half) { return d0 * 512 + ks * 4096 + half * 2048; }
__device__ __forceinline__ int crow(int r, int hi) { return (r & 3) + 8 * (r >> 2) + 4 * hi; }
__device__ __forceinline__ unsigned cvtpk(float lo, float hi) { unsigned r; asm volatile("v_cvt_pk_bf16_f32 %0, %1, %2" : "=v"(r) : "v"(lo), "v"(hi)); return r; }
__device__ __forceinline__ bf16x8 load8(const bf16_t* p) { return *reinterpret_cast<const bf16x8*>(p); }
__device__ __forceinline__ void mask_tile(f32x16& p0, f32x16& p1, int dqe, int dqt, unsigned W, float s2) {
    const float NEG = -__builtin_inff();
#pragma unroll
    for (int r = 0; r < 16; ++r) {
        const int c = (r & 3) + 8 * (r >> 2);
        const int a0 = c - dqt, a1 = c + 32 - dqt;
        p0[r] -= s2 * (float)(a0 > 0 ? a0 : 0);
        p1[r] -= s2 * (float)(a1 > 0 ? a1 : 0);
        if ((unsigned)(dqe - c) >= W) p0[r] = NEG;
        if ((unsigned)(dqe - c - 32) >= W) p1[r] = NEG;
    }
}
__device__ __forceinline__ void partialSM(f32x16& p0, f32x16& p1, float& m_reg, float& mn, float& alpha, bool& skip) {
    float pmax = p0[0]; for (int r = 1; r < 16; ++r) pmax = fmaxf(pmax, p0[r]); for (int r = 0; r < 16; ++r) pmax = fmaxf(pmax, p1[r]);
    { auto rr = __builtin_amdgcn_permlane32_swap(__float_as_uint(pmax), __float_as_uint(pmax), false, false);
      pmax = fmaxf(__uint_as_float(rr[0]), __uint_as_float(rr[1])); }
    constexpr float C2 = 1.4426950408889634f * SCALE;
    skip = __all((pmax - m_reg) * C2 < -150.f);
    if (skip) { mn = m_reg; alpha = 1.f; return; }
    if (__builtin_expect(__all((pmax - m_reg) * SCALE <= THR), 1)) { mn = m_reg; alpha = 1.f; }
    else { mn = fmaxf(m_reg, pmax); alpha = __builtin_amdgcn_exp2f((m_reg - mn) * C2); m_reg = mn; }
    const float mnL = -mn * C2;
    for (int r = 0; r < 16; ++r) p0[r] = fmaf(p0[r], C2, mnL); for (int r = 0; r < 16; ++r) p1[r] = fmaf(p1[r], C2, mnL);
    for (int r = 0; r < 16; ++r) p0[r] = __builtin_amdgcn_exp2f(p0[r]);
}
__device__ __forceinline__ void finishSM(f32x16& p0, f32x16& p1, float alpha, float& l_reg, bf16x8& pa0, bf16x8& pa1, bf16x8& pa2, bf16x8& pa3) {
    for (int r = 0; r < 16; ++r) p1[r] = __builtin_amdgcn_exp2f(p1[r]);
    float ps = 0; for (int r = 0; r < 16; ++r) ps += p0[r]; for (int r = 0; r < 16; ++r) ps += p1[r];
    { auto rr = __builtin_amdgcn_permlane32_swap(__float_as_uint(ps), __float_as_uint(ps), false, false);
      ps = __uint_as_float(rr[0]) + __uint_as_float(rr[1]); }
    l_reg = l_reg * alpha + ps;
#define PK4(P, B_, OUT) do { unsigned a0 = cvtpk(P[B_+0], P[B_+1]), a1 = cvtpk(P[B_+2], P[B_+3]);                          \
        unsigned b0 = cvtpk(P[B_+4], P[B_+5]), b1 = cvtpk(P[B_+6], P[B_+7]);                                             \
        auto r0 = __builtin_amdgcn_permlane32_swap(a0, b0, false, false); auto r1 = __builtin_amdgcn_permlane32_swap(a1, b1, false, false); \
        u32x4 w = {r0[0], r1[0], r0[1], r1[1]}; OUT = *reinterpret_cast<bf16x8*>(&w); } while (0)
    PK4(p0, 0, pa0); PK4(p0, 8, pa1); PK4(p1, 0, pa2); PK4(p1, 8, pa3);
#undef PK4
}
template <int KB>
__device__ __forceinline__ void qkt(f32x16& p0, f32x16& p1, const char* K_lds, int r32, int hi, const bf16x8* qr) {
    p0 = f32x16{}; p1 = f32x16{};
    const char* kb[4];
#pragma unroll
    for (int dd = 0; dd < 4; ++dd) kb[dd] = K_lds + KB * SHM_K + KSWZ(r32, (dd * 16 + hi * 8) * 2);
#pragma unroll
    for (int d0 = 0; d0 < 8; ++d0) { const char* a = kb[d0 & 3] + (d0 >> 2) * 128;
        bf16x8 b0 = *reinterpret_cast<const bf16x8*>(a);
        bf16x8 b1 = *reinterpret_cast<const bf16x8*>(a + 32 * 256);
        p0 = __builtin_amdgcn_mfma_f32_32x32x16_bf16(b0, qr[d0], p0, 0, 0, 0);
        p1 = __builtin_amdgcn_mfma_f32_32x32x16_bf16(b1, qr[d0], p1, 0, 0, 0); }
}
__device__ __forceinline__ void pv_tile(f32x16* o, int vb0, bf16x8 pa0, bf16x8 pa1, bf16x8 pa2, bf16x8 pa3) {
#define TRRD(dst, off) asm volatile("ds_read_b64_tr_b16 %0, %1 offset:%2" : "=&v"(dst) : "v"(vb0), "i"(off) : "memory")
#define PV_D0(d0) do { s16x4 l0, l1, l2, l3, h0, h1, h2, h3; constexpr int b_ = v_rd_off(d0, 0, 0); \
        TRRD(l0, b_); TRRD(h0, b_ + 2048); TRRD(l1, b_ + 4096); TRRD(h1, b_ + 6144); TRRD(l2, b_ + 8192); TRRD(h2, b_ + 10240); TRRD(l3, b_ + 12288); TRRD(h3, b_ + 14336); \
        asm volatile("s_waitcnt lgkmcnt(0)" ::: "memory"); SBAR();   \
        o[d0] = __builtin_amdgcn_mfma_f32_32x32x16_bf16(pa0, (bf16x8){l0[0], l0[1], l0[2], l0[3], h0[0], h0[1], h0[2], h0[3]}, o[d0], 0, 0, 0);   \
        o[d0] = __builtin_amdgcn_mfma_f32_32x32x16_bf16(pa1, (bf16x8){l1[0], l1[1], l1[2], l1[3], h1[0], h1[1], h1[2], h1[3]}, o[d0], 0, 0, 0);   \
        o[d0] = __builtin_amdgcn_mfma_f32_32x32x16_bf16(pa2, (bf16x8){l2[0], l2[1], l2[2], l2[3], h2[0], h2[1], h2[2], h2[3]}, o[d0], 0, 0, 0);   \
        o[d0] = __builtin_amdgcn_mfma_f32_32x32x16_bf16(pa3, (bf16x8){l3[0], l3[1], l3[2], l3[3], h3[0], h3[1], h3[2], h3[3]}, o[d0], 0, 0, 0); } while (0)
    PV_D0(0); PV_D0(1); PV_D0(2); PV_D0(3);
#undef PV_D0
#undef TRRD
}
struct Blk { const bf16_t* Q; const bf16_t* K; const bf16_t* V; const bf16_t* K0; const bf16_t* V0; bf16_t* O; int P0; int mode; float s2; };
struct Seam { bf16x8 qr[8]; bf16x8 st_v0, st_v1, st_k0, st_k1; };
#define ROW(p, k0, rr) ((p) + (size_t)((k0) + (rr)) * D + sc)
#define VMW() asm volatile("s_waitcnt vmcnt(0)" ::: "memory")
#define VMWN(n) asm volatile("s_waitcnt vmcnt(%0)" :: "i"(n) : "memory")
#define SLOAD_H(Kp, Vp, k0) do { S.st_v0 = load8(ROW(Vp, k0, sr)); S.st_v1 = load8(ROW(Vp, k0, 32 + sr));              \
                         S.st_k0 = load8(ROW(Kp, k0, sr)); S.st_k1 = load8(ROW(Kp, k0, 32 + sr)); } while (0)
#define SWRITE_HK(bf) do { *(bf16x8*)(K_lds + (bf) * SHM_K + kws) = S.st_k0; *(bf16x8*)(K_lds + (bf) * SHM_K + kws + 32 * 256) = S.st_k1; } while (0)
#define SWRITE_HV(bf) do { *(bf16x8*)(V_lds + (bf) * SHM_V + vst0) = S.st_v0; *(bf16x8*)(V_lds + (bf) * SHM_V + vst1) = S.st_v1; } while (0)
#define SWRITE_H(bf) do { SWRITE_HV(bf); SWRITE_HK(bf); } while (0)
__device__ __forceinline__ void attn_prime(const Blk& cur, char* lds, Seam& S, const int tid) {
    const int wid = __builtin_amdgcn_readfirstlane(tid >> 6), lane = tid & 63, r32 = lane & 31, hi = lane >> 5;
    for (int d0 = 0; d0 < 8; ++d0) S.qr[d0] = load8(cur.Q + (size_t)(wid * QBLK + r32) * D + d0 * 16 + hi * 8);
}
__device__ __forceinline__ void attn_block(const Blk& cur, const bf16_t* nxtQ, char* lds, Seam& S, float lam, float* scrT, const bf16_t* OAb, float* SSQAb, const int tid, const int j_lo) {
    const int wid = __builtin_amdgcn_readfirstlane(tid >> 6), lane = tid & 63, r32 = lane & 31, hi = lane >> 5;
    const int NT = (cur.P0 + QB - 1) / KVBLK + 1 - j_lo;
    const int qlo = cur.P0 + wid * QBLK;
    const int qt4 = qlo + r32 - 4 * hi;
    const bool isdiff = cur.mode != 0;
    char* V_lds = lds; char* K_lds = lds + 3 * SHM_V;
    float* ws = (float*)(lds + LDS_WS) + wid * 64; float* li_l = ws, * al_l = ws + 32;
    float m_reg = ((const float*)(lds + LDS_TAB))[qlo + r32] - 45.254834f, l_reg = 0; f32x16 o[4] = {};
    const int sr = tid >> 4, sc = (tid & 15) * 8, vst0 = v_st(sr, sc), vst1 = v_st(32 + sr, sc), kws = KSWZ(sr, sc * 2);
    const int vb0 = (int)(uintptr_t)V_lds + v_rd_base(lane);
    const bf16_t* Kh = cur.K; const bf16_t* Vh = cur.V;
#define RESC(a) do { if (__any((a) < 1.f)) { if (hi == 0) al_l[r32] = (a); asm volatile("s_waitcnt lgkmcnt(0)" ::: "memory");              \
                     for (int d_ = 0; d_ < 4; ++d_) for (int r = 0; r < 16; ++r) o[d_][r] *= al_l[crow(r, hi)]; } } while (0)
#define KBASE(t) ((j_lo + (t)) * KVBLK)
#define BIAS(P0_, P1_, t) do { int h_ = hi; asm volatile("" : "+v"(h_)); const float* tb_ = (const float*)(lds + LDS_TAB) + (4 * h_ + KBASE(t));         \
        _Pragma("unroll") for (int i_ = 0; i_ < 4; ++i_) { const f32x4 b0_ = *(const f32x4*)(tb_ + 8 * i_), b1_ = *(const f32x4*)(tb_ + 32 + 8 * i_); \
            _Pragma("unroll") for (int j_ = 0; j_ < 4; ++j_) { P0_[4 * i_ + j_] += b0_[j_]; P1_[4 * i_ + j_] += b1_[j_]; } } } while (0)
#define MASKT(P0_, P1_, t) do { const int kb_ = KBASE(t); BIAS(P0_, P1_, t); if (kb_ + KVBLK - 1 > qlo || kb_ == 0) { int q_ = qt4; asm volatile("" : "+v"(q_)); const int qt_ = q_ + 4 * hi, qe_ = isdiff ? (qt_ | 63) : qt_;      \
            mask_tile(P0_, P1_, qe_ - kb_ - 4 * hi, q_ - kb_, (unsigned)(qe_ - 47), cur.s2); } } while (0)
#define SEAM_K0() do { VMWN(8); SWRITE_HK(0); SBAR(); } while (0)
    f32x16 pA0, pA1, pB0, pB1; float mnA, mnB, alA, alB; bf16x8 pa0, pa1, pa2, pa3; bool skA, skB;
    { const bf16_t* kp = j_lo == 0 ? cur.K0 : Kh + (size_t)j_lo * KVBLK * D; const bf16_t* vp = j_lo == 0 ? cur.V0 : Vh + (size_t)j_lo * KVBLK * D;
      SLOAD_H(kp, vp, 0); VMW(); SWRITE_H(0); SBAR(); }
    if (NT > 1) { SLOAD_H(Kh, Vh, KBASE(1)); }
    __syncthreads();
    SBAR(); qkt<0>(pA0, pA1, K_lds, r32, hi, S.qr);
    MASKT(pA0, pA1, 0); partialSM(pA0, pA1, m_reg, mnA, alA, skA);
    if (NT > 1) { VMW(); SWRITE_H(1); }
    __syncthreads();
#define HALF_STEP(PX0, PX1, mnX, alX, skX, PY0, PY1, alY, skY, t, KB, VB, SB_) do {                                                      \
        SBAR(); qkt<KB>(PX0, PX1, K_lds, r32, hi, S.qr);                                             \
        if (!(skY)) finishSM(PY0, PY1, alY, l_reg, pa0, pa1, pa2, pa3); SBAR();                                               \
        if ((t) + 1 < NT) { SLOAD_H(Kh, Vh, KBASE((t) + 1)); SBAR(); }                                               \
        if (!(skY)) pv_tile(o, vb0 + vprev * SHM_V, pa0, pa1, pa2, pa3); MASKT(PX0, PX1, (t)); partialSM(PX0, PX1, m_reg, mnX, alX, skX);                        \
        if ((t) + 1 < NT) { VMW(); SWRITE_HK(SB_); SWRITE_HV(vprev == 0 ? 2 : vprev - 1); }     \
        RESC(alX); __syncthreads(); vprev = vprev == 2 ? 0 : vprev + 1; } while (0)
    int vprev = 0;
    for (int t = 1; t + 1 < NT; t += 2) {
        HALF_STEP(pB0, pB1, mnB, alB, skB, pA0, pA1, alA, skA, t, 1, 0, 0);
        HALF_STEP(pA0, pA1, mnA, alA, skA, pB0, pB1, alB, skB, t + 1, 0, 1, 1);
    }
    const bool even = (NT & 1) == 0;
    if (even) { SBAR(); qkt<1>(pB0, pB1, K_lds, r32, hi, S.qr); SBAR(); }
    { int t2 = tid; asm volatile("" : "+v"(t2));
      const int l2 = t2 & 63;
      const unsigned qoff = (unsigned)((wid * QBLK + (l2 & 31)) * D + (l2 >> 5) * 8);
#pragma unroll
      for (int d0 = 0; d0 < 8; ++d0) S.qr[d0] = load8(nxtQ + qoff + d0 * 16); }
    SBAR();
    if (!skA) finishSM(pA0, pA1, alA, l_reg, pa0, pa1, pa2, pa3); SBAR();
    if (!skA) pv_tile(o, vb0 + ((even ? NT - 2 : NT - 1) % 3) * SHM_V, pa0, pa1, pa2, pa3);
    if (even) { MASKT(pB0, pB1, NT - 1); partialSM(pB0, pB1, m_reg, mnB, alB, skB); __syncthreads(); RESC(alB);
        if (!skB) { finishSM(pB0, pB1, alB, l_reg, pa0, pa1, pa2, pa3); SBAR(); pv_tile(o, vb0 + ((NT - 1) % 3) * SHM_V, pa0, pa1, pa2, pa3); } }
    SBAR();
    int ln = lane; asm volatile("" : "+v"(ln));
    const int r32e = ln & 31;
    if (hi == 0) li_l[r32] = l_reg; asm volatile("s_waitcnt lgkmcnt(0)" ::: "memory");
    float rli[16];
#pragma unroll
    for (int r = 0; r < 16; ++r) rli[r] = __builtin_amdgcn_rcpf(li_l[crow(r, hi)]);
    const int mode = cur.mode;
    if (mode == 0) {
        bf16_t* Ow = cur.O + (size_t)(wid * QBLK) * 1024;
#pragma unroll
        for (int r = 0; r < 16; ++r) { const int orow = crow(r, hi);
#pragma unroll
            for (int d0 = 0; d0 < 4; ++d0) { const float v = o[d0][r] * rli[r]; const float vn = shx(v, 1, ln);
                if ((r32e & 1) == 0) *(unsigned*)(Ow + (orow * 1024 + d0 * 32 + r32e)) = cvtpk(v, vn); } }
    } else if (mode == 1) {
        float* T = scrT + (wid * 4096 + ln);
#pragma unroll
        for (int r = 0; r < 16; ++r)
#pragma unroll
            for (int d0 = 0; d0 < 4; ++d0) T[(r * 4 + d0) * 64] = o[d0][r] * rli[r];
    } else {
        const float* T = scrT + (wid * 4096 + ln);
        bf16_t* Ow = cur.O + (size_t)(wid * QBLK) * 1024; const size_t oo = (size_t)(cur.O - OAb); float* SSw = SSQAb + (oo >> 10) * 8 + ((oo >> 7) & 7) + (wid * QBLK) * 8;
#pragma unroll
        for (int r = 0; r < 16; ++r) { const int orow = crow(r, hi); float ss = 0.f;
#pragma unroll
            for (int d0 = 0; d0 < 4; ++d0) { const float v = __hip_atomic_load(T + (r * 4 + d0) * 64, __ATOMIC_RELAXED, __HIP_MEMORY_SCOPE_AGENT) - lam * (o[d0][r] * rli[r]); ss += v * v;
                const float vn = shx(v, 1, ln);
                if ((r32e & 1) == 0) *(unsigned*)(Ow + (orow * 1024 + d0 * 32 + r32e)) = cvtpk(v, vn); }
            ss += shx(ss, 1, ln); ss += shx(ss, 2, ln); ss += shx(ss, 4, ln); ss += shx(ss, 8, ln); ss += shx(ss, 16, ln);
            if (r32e == 0) SSw[orow * 8] = ss; }
    }
    __syncthreads();
#undef RESC
#undef KBASE
#undef BIAS
#undef MASKT
#undef SEAM_K0
#undef HALF_STEP
}
#undef ROW
#undef VMW
#undef VMWN
#undef SLOAD_H
#undef SWRITE_HK
#undef SWRITE_HV
#undef SWRITE_H
}

__device__ __forceinline__ float metak2(const bf16_t* K0, int k) {
    if (k < VPAD) return 0.f;
    float a = 0.f;
    for (int q = 0; q < 16; ++q) { f32x4 x0, x1; unpack8(*(const u32x4*)(K0 + (size_t)k * 128 + q * 8), x0, x1); a += (x0[0] * x0[0] + x0[1] * x0[1]) + (x0[2] * x0[2] + x0[3] * x0[3]) + (x1[0] * x1[0] + x1[1] * x1[1]) + (x1[2] * x1[2] + x1[3] * x1[3]); }
    return a;
}
struct Params { const float* in[18]; float* out; unsigned char* ws; int ph_lo, ph_hi; };

__device__ __forceinline__ void transpose_job(const float* __restrict__ src, int ld, int col0, int nN, int Kdim, bf16_t* __restrict__ dst, int up, const float* __restrict__ scale, float* tile, const int tid) {
    const int nK = Kdim / 64, total = nK * nN;
    f32x4 v[2];
    int t = blockIdx.x;
    if (t < total) { const int k0 = (t / nN) * 64, n0 = (t % nN) * 64;
#pragma unroll
        for (int i = 0; i < 2; ++i) { const int idx = tid + 512 * i, kk = idx >> 4, c4 = idx & 15; v[i] = *(const f32x4*)(src + (size_t)(k0 + kk) * ld + col0 + n0 + c4 * 4) * (scale ? scale[k0 + kk] : 1.0f); } }
    for (; t < total; t += gridDim.x) {
        const int k0 = (t / nN) * 64, n0 = (t % nN) * 64;
#pragma unroll
        for (int i = 0; i < 2; ++i) { const int idx = tid + 512 * i, kk = idx >> 4, c4 = idx & 15;
#pragma unroll
            for (int j = 0; j < 4; ++j) tile[kk * 65 + c4 * 4 + j] = v[i][j]; }
        const int tn = t + gridDim.x;
        if (tn < total) { const int k1 = (tn / nN) * 64, n1 = (tn % nN) * 64;
#pragma unroll
            for (int i = 0; i < 2; ++i) { const int idx = tid + 512 * i, kk = idx >> 4, c4 = idx & 15; v[i] = *(const f32x4*)(src + (size_t)(k1 + kk) * ld + col0 + n1 + c4 * 4) * (scale ? scale[k1 + kk] : 1.0f); } }
        __syncthreads();
        { const int n = tid >> 3, kc = (tid & 7) * 8; f32x4 a, b;
#pragma unroll
            for (int j = 0; j < 4; ++j) { a[j] = tile[(kc + j) * 65 + n]; b[j] = tile[(kc + 4 + j) * 65 + n]; }
            const int drow = (up < 0) ? (n0 + n) : (256 * (n0 >> 7) + (n0 & 127) + up * 128 + n);
            *(u32x4*)(dst + (size_t)drow * Kdim + k0 + kc) = pack8u(a, b); }
        __syncthreads();
    }
}

__global__ void __launch_bounds__(512, 2) fwd_kernel(Params p) {
    extern __shared__ __attribute__((aligned(16))) unsigned char lds[];
    __builtin_assume(__builtin_amdgcn_workitem_id_y() == 0); __builtin_assume(__builtin_amdgcn_workitem_id_z() == 0);
    cg::grid_group grid = cg::this_grid();
    const int wid = __builtin_amdgcn_readfirstlane(threadIdx.x >> 6), G = gridDim.x, bx = blockIdx.x;
    unsigned char* ws = p.ws;
    bf16_t* W1T = (bf16_t*)(ws + WS_W1T); bf16_t* WAT = (bf16_t*)(ws + WS_WAT); bf16_t* WFT = (bf16_t*)(ws + WS_WFT); bf16_t* WOT = (bf16_t*)(ws + WS_WOT);
    bf16_t* W5T = (bf16_t*)(ws + WS_W5T); bf16_t* WDT = (bf16_t*)(ws + WS_WDT);
    bf16_t* XB = (bf16_t*)(ws + WS_RA); bf16_t* OA = (bf16_t*)(ws + WS_RA); bf16_t* OF = (bf16_t*)(ws + WS_RA + (size_t)M * 1024 * 2); bf16_t* H1B = (bf16_t*)(ws + WS_RA);
    bf16_t* QKV = (bf16_t*)(ws + WS_RB); float* TMP = (float*)(ws + WS_RB); bf16_t* MERGED = (bf16_t*)(ws + WS_RB + (size_t)M * DM * 4); bf16_t* ACT = (bf16_t*)(ws + WS_RB);
    bf16_t* GATES = (bf16_t*)(ws + WS_RG);
    float* RSTD1 = (float*)(ws + WS_RSTD1); float* SSQ2 = (float*)(ws + WS_SSQ2); float* SSQ3 = (float*)(ws + WS_SSQ3);
    float* LOGF = (float*)(ws + WS_LOGF); float* CUM = (float*)(ws + WS_CUM); float* KSQ = (float*)(ws + WS_KSQ); float* SSQA = (float*)(ws + WS_SSQA);
    const int lo = p.ph_lo, hi_ = p.ph_hi;
#define IN(k) (lo <= (k) && (k) < hi_)
#define SEAM(k) do { if (IN(k) && IN((k) + 1)) grid.sync(); } while (0)

    for (int rep_ = 0; rep_ < (REP_PHASE == 0 ? 2 : 1); ++rep_) if (IN(0)) {
        if (rep_) grid.sync();
        const int lane = fresh_lane(), tid = wid * 64 + lane;
        float* tile = (float*)lds;
        const float* w_in = p.in[3];
        transpose_job(w_in, NINC, 0, 96, DM, W1T, -1, p.in[2], tile, tid);
        transpose_job(w_in, NINC, 6152, 64, DM, W1T + (size_t)6144 * DM, -1, p.in[2], tile, tid);
        transpose_job(p.in[10], DM, 0, 32, 1024, WAT, -1, nullptr, tile, tid);
        transpose_job(p.in[11], DM, 0, 32, 1024, WFT, -1, nullptr, tile, tid);
        transpose_job(p.in[12], DM, 0, 32, DM, WOT, -1, nullptr, tile, tid);
        transpose_job(p.in[14], DFF, 0, 88, DM, W5T, 0, p.in[13], tile, tid);
        transpose_job(p.in[15], DFF, 0, 88, DM, W5T, 1, p.in[13], tile, tid);
        transpose_job(p.in[16], DM, 0, 32, DFF, WDT, -1, nullptr, tile, tid);
        float* WF = (float*)lds;
        for (int k = tid; k < DM; k += 512) { const float g = p.in[2][k]; const f32x4 a = *(const f32x4*)(w_in + (size_t)k * NINC + 6144), b = *(const f32x4*)(w_in + (size_t)k * NINC + 6148);
#pragma unroll
            for (int j = 0; j < 4; ++j) { WF[j * DM + k] = a[j] * g; WF[(4 + j) * DM + k] = b[j] * g; } }
        __syncthreads();
        const float* x = p.in[0]; const float* meta = p.in[1]; const float* b_f = p.in[9];
        for (int job = bx * 8 + wid; job < M + NMETA; job += G * 8) {
            const bool ismeta = job >= M; const int row = ismeta ? job + VPAD : job;
            const float* src = ismeta ? meta + (size_t)(job - M) * DM : x + (size_t)job * DM;
            f32x4 v[8]; float ss = 0.f; float zf[8];
#pragma unroll
            for (int j = 0; j < 8; ++j) zf[j] = 0.f;
#pragma unroll
            for (int i = 0; i < 8; ++i) { v[i] = *(const f32x4*)(src + i * 256 + lane * 4);
                ss += (v[i][0] * v[i][0] + v[i][1] * v[i][1]) + (v[i][2] * v[i][2] + v[i][3] * v[i][3]); }
#pragma unroll
            for (int i = 0; i < 8; ++i) {
                u32x2 w; w.x = pg8::cvt_pk_bf16(v[i][0], v[i][1]); w.y = pg8::cvt_pk_bf16(v[i][2], v[i][3]);
                *(u32x2*)(XB + (size_t)row * DM + i * 256 + lane * 4) = w;
#pragma unroll
                for (int j = 0; j < 8; ++j) { const f32x4 wv = *(const f32x4*)(WF + j * DM + i * 256 + lane * 4); zf[j] += (v[i][0] * wv[0] + v[i][1] * wv[1]) + (v[i][2] * wv[2] + v[i][3] * wv[3]); } }
            ss = wave_sum(ss);
#pragma unroll
            for (int j = 0; j < 8; ++j) zf[j] = wave_sum(zf[j]);
            const float rs = __builtin_amdgcn_rsqf(ss * (1.0f / 2048.0f) + 1e-6f);
            if (lane == 0) RSTD1[row] = rs;
            if (lane < 8 && !ismeta) { SSQ2[(size_t)lane * M + row] = 0.f; SSQ3[(size_t)lane * M + row] = 0.f; }
            if (lane < 8) { float zz = zf[0];
#pragma unroll
                for (int j = 1; j < 8; ++j) zz = (lane == j) ? zf[j] : zz;
                const float y = zz * rs + b_f[lane];
                const float lf = fminf(y, 0.f) - log1pf(__expf(-fabsf(y)));
                if (!ismeta) { const int b = job >> 13, t = job & (SEQ - 1); LOGF[(size_t)(b * 8 + lane) * LB + 64 + t] = lf; }
                else { const int vp = VPAD + (job - M);
#pragma unroll
                    for (int b = 0; b < NBATCH; ++b) LOGF[(size_t)(b * 8 + lane) * LB + vp] = lf; } }
        }
        for (int i = bx * 512 + tid; i < 16 * MQ; i += G * 512) KSQ[i] = 0.f;
        if (bx == 0 && tid == 0) *(unsigned*)(ws + WS_QCTR) = 0u;
        if (bx == 1 && tid < 256) ((unsigned*)(ws + WS_CNT6))[64 * tid] = 0u;
        if (bx == 0) for (int i = tid; i < 32 * VPAD; i += 512) LOGF[(size_t)(i / VPAD) * LB + (i % VPAD)] = 0.f;
        __syncthreads();
    }
    SEAM(0);

    for (int rep_ = 0; rep_ < (REP_PHASE == 1 ? 2 : 1); ++rep_) if (IN(1)) {
        if (rep_) grid.sync();
        const int lane = fresh_lane(), tid = wid * 64 + lane;
        if (bx < 32) {
            const float* srcp = LOGF + (size_t)bx * LB; float* dstp = CUM + (size_t)bx * LB; float* red = (float*)lds;
            const int i0 = tid * 17; float vals[17]; float s = 0.f;
#pragma unroll
            for (int i = 0; i < 17; ++i) { const int k = i0 + i; vals[i] = k < LB ? srcp[k] : 0.f; s += vals[i]; vals[i] = s; }
            float incl = s;
#pragma unroll
            for (int o = 1; o < 64; o <<= 1) { const float t = __shfl_up(incl, o); if (lane >= o) incl += t; }
            if (lane == 63) red[wid] = incl;
            __syncthreads();
            float base = incl - s;
            for (int w = 0; w < wid; ++w) base += red[w];
#pragma unroll
            for (int i = 0; i < 17; ++i) { const int k = i0 + i; if (k < LB) dstp[k] = (base + vals[i]) * 11.313708498984761f; }
            __syncthreads();
        }
        {
            bf16_t* xm = (bf16_t*)lds;
            for (int i = tid; i < 16 * 256; i += 512) *(u32x4*)(xm + (size_t)i * 8) = *(const u32x4*)(XB + (size_t)(M + VPAD) * DM + (size_t)i * 8);
            { const int i = bx * 512 + tid; if (i < 32 * VPAD * 16) { const int sl = i / (VPAD * 16), r = (i / 16) % VPAD, ch = i % 16; const int hd = sl < 16 ? 8 + sl : 16 + sl;
                *(u32x4*)(QKV + ((size_t)hd * MQ + M + r) * 128 + ch * 8) = (u32x4){0u, 0u, 0u, 0u}; } }
            __syncthreads();
            for (int c0 = bx * 16; c0 < 4096; c0 += G * 16) {
#pragma unroll 1
                for (int cc = 0; cc < 2; ++cc) { const int c = c0 + wid * 2 + cc, sl = c >> 7, hd = sl < 16 ? 8 + sl : 16 + sl, n = hd * 128 + (c & 127);
                    f32x4 wa[8];
#pragma unroll
                    for (int q = 0; q < 4; ++q) unpack8(*(const u32x4*)(W1T + (size_t)n * DM + lane * 32 + q * 8), wa[2 * q], wa[2 * q + 1]);
                    float mine = 0.f;
#pragma unroll 1
                    for (int j = 0; j < 16; ++j) { float a = 0.f;
#pragma unroll
                        for (int q = 0; q < 4; ++q) { f32x4 x0, x1; unpack8(*(const u32x4*)(xm + (size_t)j * DM + lane * 32 + q * 8), x0, x1);
                            a += (x0[0] * wa[2 * q][0] + x0[1] * wa[2 * q][1]) + (x0[2] * wa[2 * q][2] + x0[3] * wa[2 * q][3]) + (x1[0] * wa[2 * q + 1][0] + x1[1] * wa[2 * q + 1][1]) + (x1[2] * wa[2 * q + 1][2] + x1[3] * wa[2 * q + 1][3]); }
                        a = wave_sum(a); mine = (lane == j) ? a : mine; }
                    if (lane < 16) { const float v = mine * RSTD1[M + VPAD + lane]; QKV[((size_t)hd * MQ + M + VPAD + lane) * 128 + (c & 127)] = (bf16_t)(pg8::cvt_pk_bf16(v, v) & 0xffffu); } }
            }
            __syncthreads();
        }
        pg8::Gemm g{XB, W1T, M, N1, DM}; pg8::StaticOrder S; S.init(M, N1, G, bx);
        Epi1 E{QKV, GATES, RSTD1, KSQ};
        pg8::gemm_phase<Epi1, pg8::StaticOrder>((PG8_LAS unsigned char*)lds, g, S, E, wid * 64 + fresh_lane());
    }
    SEAM(1);

    for (int rep_ = 0; rep_ < (REP_PHASE == 2 ? 2 : 1); ++rep_) if (IN(2)) {
        if (rep_) grid.sync();
        const int lane = fresh_lane(), tid = wid * 64 + lane;
        float lam;
        { const float* q1 = p.in[4]; const float* k1 = p.in[5]; const float* q2 = p.in[6]; const float* k2 = p.in[7];
          float s1 = q1[lane] * k1[lane] + q1[lane + 64] * k1[lane + 64], s2 = q2[lane] * k2[lane] + q2[lane + 64] * k2[lane + 64];
          s1 = wave_sum(s1); s2 = wave_sum(s2); lam = __expf(s1) - __expf(s2) + 0.2f; lam = __uint_as_float(__builtin_amdgcn_readfirstlane(__float_as_uint(lam))); }
        float* scrT = (float*)(ws + WS_SCR + (size_t)bx * 262144);
        float* tabw = (float*)(lds + att::LDS_TAB);
        constexpr int NITEM = 2048, NDIFF = 1024;
        unsigned* qctr = (unsigned*)(ws + WS_QCTR);
        float* red = (float*)(lds + att::LDS_TAB + 8256 * 4);
        auto grab = [&]() -> int { if (wid == 0 && fresh_lane() == 0) red[16] = __uint_as_float(atomicAdd(qctr, 1u)); __syncthreads();
                                   const int v = __builtin_amdgcn_readfirstlane((int)__float_as_uint(red[16])); __syncthreads(); return v; };
        auto desc = [&](int item, int ps) -> att::Blk {
            att::Blk r;
            if (item >= NDIFF) { const int j = item - NDIFF, h = j >> 7, b = (j >> 5) & 3, qb = 31 - (j & 31);
                const size_t rb = (size_t)b * SEQ + 256 * qb; r.P0 = 64 + 256 * qb; r.mode = 0; r.s2 = 0.f;
                r.Q = QKV + ((size_t)(24 + h) * MQ + rb) * 128; r.K = QKV + ((size_t)(32 + h) * MQ + (size_t)b * SEQ) * 128 - 64 * 128; r.V = QKV + ((size_t)(40 + h) * MQ + (size_t)b * SEQ) * 128 - 64 * 128;
                r.K0 = QKV + ((size_t)(32 + h) * MQ + M) * 128; r.V0 = QKV + ((size_t)(40 + h) * MQ + M) * 128;
                r.O = OF + rb * 1024 + h * 128; }
            else { const int h = 3 - (item >> 8), b = (item >> 6) & 3, qb = 31 - ((item >> 1) & 31), e = item & 1, c = ps;
                const size_t rb = (size_t)b * SEQ + 256 * qb; r.P0 = 64 + 256 * qb; r.mode = 1 + c;
                r.s2 = 2.0f * 11.313708498984761f * (h == 0 ? 0.25f : h == 1 ? 0.0625f : h == 2 ? 0.015625f : 0.00390625f);
                r.Q = QKV + ((size_t)(2 * h + c) * MQ + rb) * 128; r.K = QKV + ((size_t)(8 + 2 * h + c) * MQ + (size_t)b * SEQ) * 128 - 64 * 128; r.V = QKV + ((size_t)(16 + 2 * h + e) * MQ + (size_t)b * SEQ) * 128 - 64 * 128;
                r.K0 = QKV + ((size_t)(8 + 2 * h + c) * MQ + M) * 128; r.V0 = QKV + ((size_t)(16 + 2 * h + e) * MQ + M) * 128;
                r.O = OA + rb * 1024 + h * 256 + e * 128; }
            return r; };
        int item = grab();
        if (item < NITEM) {
            att::Seam S;
            { const att::Blk first = desc(item, 0); att::attn_prime(first, (char*)lds, S, wid * 64 + fresh_lane()); }
            while (item < NITEM) {
              const int item_next = grab();
              const int np = item < NDIFF ? 2 : 1;
              for (int ps = 0; ps < np; ++ps) {
                const att::Blk cur = desc(item, ps);
                const bf16_t* nxtQ = (ps + 1 < np) ? desc(item, ps + 1).Q : (item_next < NITEM ? desc(item_next, 0).Q : cur.Q);
                const int tt = wid * 64 + fresh_lane(), ln_ = tt & 63;
                float km = 0.f;
                { const int nk = cur.P0 + 256;
                  if (item >= NDIFF) { const int j = item - NDIFF, h = j >> 7, b = (j >> 5) & 3; const float* cm = CUM + (size_t)(b * 8 + h) * LB; const float cref = cm[cur.P0];
                      const float* kq = KSQ + (size_t)(8 + h) * MQ;
                      for (int k = tt; k < nk; k += 512) { tabw[k] = cref - cm[k]; km = fmaxf(km, k < 64 ? metak2(cur.K0, k) : kq[b * SEQ + k - 64]); } }
                  else { const int h = 3 - (item >> 8), b = (item >> 6) & 3, c = ps; const float sl = 0.5f * cur.s2; const float* kq = KSQ + (size_t)(2 * h + c) * MQ;
                      for (int k = tt; k < nk; k += 512) { tabw[k] = sl * (float)(k - cur.P0); km = fmaxf(km, k < 64 ? metak2(cur.K0, k) : kq[b * SEQ + k - 64]); } } }
                float qs = 0.f;
#pragma unroll
                for (int d0 = 0; d0 < 8; ++d0) { f32x4 a, b2; unpack8(*reinterpret_cast<const u32x4*>(&S.qr[d0]), a, b2); qs += (a[0] * a[0] + a[1] * a[1]) + (a[2] * a[2] + a[3] * a[3]) + (b2[0] * b2[0] + b2[1] * b2[1]) + (b2[2] * b2[2] + b2[3] * b2[3]); }
                qs += shx(qs, 32, ln_);
#pragma unroll
                for (int o = 32; o >= 1; o >>= 1) { qs = fmaxf(qs, shx(qs, o, ln_)); km = fmaxf(km, shx(km, o, ln_)); }
                if (ln_ == 0) { red[wid] = qs; red[8 + wid] = km; }
                __syncthreads();
                int j_lo;
                { float q2 = red[0], k2 = red[8];
#pragma unroll
                  for (int w = 1; w < 8; ++w) { q2 = fmaxf(q2, red[w]); k2 = fmaxf(k2, red[8 + w]); }
                  const float Bnd = sqrtf(q2 * k2) * 1.05f + 1.0f; const float thr = -(1176.3f + 45.3f + Bnd);
                  int lo_ = 0, hi_2 = (cur.P0 + 255) / 64;
                  while (lo_ < hi_2) { const int mid = (lo_ + hi_2) >> 1; if (tabw[64 * mid + 63] < thr) lo_ = mid + 1; else hi_2 = mid; }
                  j_lo = __builtin_amdgcn_readfirstlane(lo_); }
                att::attn_block(cur, nxtQ, (char*)lds, S, lam, scrT, OA, SSQA, wid * 64 + fresh_lane(), j_lo);
              }
              item = item_next;
            }
        }
        asm volatile("s_waitcnt vmcnt(0)" ::: "memory");
        __syncthreads();
        grid.sync();
        { const int ln2 = fresh_lane(), h = ln2 >> 4; const float* g_subln = p.in[8];
          f32x4 gq[4];
#pragma unroll
          for (int q = 0; q < 4; ++q) gq[q] = *(const f32x4*)(g_subln + (ln2 & 15) * 16 + q * 4) * 0.8f;
          for (int row = bx * 8 + wid; row < M; row += G * 8) {
              const float rn = __builtin_amdgcn_rsqf((SSQA[(size_t)row * 8 + 2 * h] + SSQA[(size_t)row * 8 + 2 * h + 1]) * (1.0f / 256.0f) + 1e-5f);
              bf16_t* d = OA + (size_t)row * 1024 + ln2 * 16;
              f32x4 a0, a1, a2, a3; unpack8(*(const u32x4*)d, a0, a1); unpack8(*(const u32x4*)(d + 8), a2, a3);
              *(u32x4*)d = pack8u(a0 * rn * gq[0], a1 * rn * gq[1]); *(u32x4*)(d + 8) = pack8u(a2 * rn * gq[2], a3 * rn * gq[3]); } }
    }
    SEAM(2);

    for (int rep_ = 0; rep_ < (REP_PHASE == 3 ? 2 : 1); ++rep_) if (IN(3)) {
        if (rep_) grid.sync();
        if (G == 256) { pg8::Gemm g{OA, WAT, M, DM, 1024}; PanelOrder S{bx}; Epi3a E{TMP, GATES};
          pg8::gemm_phase<Epi3a, PanelOrder>((PG8_LAS unsigned char*)lds, g, S, E, wid * 64 + fresh_lane()); }
        else { pg8::Gemm g{OA, WAT, M, DM, 1024}; pg8::StaticOrder S; S.init(M, DM, G, bx); Epi3a E{TMP, GATES};
          pg8::gemm_phase<Epi3a, pg8::StaticOrder>((PG8_LAS unsigned char*)lds, g, S, E, wid * 64 + fresh_lane()); }
        if (G == 256) { pg8::Gemm g{OF, WFT, M, DM, 1024}; PanelOrder S{bx}; Epi3b E{TMP, GATES, MERGED};
          pg8::gemm_phase<Epi3b, PanelOrder>((PG8_LAS unsigned char*)lds, g, S, E, wid * 64 + fresh_lane()); }
        else { pg8::Gemm g{OF, WFT, M, DM, 1024}; pg8::StaticOrder S; S.init(M, DM, G, bx); Epi3b E{TMP, GATES, MERGED};
          pg8::gemm_phase<Epi3b, pg8::StaticOrder>((PG8_LAS unsigned char*)lds, g, S, E, wid * 64 + fresh_lane()); }
    }
    SEAM(3);

    if (IN(4)) {
        pg8::Gemm g{MERGED, WOT, M, DM, DM}; Epi4 E{p.in[0], p.out, H1B, SSQ2};
        if (G == 256) { PanelOrder S{bx}; pg8::gemm_phase<Epi4, PanelOrder>((PG8_LAS unsigned char*)lds, g, S, E, wid * 64 + fresh_lane()); }
        else { pg8::StaticOrder S; S.init(M, DM, G, bx); pg8::gemm_phase<Epi4, pg8::StaticOrder>((PG8_LAS unsigned char*)lds, g, S, E, wid * 64 + fresh_lane()); }
    }
    SEAM(4);

    for (int rep_ = 0; rep_ < (REP_PHASE == 5 ? 2 : 1); ++rep_) if (IN(5)) {
        if (rep_) grid.sync();
        pg8::Gemm g{H1B, W5T, M, N5, DM}; pg8::StaticOrder S; S.init(M, N5, G, bx); Epi5 E{SSQ2, ACT};
        pg8::gemm_phase<Epi5, pg8::StaticOrder>((PG8_LAS unsigned char*)lds, g, S, E, wid * 64 + fresh_lane());
    }
    SEAM(5);

    if (IN(6)) {
        pg8::Gemm g{ACT, WDT, M, DM, DFF};
        if (G == 256) { PanelOrder S{bx}; Epi6 E{p.out, SSQ3};
            pg8::gemm_phase<Epi6, PanelOrder>((PG8_LAS unsigned char*)lds, g, S, E, wid * 64 + fresh_lane()); }
        else { pg8::StaticOrder S; S.init(M, DM, G, bx); Epi6 E{p.out, SSQ3};
            pg8::gemm_phase<Epi6, pg8::StaticOrder>((PG8_LAS unsigned char*)lds, g, S, E, wid * 64 + fresh_lane()); }
    }
    SEAM(6);

    if (IN(7)) {
        const int lane = fresh_lane();
        const float* gfin = p.in[17];
        f32x4 gv[8];
#pragma unroll
        for (int i = 0; i < 8; ++i) gv[i] = *(const f32x4*)(gfin + i * 256 + lane * 4);
        for (int orow = bx * 8 + wid; orow < NBATCH * SEQ; orow += G * 8) {
            const int row = orow;
            float sq = 0.f;
#pragma unroll
            for (int t = 0; t < 8; ++t) sq += SSQ3[(size_t)t * M + row];
            const float rs = __builtin_amdgcn_rsqf(sq * (1.0f / 2048.0f) + 1e-6f);
            float* d = p.out + (size_t)orow * DM + lane * 4;
#pragma unroll
            for (int i = 0; i < 8; ++i) { const f32x4 v = *(const f32x4*)(d + i * 256); *(f32x4*)(d + i * 256) = v * rs * gv[i]; }
        }
    }
#undef IN
#undef SEAM
}

extern "C" void kernel_launch(void* const* d_in, const int* in_sizes, int n_in, void* d_out, int out_size, void* d_ws, size_t ws_size, hipStream_t stream) {
    static int grid = 0;
    if (grid == 0) {
        if (n_in != 18 || ws_size < WS_END) { fprintf(stderr, "kernel_launch: need 18 inputs and >= %zu bytes of workspace (got %d, %zu)\n", (size_t)WS_END, n_in, ws_size); grid = -1; return; }
        int dev = 0, cus = 0, per_cu = 0;
        (void)hipGetDevice(&dev);
        if (hipDeviceGetAttribute(&cus, hipDeviceAttributeMultiprocessorCount, dev) != hipSuccess || cus <= 0) cus = 256;
        if (hipFuncSetAttribute((const void*)fwd_kernel, hipFuncAttributeMaxDynamicSharedMemorySize, LDS_BYTES) != hipSuccess) { fprintf(stderr, "kernel_launch: hipFuncSetAttribute failed\n"); }
        if (hipOccupancyMaxActiveBlocksPerMultiprocessor(&per_cu, (const void*)fwd_kernel, 512, LDS_BYTES) != hipSuccess || per_cu < 1) { fprintf(stderr, "kernel_launch: occupancy query says %d\n", per_cu); per_cu = 1; }
        (void)hipGetLastError();
        grid = cus * 1;
        if (grid > 256) grid = 256;
    }
    if (grid < 0) return;
    Params p{};
    for (int i = 0; i < 18; ++i) p.in[i] = (const float*)d_in[i];
    p.out = (float*)d_out; p.ws = (unsigned char*)d_ws;
#if ONE_LAUNCH
    p.ph_lo = 0; p.ph_hi = 8;
    void* args[] = {&p};
    hipError_t e = hipLaunchCooperativeKernel((const void*)fwd_kernel, dim3(grid), dim3(512), args, LDS_BYTES, stream);
    if (e != hipSuccess) fprintf(stderr, "cooperative launch failed: %s (grid %d)\n", hipGetErrorString(e), grid);
#else
    for (int ph = 0; ph < 8; ++ph) { p.ph_lo = ph; p.ph_hi = ph + 1; hipLaunchKernelGGL(fwd_kernel, dim3(grid), dim3(512), LDS_BYTES, stream, p); }
#endif
}
```
